# Optimizing an MI355X kernel written in HIP

```python
import jax, jax.numpy as jnp
from jax import lax

D_MODEL = 2048
BATCH = 2
SEQ = 4096
DEPTH = 4
DEC_BATCH = 32
DEC_SEQ = 4
PAST_LEN = 16384
PAGE_SIZE = 128

HEAD_DIM = 64
N_HEADS = D_MODEL // HEAD_DIM
N_KV_HEADS = N_HEADS // 8
GQA_GROUP = N_HEADS // N_KV_HEADS
ROT_DIM = HEAD_DIM // 4
ROPE_THETA = 500000.0
WINDOW = 128
BLOCK = 128
CONV_WIDTH = 3
SGU_WIDTH = D_MODEL
SGU_GROUPS = 8
SGU_GROUP_DIM = SGU_WIDTH // SGU_GROUPS
CHUNK = 128
D_FF = 5632
N_MIXERS = 3
N_ATTN_LAYERS = (DEPTH + 2) // 3
N_CONV_LAYERS = (DEPTH + 1) // 3
N_SGU_LAYERS = DEPTH // 3
RMS_EPS = 1e-6
LN_EPS = 1e-5
NEG_INF = -1e30

kernel_name = "hybrid_swa_shortconv_sgu_macaron_step"


def rms_norm(x, g):
    xf = x.astype(jnp.float32)
    y = xf * lax.rsqrt(jnp.mean(xf * xf, axis=-1, keepdims=True) + RMS_EPS)
    return (y * g.astype(jnp.float32)).astype(x.dtype)


def layer_norm(x, g, b):
    xf = x.astype(jnp.float32)
    mu = jnp.mean(xf, axis=-1, keepdims=True)
    xc = xf - mu
    y = xc * lax.rsqrt(jnp.mean(xc * xc, axis=-1, keepdims=True) + LN_EPS)
    return (y * g.astype(jnp.float32) + b.astype(jnp.float32)).astype(x.dtype)


def swiglu(h, w_gu, w_down):
    g, u = jnp.split(h @ w_gu, 2, axis=-1)
    return (jax.nn.silu(g) * u) @ w_down


def half_ffn(x, g_pre, g_post, w_gu, w_down):
    return x + 0.5 * rms_norm(swiglu(rms_norm(x, g_pre), w_gu, w_down), g_post)


def rope(x, pos):
    half = ROT_DIM // 2
    inv = jnp.power(jnp.float32(ROPE_THETA), -jnp.arange(0, ROT_DIM, 2, dtype=jnp.float32) / ROT_DIM)
    ang = pos.astype(jnp.float32)[:, None] * inv[None, :]
    c = jnp.cos(ang)[None, :, None, :]
    s = jnp.sin(ang)[None, :, None, :]
    xf = x.astype(jnp.float32)
    x1, x2 = xf[..., :half], xf[..., half:ROT_DIM]
    out = jnp.concatenate([x1 * c - x2 * s, x2 * c + x1 * s, xf[..., ROT_DIM:]], axis=-1)
    return out.astype(x.dtype)


def qkv_proj(h, pos, w_qkv):
    B, L, _ = h.shape
    q, k, v = jnp.split(h @ w_qkv, [N_HEADS * HEAD_DIM, (N_HEADS + N_KV_HEADS) * HEAD_DIM], axis=-1)
    q = rope(q.reshape(B, L, N_HEADS, HEAD_DIM), pos)
    k = rope(k.reshape(B, L, N_KV_HEADS, HEAD_DIM), pos)
    v = v.reshape(B, L, N_KV_HEADS, HEAD_DIM)
    return q, k, v


def sink_attention(q, k, v, mask, sinks):
    s = jnp.einsum('bnqhgd,bnkhd->bnhgqk', q, k).astype(jnp.float32) * (HEAD_DIM ** -0.5)
    s = jnp.where(mask[None, :, None, None], s, NEG_INF)
    sk = sinks.astype(jnp.float32).reshape(N_KV_HEADS, GQA_GROUP)[None, None, :, :, None, None]
    m = jnp.maximum(jnp.max(s, axis=-1, keepdims=True), sk)
    p = jnp.exp(s - m)
    denom = jnp.sum(p, axis=-1, keepdims=True) + jnp.exp(sk - m)
    p = (p / denom).astype(v.dtype)
    return jnp.einsum('bnhgqk,bnkhd->bnqhgd', p, v)


def swa_prompt(h, w_qkv, w_o, sinks):
    B, L, _ = h.shape
    nb = L // BLOCK
    q, k, v = qkv_proj(h, jnp.arange(L), w_qkv)
    qb = q.reshape(B, nb, BLOCK, N_KV_HEADS, GQA_GROUP, HEAD_DIM)
    kb = k.reshape(B, nb, BLOCK, N_KV_HEADS, HEAD_DIM)
    vb = v.reshape(B, nb, BLOCK, N_KV_HEADS, HEAD_DIM)

    def with_prev(t):
        prev = jnp.concatenate([jnp.zeros_like(t[:, :1]), t[:, :-1]], axis=1)
        return jnp.concatenate([prev, t], axis=2)

    blk = jnp.arange(nb)[:, None] * BLOCK
    qpos = blk + jnp.arange(BLOCK)[None, :]
    kpos = blk - BLOCK + jnp.arange(2 * BLOCK)[None, :]
    d = qpos[:, :, None] - kpos[:, None, :]
    mask = (d >= 0) & (d <= WINDOW) & (kpos[:, None, :] >= 0)
    o = sink_attention(qb, with_prev(kb), with_prev(vb), mask, sinks)
    o = o.reshape(B, L, N_HEADS * HEAD_DIM) @ w_o
    return o, k[:, L - WINDOW:], v[:, L - WINDOW:]


def swa_sample(h, ck, cv, w_qkv, w_o, sinks):
    B, L, _ = h.shape
    q, k, v = qkv_proj(h, PAST_LEN + jnp.arange(L), w_qkv)
    kc = jnp.concatenate([ck.astype(k.dtype), k], axis=1)
    vc = jnp.concatenate([cv.astype(v.dtype), v], axis=1)
    d = (WINDOW + jnp.arange(L))[:, None] - jnp.arange(WINDOW + L)[None, :]
    mask = ((d >= 0) & (d <= WINDOW))[None]
    o = sink_attention(q.reshape(B, 1, L, N_KV_HEADS, GQA_GROUP, HEAD_DIM), kc[:, None], vc[:, None], mask, sinks)
    o = o.reshape(B, L, N_HEADS * HEAD_DIM) @ w_o
    return o, kc[:, L:], vc[:, L:]


def short_conv(h, prefix, w_in, w_conv, w_out):
    L = h.shape[1]
    b_gate, c_gate, hin = jnp.split(h @ w_in, 3, axis=-1)
    z = c_gate * hin
    zp = jnp.concatenate([prefix.astype(z.dtype), z], axis=1)
    y = w_conv[0] * zp[:, 0:L]
    for j in range(1, CONV_WIDTH):
        y = y + w_conv[j] * zp[:, j:j + L]
    return (b_gate * y) @ w_out, zp[:, L:]


def sgu(h, chunk, w_in, ln_g, ln_b, w_s, b_s, w_out):
    B, L, _ = h.shape
    nc = L // chunk
    u, v = jnp.split(jax.nn.gelu(h @ w_in), 2, axis=-1)
    v = layer_norm(v, ln_g, ln_b)
    causal = jnp.tril(jnp.ones((chunk, chunk), dtype=bool))
    ws = w_s[:, :chunk, :chunk]
    ws = jnp.where(causal[None], ws, jnp.zeros((), ws.dtype)).astype(v.dtype)
    vg = v.reshape(B, nc, chunk, SGU_GROUPS, SGU_GROUP_DIM)
    mixed = jnp.einsum('gts,bcsgd->bctgd', ws, vg) + b_s[:, :chunk].T.astype(v.dtype)[None, None, :, :, None]
    out = (u * mixed.reshape(B, L, SGU_WIDTH)) @ w_out
    return out, v


def setup_inputs(seed: int = 0) -> dict:
    key = jax.random.key(seed)
    ks = jax.random.split(key, 20)

    def nrm(k, shape, scale):
        return jax.random.normal(k, shape, jnp.float32) * scale

    D, H, KV, hd = D_MODEL, N_HEADS, N_KV_HEADS, HEAD_DIM
    return {
        "x_prompt": nrm(ks[0], (BATCH, SEQ, D), 1.0),
        "x_sample": nrm(ks[1], (DEC_BATCH, DEC_SEQ, D), 1.0),
        "cache_k": nrm(ks[2], (N_ATTN_LAYERS, DEC_BATCH, WINDOW, KV, hd), 1.0),
        "cache_v": nrm(ks[3], (N_ATTN_LAYERS, DEC_BATCH, WINDOW, KV, hd), 1.0),
        "state_conv": nrm(ks[4], (N_CONV_LAYERS, DEC_BATCH, CONV_WIDTH - 1, D), 1.0),
        "norm_g": 1.0 + nrm(ks[5], (DEPTH, 6, D), 0.02),
        "ffn_w_gu": nrm(ks[6], (DEPTH, 2, D, 2 * D_FF), D ** -0.5),
        "ffn_w_down": nrm(ks[7], (DEPTH, 2, D_FF, D), D_FF ** -0.5),
        "attn_w_qkv": nrm(ks[8], (N_ATTN_LAYERS, D, (H + 2 * KV) * hd), D ** -0.5),
        "attn_w_o": nrm(ks[9], (N_ATTN_LAYERS, H * hd, D), (H * hd) ** -0.5),
        "attn_sinks": nrm(ks[10], (N_ATTN_LAYERS, H), 1.0),
        "conv_w_in": nrm(ks[11], (N_CONV_LAYERS, D, 3 * D), D ** -0.5),
        "conv_w": nrm(ks[12], (N_CONV_LAYERS, CONV_WIDTH, D), CONV_WIDTH ** -0.5),
        "conv_w_out": nrm(ks[13], (N_CONV_LAYERS, D, D), D ** -0.5),
        "sgu_w_in": nrm(ks[14], (N_SGU_LAYERS, D, 2 * SGU_WIDTH), D ** -0.5),
        "sgu_ln_g": 1.0 + nrm(ks[15], (N_SGU_LAYERS, SGU_WIDTH), 0.02),
        "sgu_ln_b": nrm(ks[16], (N_SGU_LAYERS, SGU_WIDTH), 0.02),
        "sgu_w_s": nrm(ks[17], (N_SGU_LAYERS, SGU_GROUPS, CHUNK, CHUNK), CHUNK ** -0.5),
        "sgu_b_s": 1.0 + nrm(ks[18], (N_SGU_LAYERS, SGU_GROUPS, CHUNK), 0.1),
        "sgu_w_out": nrm(ks[19], (N_SGU_LAYERS, SGU_WIDTH, D), SGU_WIDTH ** -0.5),
    }


def reference(x_prompt, x_sample, cache_k, cache_v, state_conv, norm_g, ffn_w_gu, ffn_w_down,
              attn_w_qkv, attn_w_o, attn_sinks, conv_w_in, conv_w, conv_w_out,
              sgu_w_in, sgu_ln_g, sgu_ln_b, sgu_w_s, sgu_b_s, sgu_w_out):
    xp, xs = x_prompt, x_sample
    kp_l, vp_l, ks_l, vs_l, cp_l, cs_l, sv_l = [], [], [], [], [], [], []
    for i in range(DEPTH):
        kind, j = i % N_MIXERS, i // N_MIXERS
        g = norm_g[i]
        xp = half_ffn(xp, g[0], g[1], ffn_w_gu[i, 0], ffn_w_down[i, 0])
        xs = half_ffn(xs, g[0], g[1], ffn_w_gu[i, 0], ffn_w_down[i, 0])
        hp, hs = rms_norm(xp, g[2]), rms_norm(xs, g[2])
        if kind == 0:
            op, kp, vp = swa_prompt(hp, attn_w_qkv[j], attn_w_o[j], attn_sinks[j])
            os_, kn, vn = swa_sample(hs, cache_k[j], cache_v[j], attn_w_qkv[j], attn_w_o[j], attn_sinks[j])
            kp_l.append(kp); vp_l.append(vp); ks_l.append(kn); vs_l.append(vn)
        elif kind == 1:
            zero_prefix = jnp.zeros((hp.shape[0], CONV_WIDTH - 1, D_MODEL), hp.dtype)
            op, cp = short_conv(hp, zero_prefix, conv_w_in[j], conv_w[j], conv_w_out[j])
            os_, cn = short_conv(hs, state_conv[j], conv_w_in[j], conv_w[j], conv_w_out[j])
            cp_l.append(cp); cs_l.append(cn)
        else:
            op, _ = sgu(hp, CHUNK, sgu_w_in[j], sgu_ln_g[j], sgu_ln_b[j], sgu_w_s[j], sgu_b_s[j], sgu_w_out[j])
            os_, sv = sgu(hs, DEC_SEQ, sgu_w_in[j], sgu_ln_g[j], sgu_ln_b[j], sgu_w_s[j], sgu_b_s[j], sgu_w_out[j])
            sv_l.append(sv)
        xp = xp + rms_norm(op, g[3])
        xs = xs + rms_norm(os_, g[3])
        xp = half_ffn(xp, g[4], g[5], ffn_w_gu[i, 1], ffn_w_down[i, 1])
        xs = half_ffn(xs, g[4], g[5], ffn_w_gu[i, 1], ffn_w_down[i, 1])
    return (xp, xs, jnp.stack(kp_l), jnp.stack(vp_l), jnp.stack(ks_l), jnp.stack(vs_l),
            jnp.stack(cp_l), jnp.stack(cs_l), jnp.stack(sv_l))
```

```cpp
#include <hip/hip_runtime.h>
#include <cstdio>
#include <cstdint>
namespace pg8 {
#define PG8_LAS __attribute__((address_space(3)))
typedef unsigned short bf16_t;
typedef short bf16x8 __attribute__((ext_vector_type(8)));
typedef float f32x4 __attribute__((ext_vector_type(4)));
typedef unsigned u32x4 __attribute__((ext_vector_type(4)));
typedef int i32x4 __attribute__((ext_vector_type(4)));
constexpr int BM = 256, BK = 64, HALF = 128, HTB = HALF * BK * 2  , STAGE_BYTES = 8 * HTB, NXCD = 8, WGM = 8;

__host__ __device__ __forceinline__ int lds_byte(int r, int c) { const int st = (r >> 4) * 2 + (c >> 5), rr = r & 15, cc = c & 31, ob = rr * 64 + cc * 2; return st * 1024 + (ob ^ (((ob >> 9) & 1) << 5)); }
__host__ __device__ __forceinline__ void stage_rc(int b, int& R, int& C) { const int st = b / 1024, sb = b % 1024, swz = sb ^ (((sb >> 9) & 1) << 5); R = (st >> 1) * 16 + swz / 64; C = (st & 1) * 32 + (swz % 64) / 2; }
__host__ __device__ __forceinline__ int perm32(int rho) { const int n = rho >> 4, i = rho & 15; return 8 * (i >> 2) + 4 * n + (i & 3); }

struct Unit { int pm, pn, ks, nt, hm, roff; };
struct Gemm { const bf16_t* A; const bf16_t* Bt; int K; };

struct StaticOrder {
    int nM, nN, nwg, G, c;
    __host__ __device__ void init(int M, int N, int G_, int c_) { nM = M / BM; nN = N / BM; nwg = nM * nN; G = G_; c = c_; }
    __host__ __device__ bool next(int i, Unit& u) const {
        const long L = (long)i * G + c; if (L >= nwg) return false;
        int wgid = (int)L; { const int q = nwg / NXCD, r = nwg % NXCD, xcd = wgid % NXCD, off = wgid / NXCD; wgid = (xcd < r ? xcd * (q + 1) : r * (q + 1) + (xcd - r) * q) + off; }
        const int nig = WGM * nN, gid = wgid / nig, fm = gid * WGM, gsz = (nM - fm) < WGM ? (nM - fm) : WGM;
        u.pm = fm + ((wgid % nig) % gsz); u.pn = (wgid % nig) / gsz; u.ks = 0; u.nt = 0; u.hm = 0; u.roff = 0; return true;
    }
    __device__ __forceinline__ void a_ready(const Unit&) const {}
    __device__ __forceinline__ void done(const Unit&) const {}
};
struct PanelOrder {
    int nN, nP, nS, nsplit, G, c, ntFull, L0, L1, nF, nH;
    const unsigned* flag; unsigned need;
    __device__ __forceinline__ void init(int N, int K, int nsplit_, int G_, int c_, int mode = 0, const unsigned* flag_ = nullptr, unsigned need_ = 0u) {
        nN = N / BM; nP = 32 * nN; nsplit = nsplit_; nS = (mode == 1) ? 0 : nN * nsplit_; G = G_; c = c_; ntFull = K / BK; flag = flag_; need = need_;
        if (mode == 2) { nF = 0; nH = 0; c = G_ - 1 - c_; L0 = 0; L1 = nS; return; }
        const int R = nP % G_;
        nH = (R > 0 && 2 * R + nS <= G_) ? 2 * R : 0; nF = nP - nH / 2; L0 = 0; L1 = nF + nH + nS; }
    __device__ __forceinline__ void prompt_unit(int b, Unit& u) const {
        int wgid = b; { const int q = nP / NXCD, r = nP % NXCD, xcd = wgid % NXCD, off = wgid / NXCD; wgid = (xcd < r ? xcd * (q + 1) : r * (q + 1) + (xcd - r) * q) + off; }
        const int nig = WGM * nN, gid = wgid / nig, fm = gid * WGM;
        u.pm = fm + ((wgid % nig) % WGM); u.pn = (wgid % nig) / WGM; u.ks = 0; u.nt = ntFull; }
    __device__ __forceinline__ bool next(int i, Unit& u) const {
        const int L = L0 + i * G + c; if (L >= L1) return false;
        if (L < nF) { prompt_unit(L, u); u.hm = 0; u.roff = 0; }
        else if (L < nF + nH) { const int j = L - nF; prompt_unit(nF + (j >> 1), u); u.hm = 1; u.roff = 128 * (j & 1); }
        else { const int j = L - nF - nH; u.pm = 32; u.pn = j % nN; u.ks = j / nN; u.nt = ntFull / nsplit; u.hm = 1; u.roff = 0; }
        return true;
    }
    __device__ __forceinline__ void a_ready(const Unit& u) const {
        if (flag == nullptr || u.pm != 32) return;
        if (threadIdx.x < 64) {
            unsigned spins = 0;
            while ((unsigned)__builtin_amdgcn_readfirstlane(__hip_atomic_load(flag, __ATOMIC_RELAXED, __HIP_MEMORY_SCOPE_AGENT)) < need) { __builtin_amdgcn_s_sleep(2); if (++spins > (1u << 22)) break; }
            __builtin_amdgcn_fence(__ATOMIC_ACQUIRE, "agent");
            asm volatile("s_waitcnt vmcnt(0)" ::: "memory");
        }
        asm volatile("" ::: "memory"); __builtin_amdgcn_s_barrier(); asm volatile("" ::: "memory");
    }
    __device__ __forceinline__ void done(const Unit&) const {}
};


typedef float f32x2_cv __attribute__((ext_vector_type(2))); typedef __bf16 bf16x2_cv __attribute__((ext_vector_type(2)));
__device__ __forceinline__ unsigned cvt_pk_bf16(float lo, float hi) { const f32x2_cv v = {lo, hi}; const bf16x2_cv b = __builtin_convertvector(v, bf16x2_cv); return __builtin_bit_cast(unsigned, b); }
typedef unsigned u32x2 __attribute__((ext_vector_type(2)));
__device__ __forceinline__ float silu_f(float x) { return x * __builtin_amdgcn_rcpf(1.0f + __builtin_amdgcn_exp2f(-1.44269504089f * x)); }
__device__ __forceinline__ float gelu_tanh_f(float x) { const float t = x * (1.0f + 0.044715f * x * x) * (-2.0f * 0.7978845608f * 1.44269504089f); return x * __builtin_amdgcn_rcpf(1.0f + __builtin_amdgcn_exp2f(t)); }
__device__ __forceinline__ float rs_of(float ssq) { return __builtin_amdgcn_rsqf(ssq * (1.0f / 2048.0f) + 1e-6f); }
__device__ __forceinline__ u32x4 pack8(const f32x4 a, const f32x4 b) { u32x4 w; w.x = cvt_pk_bf16(a[0], a[1]); w.y = cvt_pk_bf16(a[2], a[3]); w.z = cvt_pk_bf16(b[0], b[1]); w.w = cvt_pk_bf16(b[2], b[3]); return w; }

struct EpiF32 {
    static constexpr bool PERM = true, AFTER_DRAIN = false;
    bf16_t* O; int ldc; float* P; size_t slab;
    __device__ __forceinline__ void operator()(const f32x4 (&acc)[2][2][4][2], const Unit& u, int wr, int wc, int fr, int fq) const {
        const int col0 = u.pn * BM + wc * 32 + 8 * fq;
        if (u.pm == 32) {
            const int row0 = wr * 64 + fr; float* base = P + (size_t)u.ks * slab;
#pragma unroll
            for (int m = 0; m < 4; ++m) { float* rowp = base + (size_t)(row0 + m * 16) * ldc + col0;
#pragma unroll
                for (int bj = 0; bj < 2; ++bj)
#pragma unroll
                    for (int n = 0; n < 2; ++n) {
                        const f32x4 v = acc[0][bj][m][n]; const float v0 = v[0], v1 = v[1], v2 = v[2], v3 = v[3];
                        unsigned long long* p = (unsigned long long*)(rowp + bj * HALF + 4 * n);
                        __hip_atomic_store(p, ((unsigned long long)__float_as_uint(v1) << 32) | __float_as_uint(v0), __ATOMIC_RELAXED, __HIP_MEMORY_SCOPE_AGENT);
                        __hip_atomic_store(p + 1, ((unsigned long long)__float_as_uint(v3) << 32) | __float_as_uint(v2), __ATOMIC_RELAXED, __HIP_MEMORY_SCOPE_AGENT); } }
        } else {
            const int row0 = u.pm * BM + u.roff + wr * 64 + fr;
#pragma unroll
            for (int ai = 0; ai < 2; ++ai) { if (ai == 1 && u.hm) break;
#pragma unroll
                for (int m = 0; m < 4; ++m) { bf16_t* rowp = O + (size_t)(row0 + ai * HALF + m * 16) * ldc + col0;
#pragma unroll
                    for (int bj = 0; bj < 2; ++bj) *(u32x4*)(rowp + bj * HALF) = pack8(acc[ai][bj][m][0], acc[ai][bj][m][1]); } }
        }
    }
};
template <int ACT> struct EpiGated {
    static constexpr bool PERM = true, AFTER_DRAIN = false;
    bf16_t* O; int ldc; const float* rstd;
    __device__ __forceinline__ void operator()(const f32x4 (&acc)[2][2][4][2], const Unit& u, int wr, int wc, int fr, int fq) const {
        const int row0 = u.pm * BM + u.roff + wr * 64 + fr, col0 = u.pn * HALF + wc * 32 + 8 * fq;
        float rsr[2][4];
#pragma unroll
        for (int ai = 0; ai < 2; ++ai)
#pragma unroll
            for (int m = 0; m < 4; ++m) rsr[ai][m] = rstd[row0 + ai * HALF + m * 16];
#pragma unroll
        for (int ai = 0; ai < 2; ++ai) { if (ai == 1 && u.hm) break;
#pragma unroll
            for (int m = 0; m < 4; ++m) { bf16_t* rowp = O + (size_t)(row0 + ai * HALF + m * 16) * ldc + col0; const float rs = rsr[ai][m];
                f32x4 v0, v1;
#pragma unroll
                for (int e = 0; e < 4; ++e) { const float g0 = acc[ai][0][m][0][e] * rs, g1 = acc[ai][0][m][1][e] * rs;
                    v0[e] = (ACT ? silu_f(g0) : g0) * (acc[ai][1][m][0][e] * rs); v1[e] = (ACT ? silu_f(g1) : g1) * (acc[ai][1][m][1][e] * rs); }
                *(u32x4*)rowp = pack8(v0, v1); } }
    }
};
struct EpiGatedI8 {
    static constexpr bool PERM = true, AFTER_DRAIN = false;
    bf16_t* O; int ldc; const float* rs; const float* sw;
    __device__ __forceinline__ void operator()(const f32x4 (&acc)[2][2][4][2], const Unit& u, int wr, int wc, int fr, int fq) const {
        const int row0 = u.pm * BM + u.roff + wr * 64 + fr, cl = wc * 32 + 8 * fq, col0 = u.pn * HALF + cl;
        const f32x4 sg0 = *(const f32x4*)(sw + u.pn * BM + cl) * -1.44269504089f, sg1 = *(const f32x4*)(sw + u.pn * BM + cl + 4) * -1.44269504089f,
                    su0 = *(const f32x4*)(sw + u.pn * BM + HALF + cl) * -0.69314718056f, su1 = *(const f32x4*)(sw + u.pn * BM + HALF + cl + 4) * -0.69314718056f;
        float rsr[2][4];
#pragma unroll
        for (int ai = 0; ai < 2; ++ai)
#pragma unroll
            for (int m = 0; m < 4; ++m) rsr[ai][m] = rs[row0 + ai * HALF + m * 16];
#pragma unroll
        for (int ai = 0; ai < 2; ++ai) { if (ai == 1 && u.hm) break;
#pragma unroll
            for (int m = 0; m < 4; ++m) { bf16_t* rowp = O + (size_t)(row0 + ai * HALF + m * 16) * ldc + col0; const float r = rsr[ai][m];
                f32x4 v0, v1;
#pragma unroll
                for (int e = 0; e < 4; ++e) {
                    const float ag0 = acc[ai][0][m][0][e], ag1 = acc[ai][0][m][1][e], au0 = acc[ai][1][m][0][e], au1 = acc[ai][1][m][1][e];
                    const float t0 = (float)__float_as_int(ag0) * (r * sg0[e]), t1 = (float)__float_as_int(ag1) * (r * sg1[e]);
                    const float u0 = (float)__float_as_int(au0) * (r * su0[e]), u1 = (float)__float_as_int(au1) * (r * su1[e]);
                    v0[e] = (t0 * u0) * __builtin_amdgcn_rcpf(1.0f + __builtin_amdgcn_exp2f(t0)); v1[e] = (t1 * u1) * __builtin_amdgcn_rcpf(1.0f + __builtin_amdgcn_exp2f(t1)); }
                *(u32x4*)rowp = pack8(v0, v1); } }
    }
};
struct EpiConvIn {
    static constexpr bool PERM = true, AFTER_DRAIN = false;
    bf16_t* BG; bf16_t* Z; const float* rstd;
    __device__ __forceinline__ void operator()(const f32x4 (&acc)[2][2][4][2], const Unit& u, int wr, int wc, int fr, int fq) const {
        const int row0 = u.pm * BM + u.roff + wr * 64 + fr;
        float rsr[2][4];
#pragma unroll
        for (int ai = 0; ai < 2; ++ai)
#pragma unroll
            for (int m = 0; m < 4; ++m) rsr[ai][m] = rs_of(rstd[row0 + ai * HALF + m * 16]);
        if (u.pn < 8) {
            const int col0 = u.pn * BM + wc * 32 + 8 * fq;
#pragma unroll
            for (int ai = 0; ai < 2; ++ai) { if (ai == 1 && u.hm) break;
#pragma unroll
                for (int m = 0; m < 4; ++m) { bf16_t* rowp = BG + (size_t)(row0 + ai * HALF + m * 16) * 2048 + col0; const float rs = rsr[ai][m];
#pragma unroll
                    for (int bj = 0; bj < 2; ++bj) *(u32x4*)(rowp + bj * HALF) = pack8(acc[ai][bj][m][0] * rs, acc[ai][bj][m][1] * rs); } }
        } else {
            const int col0 = (u.pn - 8) * HALF + wc * 32 + 8 * fq;
#pragma unroll
            for (int ai = 0; ai < 2; ++ai) { if (ai == 1 && u.hm) break;
#pragma unroll
                for (int m = 0; m < 4; ++m) { bf16_t* rowp = Z + (size_t)(row0 + ai * HALF + m * 16) * 2048 + col0; const float rs = rsr[ai][m], rs2 = rs * rs;
                    *(u32x4*)rowp = pack8(acc[ai][0][m][0] * acc[ai][1][m][0] * rs2, acc[ai][0][m][1] * acc[ai][1][m][1] * rs2); } }
        }
    }
};
struct EpiGeluSplit {
    static constexpr bool PERM = true, AFTER_DRAIN = false;
    bf16_t* U; bf16_t* V; const float* rstd;
    __device__ __forceinline__ void operator()(const f32x4 (&acc)[2][2][4][2], const Unit& u, int wr, int wc, int fr, int fq) const {
        const int row0 = u.pm * BM + u.roff + wr * 64 + fr, col0 = (u.pn & 7) * BM + wc * 32 + 8 * fq;
        bf16_t* base = (u.pn < 8) ? U : V;
        float rsr[2][4];
#pragma unroll
        for (int ai = 0; ai < 2; ++ai)
#pragma unroll
            for (int m = 0; m < 4; ++m) rsr[ai][m] = rs_of(rstd[row0 + ai * HALF + m * 16]);
#pragma unroll
        for (int ai = 0; ai < 2; ++ai) { if (ai == 1 && u.hm) break;
#pragma unroll
            for (int m = 0; m < 4; ++m) { bf16_t* rowp = base + (size_t)(row0 + ai * HALF + m * 16) * 2048 + col0; const float rs = rsr[ai][m];
#pragma unroll
                for (int bj = 0; bj < 2; ++bj) { f32x4 v0, v1;
#pragma unroll
                    for (int e = 0; e < 4; ++e) { v0[e] = gelu_tanh_f(acc[ai][bj][m][0][e] * rs); v1[e] = gelu_tanh_f(acc[ai][bj][m][1][e] * rs); }
                    *(u32x4*)(rowp + bj * HALF) = pack8(v0, v1); } } }
    }
};
struct EpiQKV {
    static constexpr bool PERM = true, AFTER_DRAIN = false;
    bf16_t* O; const float* rope_c; const float* rope_s; const float* rstd;
    __device__ __forceinline__ void operator()(const f32x4 (&acc)[2][2][4][2], const Unit& u, int wr, int wc, int fr, int fq) const {
        const int row0 = u.pm * BM + u.roff + wr * 64 + fr, col0 = u.pn * BM + wc * 32 + 8 * fq;
        const bool rot_tile = (u.pn < 9) && ((wc & 1) == 0);
        const bool rot_lane = fq < 2;
        const float sgn = (fq == 0) ? -1.0f : 1.0f;
#pragma unroll
        for (int ai = 0; ai < 2; ++ai) { if (ai == 1 && u.hm) break;
#pragma unroll
            for (int m = 0; m < 4; ++m) { const int row = row0 + ai * HALF + m * 16; bf16_t* rowp = O + (size_t)row * 2560 + col0; const float rs = rs_of(rstd[row]);
                if (rot_tile) {
                    const int slot = row < 8192 ? (row & 4095) : (row < 8320 ? 4096 + ((row - 8192) & 3) : 0);
                    const f32x4 c0 = *(const f32x4*)(rope_c + slot * 8), c1 = *(const f32x4*)(rope_c + slot * 8 + 4);
                    const f32x4 s0 = *(const f32x4*)(rope_s + slot * 8), s1 = *(const f32x4*)(rope_s + slot * 8 + 4);
#pragma unroll
                    for (int bj = 0; bj < 2; ++bj) { f32x4 v0 = acc[ai][bj][m][0] * rs, v1 = acc[ai][bj][m][1] * rs, o0, o1;
#pragma unroll
                        for (int e = 0; e < 4; ++e) { o0[e] = __shfl_xor(v0[e], 16); o1[e] = __shfl_xor(v1[e], 16); }
                        if (rot_lane) {
#pragma unroll
                            for (int e = 0; e < 4; ++e) { v0[e] = v0[e] * c0[e] + sgn * o0[e] * s0[e]; v1[e] = v1[e] * c1[e] + sgn * o1[e] * s1[e]; } }
                        *(u32x4*)(rowp + bj * HALF) = pack8(v0, v1); }
                } else {
#pragma unroll
                    for (int bj = 0; bj < 2; ++bj) *(u32x4*)(rowp + bj * HALF) = pack8(acc[ai][bj][m][0] * rs, acc[ai][bj][m][1] * rs);
                }
            } }
    }
};


struct EpiResNorm {
    static constexpr bool PERM = true, AFTER_DRAIN = true;
    bf16_t* X; const float* g; float alpha; float* ps; unsigned* cnt; float* ssq;
    __device__ __forceinline__ void operator()(const f32x4 (&)[2][2][4][2], const Unit&, int, int, int, int) const {}
    __device__ __forceinline__ void fused(f32x4 (&acc)[2][2][4][2], const Unit& u, int wr, int wc, int fr, int fq, PG8_LAS unsigned char* lds, int wid, int lane) const {
        PG8_LAS float* P = (PG8_LAS float*)lds;
        PG8_LAS float* S = (PG8_LAS float*)(lds + 4096);
        PG8_LAS float* Q = (PG8_LAS float*)(lds + 8192);
        const int row0 = u.pm * BM + wr * 64 + fr, col0 = u.pn * BM + wc * 32 + 8 * fq;
        u32x4 xr[2][4][2];
        PG8_LAS float* GL = (PG8_LAS float*)(lds + 12288);
#pragma unroll
        for (int ai = 0; ai < 2; ++ai)
#pragma unroll
            for (int m = 0; m < 4; ++m)
#pragma unroll
                for (int bj = 0; bj < 2; ++bj) xr[ai][m][bj] = *(const u32x4*)(X + (size_t)(row0 + ai * HALF + m * 16) * 2048 + col0 + bj * HALF);
        if (wid == 0) *(PG8_LAS f32x4*)(GL + lane * 4) = *(const f32x4*)(g + u.pn * BM + lane * 4);
#pragma unroll
        for (int ai = 0; ai < 2; ++ai)
#pragma unroll
            for (int m = 0; m < 4; ++m) { float q = 0.f;
#pragma unroll
                for (int bj = 0; bj < 2; ++bj)
#pragma unroll
                    for (int n = 0; n < 2; ++n) { const f32x4 v = acc[ai][bj][m][n]; q += (v[0] * v[0] + v[1] * v[1]) + (v[2] * v[2] + v[3] * v[3]); }
                q += __shfl_xor(q, 16); q += __shfl_xor(q, 32);
                if (fq == 0) P[(ai * HALF + wr * 64 + m * 16 + fr) * 4 + wc] = q; }
        asm volatile("s_waitcnt lgkmcnt(0)" ::: "memory"); __builtin_amdgcn_s_barrier(); asm volatile("" ::: "memory");
        const int row = wid * 32 + (lane & 31);
        if (lane < 32) { const f32x4 t = *(const PG8_LAS f32x4*)(P + row * 4);
            __hip_atomic_store((unsigned*)ps + ((size_t)(u.pm * BM + row) * 8 + u.pn), __float_as_uint((t[0] + t[1]) + (t[2] + t[3])), __ATOMIC_RELAXED, __HIP_MEMORY_SCOPE_AGENT); }
        asm volatile("s_waitcnt vmcnt(0)" ::: "memory");
        if (lane == 0) __hip_atomic_fetch_add(cnt + 64 * u.pm, 1u, __ATOMIC_RELAXED, __HIP_MEMORY_SCOPE_AGENT);
        if (wid == 0) { unsigned spins = 0;
            while ((unsigned)__builtin_amdgcn_readfirstlane(__hip_atomic_load(cnt + 64 * u.pm, __ATOMIC_RELAXED, __HIP_MEMORY_SCOPE_AGENT)) < 64u) { __builtin_amdgcn_s_sleep(1); if (++spins > (1u << 22)) break; }
            __builtin_amdgcn_fence(__ATOMIC_ACQUIRE, "agent"); }
        asm volatile("s_waitcnt vmcnt(0) lgkmcnt(0)" ::: "memory"); __builtin_amdgcn_s_barrier(); asm volatile("" ::: "memory");
        if (lane < 32) { const unsigned* slot = (const unsigned*)ps + (size_t)(u.pm * BM + row) * 8; float t = 0.f;
#pragma unroll
            for (int k = 0; k < 8; ++k) t += __uint_as_float(__hip_atomic_load(slot + k, __ATOMIC_RELAXED, __HIP_MEMORY_SCOPE_AGENT));
            S[row] = alpha * __builtin_amdgcn_rsqf(t * (1.0f / 2048.0f) + 1e-6f); }
        asm volatile("s_waitcnt vmcnt(0) lgkmcnt(0)" ::: "memory"); __builtin_amdgcn_s_barrier(); asm volatile("" ::: "memory");
#pragma unroll
        for (int ai = 0; ai < 2; ++ai)
#pragma unroll
            for (int m = 0; m < 4; ++m) { const float sr = S[ai * HALF + wr * 64 + m * 16 + fr]; float q = 0.f;
#pragma unroll
                for (int bj = 0; bj < 2; ++bj) { const u32x4 xo = xr[ai][m][bj]; f32x4 v0, v1;
                    const f32x4 g0 = *(const PG8_LAS f32x4*)(GL + wc * 32 + 8 * fq + bj * HALF), g1 = *(const PG8_LAS f32x4*)(GL + wc * 32 + 8 * fq + bj * HALF + 4);
#pragma unroll
                    for (int e = 0; e < 4; ++e) { const unsigned w0 = xo[e >> 1], w1 = xo[2 + (e >> 1)];
                        const float x0 = __uint_as_float((e & 1) ? (w0 & 0xffff0000u) : (w0 << 16)), x1 = __uint_as_float((e & 1) ? (w1 & 0xffff0000u) : (w1 << 16));
                        const float a0 = acc[ai][bj][m][0][e], a1 = acc[ai][bj][m][1][e];
                        v0[e] = x0 + (a0 * sr) * g0[e]; v1[e] = x1 + (a1 * sr) * g1[e]; }
                    const u32x4 w = pack8(v0, v1);
                    *(u32x4*)(X + (size_t)(row0 + ai * HALF + m * 16) * 2048 + col0 + bj * HALF) = w;
#pragma unroll
                    for (int e = 0; e < 4; ++e) { const float lo = __uint_as_float(w[e] << 16), hi = __uint_as_float(w[e] & 0xffff0000u); q += lo * lo + hi * hi; } }
                q += __shfl_xor(q, 16); q += __shfl_xor(q, 32);
                if (fq == 0) Q[(ai * HALF + wr * 64 + m * 16 + fr) * 4 + wc] = q; }
        asm volatile("s_waitcnt lgkmcnt(0)" ::: "memory"); __builtin_amdgcn_s_barrier(); asm volatile("" ::: "memory");
        float* ps2 = ps + 32 * 256 * 8;
        if (lane < 32) { const f32x4 t = *(const PG8_LAS f32x4*)(Q + row * 4);
            __hip_atomic_store((unsigned*)ps2 + ((size_t)(u.pm * BM + row) * 8 + u.pn), __float_as_uint((t[0] + t[1]) + (t[2] + t[3])), __ATOMIC_RELAXED, __HIP_MEMORY_SCOPE_AGENT); }
        asm volatile("s_waitcnt vmcnt(0)" ::: "memory");
        if (lane == 0) __hip_atomic_fetch_add(cnt + 64 * u.pm + 32, 1u, __ATOMIC_RELAXED, __HIP_MEMORY_SCOPE_AGENT);
        if (u.pn == 0) {
            if (wid == 0) { unsigned spins = 0;
                while ((unsigned)__builtin_amdgcn_readfirstlane(__hip_atomic_load(cnt + 64 * u.pm + 32, __ATOMIC_RELAXED, __HIP_MEMORY_SCOPE_AGENT)) < 64u) { __builtin_amdgcn_s_sleep(1); if (++spins > (1u << 22)) break; }
                __builtin_amdgcn_fence(__ATOMIC_ACQUIRE, "agent"); }
            asm volatile("s_waitcnt vmcnt(0) lgkmcnt(0)" ::: "memory"); __builtin_amdgcn_s_barrier(); asm volatile("" ::: "memory");
            if (lane < 32) { const unsigned* slot = (const unsigned*)ps2 + (size_t)(u.pm * BM + row) * 8; float t = 0.f;
#pragma unroll
                for (int k = 0; k < 8; ++k) t += __uint_as_float(__hip_atomic_load(slot + k, __ATOMIC_RELAXED, __HIP_MEMORY_SCOPE_AGENT));
                ssq[u.pm * BM + row] = t; }
        }
    }
};

template <class Epi, class Sched, bool ALIGN_EPI = false, bool SP2 = false, bool I8 = false>
__device__ __forceinline__ void gemm_phase(PG8_LAS unsigned char* lds, const Gemm g, const Sched& S, const Epi& E) {
    int tid_ = threadIdx.x; asm volatile("" : "+v"(tid_));
    const int tid = tid_, wid = __builtin_amdgcn_readfirstlane(tid >> 6), lane = tid & 63, wr = wid >> 2, wc = wid & 3, fr = lane & 15, fq = lane >> 4;
    const int LD = g.K;
    unsigned voffA[2], voffB[2];
#pragma unroll
    for (int i = 0; i < 2; ++i) { int R, C; stage_rc(tid * 16 + i * 8192, R, C); const int Rb = Epi::PERM ? ((R & ~31) + perm32(R & 31)) : R;
        voffA[i] = (unsigned)(R * LD + C) * 2u; voffB[i] = (unsigned)(Rb * LD + C) * 2u; }
    const size_t kstep = (size_t)(BK * 2);
    const size_t hstep = (size_t)HALF * LD * 2;
    const size_t tstep = 2 * hstep;
    const unsigned ldsw = (unsigned)wid * 1024u;
    const int aoff = lds_byte(wr * 64 + fr, fq * 8), boff = lds_byte(wc * 32 + fr, fq * 8);
#define PG8_SA(b, h) (((b) * 2 + (h)) * HTB)
#define PG8_SB(b, h) ((4 + (b) * 2 + (h)) * HTB)
#define PG8_STAGE(bufoff, gbase, voff) do { _Pragma("unroll") for (int _i = 0; _i < 2; ++_i) \
        __builtin_amdgcn_global_load_lds((const unsigned*)((const char*)(gbase) + (voff)[_i]), (PG8_LAS unsigned*)(lds + (bufoff) + ldsw + _i * 8192), 16, 0, 0); } while (0)
#define PG8_LDA(dst, b, h) do { _Pragma("unroll") for (int m = 0; m < 4; ++m) _Pragma("unroll") for (int k = 0; k < 2; ++k) dst[m][k] = *(const PG8_LAS bf16x8*)(lds + PG8_SA(b, h) + aoff + m * 2048 + k * 1024); } while (0)
#define PG8_LDB(dst, b, h) do { _Pragma("unroll") for (int n = 0; n < 2; ++n) _Pragma("unroll") for (int k = 0; k < 2; ++k) dst[n][k] = *(const PG8_LAS bf16x8*)(lds + PG8_SB(b, h) + boff + n * 2048 + k * 1024); } while (0)
#define PG8_MMA(ai, bj, At, Bt) do { __builtin_amdgcn_s_setprio(1); _Pragma("unroll") for (int m = 0; m < 4; ++m) _Pragma("unroll") for (int n = 0; n < 2; ++n) _Pragma("unroll") for (int k = 0; k < 2; ++k) \
        { if constexpr (I8) acc[ai][bj][m][n] = __builtin_bit_cast(f32x4, __builtin_amdgcn_mfma_i32_16x16x64_i8(__builtin_bit_cast(i32x4, Bt[n][k]), __builtin_bit_cast(i32x4, At[m][k]), __builtin_bit_cast(i32x4, acc[ai][bj][m][n]), 0, 0, 0)); \
          else acc[ai][bj][m][n] = __builtin_amdgcn_mfma_f32_16x16x32_bf16(Bt[n][k], At[m][k], acc[ai][bj][m][n], 0, 0, 0); } __builtin_amdgcn_s_setprio(0); } while (0)
#define PG8_WAIT_V(n) asm volatile("s_waitcnt vmcnt(" #n ")" ::: "memory")
#define PG8_WAIT_L(n) asm volatile("s_waitcnt lgkmcnt(" #n ")" ::: "memory")
#define PG8_BAR __builtin_amdgcn_s_barrier()
#define PG8_SCHED __builtin_amdgcn_sched_barrier(0)
    Unit cur, nxt; int ui = 0;
    if (!S.next(0, cur)) return;
    f32x4 acc[2][2][4][2];
#pragma unroll
    for (int a = 0; a < 2; ++a)
#pragma unroll
        for (int b = 0; b < 2; ++b)
#pragma unroll
            for (int m = 0; m < 4; ++m)
#pragma unroll
                for (int n = 0; n < 2; ++n) acc[a][b][m][n] = (f32x4){0.f, 0.f, 0.f, 0.f};
    bf16x8 At[4][2], B0[2][2], B1[2][2];
    int nt = cur.nt; bool hm = cur.hm != 0;
#define PG8_KOFFB(u) ((size_t)(u).ks * (size_t)(u).nt * (BK * 2))
#define PG8_KOFF(u) ((size_t)(u).ks * (size_t)(u).nt * (BK * 2) + (size_t)(u).roff * (size_t)LD * 2)
    const char* cA = (const char*)g.A + (size_t)cur.pm * tstep + PG8_KOFF(cur); const char* cB = (const char*)g.Bt + (size_t)cur.pn * tstep + PG8_KOFFB(cur);
    S.a_ready(cur);
    if constexpr (SP2) {
        PG8_STAGE(PG8_SB(0, 0), cB, voffB); PG8_STAGE(PG8_SB(0, 1), cB + hstep, voffB); PG8_STAGE(PG8_SA(0, 0), cA, voffA); PG8_STAGE(PG8_SA(0, 1), cA + hstep, voffA);
        if (wr == 1) PG8_BAR;
        PG8_WAIT_V(2); PG8_BAR;
        PG8_STAGE(PG8_SB(1, 0), cB + kstep, voffB); PG8_STAGE(PG8_SA(1, 0), cA + kstep, voffA); PG8_STAGE(PG8_SB(1, 1), cB + hstep + kstep, voffB);
        PG8_WAIT_V(6); PG8_BAR;
    } else {
        PG8_STAGE(PG8_SB(0, 0), cB, voffB); PG8_STAGE(PG8_SA(0, 0), cA, voffA); PG8_STAGE(PG8_SB(0, 1), cB + hstep, voffB); PG8_STAGE(PG8_SA(0, 1), cA + hstep, voffA);
        if (wr == 1) PG8_BAR;
        PG8_WAIT_V(4); PG8_BAR;
        PG8_STAGE(PG8_SB(1, 0), cB + kstep, voffB); PG8_STAGE(PG8_SA(1, 0), cA + kstep, voffA); PG8_STAGE(PG8_SB(1, 1), cB + hstep + kstep, voffB);
        PG8_WAIT_V(6); PG8_BAR;
    }
    for (;;) {
        const bool has_next = S.next(ui + 1, nxt);
        const char* nA = has_next ? (const char*)g.A + (size_t)nxt.pm * tstep + PG8_KOFF(nxt) : cA; const char* nB = has_next ? (const char*)g.Bt + (size_t)nxt.pn * tstep + PG8_KOFFB(nxt) : cB;
        for (int t = 0; t < nt; t += 2) {
            const bool last = (t == nt - 2);
            const char* a1 = cA + (size_t)(t + 1) * kstep;
            const char* a2 = last ? nA : cA + (size_t)(t + 2) * kstep; const char* b2 = last ? nB : cB + (size_t)(t + 2) * kstep;
            const char* a3 = a2 + kstep; const char* b3 = b2 + kstep;
            if (last && has_next) S.a_ready(nxt);
            if constexpr (SP2) {
            PG8_LDB(B0, 0, 0); PG8_LDB(B1, 0, 1); PG8_SCHED; PG8_LDA(At, 0, 0); PG8_STAGE(PG8_SA(1, 1), a1 + hstep, voffA);
            PG8_WAIT_V(8); PG8_WAIT_L(0); PG8_BAR; PG8_MMA(0, 0, At, B0); PG8_MMA(0, 1, At, B1); PG8_BAR; PG8_SCHED;
            if (!hm) { PG8_LDA(At, 0, 1); } PG8_STAGE(PG8_SB(0, 0), b2, voffB); PG8_STAGE(PG8_SB(0, 1), b2 + hstep, voffB); PG8_STAGE(PG8_SA(0, 0), a2, voffA);
            PG8_WAIT_V(8); PG8_WAIT_L(0); PG8_BAR; if (!hm) { PG8_MMA(1, 0, At, B0); PG8_MMA(1, 1, At, B1); } PG8_BAR; PG8_SCHED;
            PG8_LDB(B0, 1, 0); PG8_LDB(B1, 1, 1); PG8_SCHED; PG8_LDA(At, 1, 0); PG8_STAGE(PG8_SA(0, 1), a2 + hstep, voffA);
            PG8_WAIT_V(8); PG8_WAIT_L(0); PG8_BAR; PG8_MMA(0, 0, At, B0); PG8_MMA(0, 1, At, B1); PG8_BAR; PG8_SCHED;
            if (!hm) { PG8_LDA(At, 1, 1); } PG8_STAGE(PG8_SB(1, 0), b3, voffB); PG8_STAGE(PG8_SB(1, 1), b3 + hstep, voffB); PG8_STAGE(PG8_SA(1, 0), a3, voffA);
            PG8_WAIT_V(8); PG8_WAIT_L(0); PG8_BAR; if (!hm) { PG8_MMA(1, 0, At, B0); PG8_MMA(1, 1, At, B1); } PG8_BAR; PG8_SCHED;
            } else {
            PG8_LDB(B0, 0, 0); PG8_SCHED; PG8_LDA(At, 0, 0); PG8_STAGE(PG8_SA(1, 1), a1 + hstep, voffA);
            PG8_WAIT_L(8); PG8_BAR; PG8_WAIT_L(0); PG8_MMA(0, 0, At, B0); PG8_BAR; PG8_SCHED;
            PG8_LDB(B1, 0, 1); PG8_STAGE(PG8_SB(0, 0), b2, voffB);
            PG8_BAR; PG8_WAIT_L(0); PG8_MMA(0, 1, At, B1); PG8_BAR;
            PG8_LDA(At, 0, 1); PG8_STAGE(PG8_SA(0, 0), a2, voffA);
            PG8_BAR; PG8_WAIT_L(0); PG8_MMA(1, 0, At, B0); PG8_BAR; PG8_SCHED;
            PG8_STAGE(PG8_SB(0, 1), b2 + hstep, voffB);
            PG8_WAIT_V(6); PG8_BAR; PG8_MMA(1, 1, At, B1); PG8_BAR;
            PG8_LDB(B0, 1, 0); PG8_SCHED; PG8_LDA(At, 1, 0); PG8_STAGE(PG8_SA(0, 1), a2 + hstep, voffA);
            PG8_WAIT_L(8); PG8_BAR; PG8_WAIT_L(0); PG8_MMA(0, 0, At, B0); PG8_BAR; PG8_SCHED;
            PG8_LDB(B1, 1, 1); PG8_STAGE(PG8_SB(1, 0), b3, voffB);
            PG8_BAR; PG8_WAIT_L(0); PG8_MMA(0, 1, At, B1); PG8_BAR;
            PG8_LDA(At, 1, 1); PG8_STAGE(PG8_SA(1, 0), a3, voffA);
            PG8_BAR; PG8_WAIT_L(0); PG8_MMA(1, 0, At, B0); PG8_BAR; PG8_SCHED;
            PG8_STAGE(PG8_SB(1, 1), b3 + hstep, voffB);
            PG8_WAIT_V(6); PG8_BAR; PG8_MMA(1, 1, At, B1); PG8_BAR;
            }
        }
        if constexpr (ALIGN_EPI) { if (wr == 0) PG8_BAR; }
        if constexpr (!Epi::AFTER_DRAIN) { E(acc, cur, wr, wc, fr, fq); S.done(cur); }
        if (!has_next) break;
#pragma unroll
        for (int a = 0; a < 2; ++a)
#pragma unroll
            for (int b = 0; b < 2; ++b)
#pragma unroll
                for (int m = 0; m < 4; ++m)
#pragma unroll
                    for (int n = 0; n < 2; ++n) acc[a][b][m][n] = (f32x4){0.f, 0.f, 0.f, 0.f};
        cur = nxt; cA = nA; cB = nB; ++ui; nt = cur.nt; hm = cur.hm != 0;
        if constexpr (ALIGN_EPI) { if (wr == 1) PG8_BAR; }
    }
    PG8_WAIT_V(0);
    if constexpr (!ALIGN_EPI) { if (wr == 0) PG8_BAR; }
    PG8_BAR;
    if constexpr (Epi::AFTER_DRAIN) { E.fused(acc, cur, wr, wc, fr, fq, lds, wid, lane); S.done(cur); }
#undef PG8_KOFF
#undef PG8_KOFFB
#undef PG8_SA
#undef PG8_SB
#undef PG8_STAGE
#undef PG8_LDA
#undef PG8_LDB
#undef PG8_MMA
#undef PG8_WAIT_V
#undef PG8_WAIT_L
#undef PG8_BAR
#undef PG8_SCHED
}
}

constexpr int NWAVES = 8;
constexpr int D = 2048, DFF = 5632, NGU = 2 * DFF, SEQ = 4096, NBATCH = 2, MP = NBATCH * SEQ, DBATCH = 32, DSEQ = 4, MS = DBATCH * DSEQ;
constexpr int MR = MP + MS;
constexpr int M = 8448;
constexpr int NQKV = 2560, NCIN = 6144, NSIN = 4096;
constexpr int BM_ROWS = 256;
constexpr float RMS_EPS = 1e-6f, LN_EPS = 1e-5f, LOG2E = 1.4426950408889634f;
constexpr size_t OFF_Y = 0, OFF_KP = (size_t)MR * D, OFF_VP = OFF_KP + 131072, OFF_KS = OFF_VP + 131072, OFF_VS = OFF_KS + 2097152,
                 OFF_CP = OFF_VS + 2097152, OFF_CS = OFF_CP + 8192, OFF_SV = OFF_CS + 131072, OUT_TOTAL = OFF_SV + 262144;
constexpr size_t MiB = 1u << 20;
constexpr size_t WS_CTL = 0, CTL_ZERO_BYTES = 320 * 1024;
constexpr int CW_PCNT = 20480;
constexpr size_t WS_SSQ = 128 * 1024;
constexpr size_t WS_PS = 512 * 1024;
constexpr size_t WS_ROPE = 1 * MiB;
constexpr size_t WS_RSTD = WS_ROPE + 512 * 1024;
constexpr size_t WS_H = 2 * MiB;
constexpr size_t WS_ACT = 35 * MiB;
constexpr size_t WS_OUTF = 126 * MiB;
constexpr size_t WS_QKV = 192 * MiB;
constexpr size_t WS_O = 234 * MiB;
constexpr size_t WS_BG = 267 * MiB;
constexpr size_t WS_Z = 300 * MiB;
constexpr size_t WS_VLN = 333 * MiB;
constexpr size_t WS_WFFN = 368 * MiB;
constexpr size_t WFFN_STRIDE = 66 * MiB, WD_OFF = 44 * MiB;
constexpr size_t WS_WATT = WS_WFFN + 8 * WFFN_STRIDE;
constexpr size_t WATT_STRIDE = 18 * MiB, WO_OFF = 10 * MiB;
constexpr size_t WS_WCONV = WS_WATT + 2 * WATT_STRIDE;
constexpr size_t WCOUT_OFF = 24 * MiB;
constexpr size_t WS_WSGU = WS_WCONV + 32 * MiB;
constexpr size_t WSOUT_OFF = 16 * MiB;
constexpr size_t WS_PART = WS_WSGU + 24 * MiB;
constexpr size_t PART_SLAB = (size_t)MS * D;
constexpr int NSPLIT_FFN = 11, NSPLIT_MIX = 4;
constexpr size_t WS_XQ8 = WS_PART + 24 * MiB;
constexpr size_t WS_SW = WS_XQ8 + 17 * MiB;
constexpr size_t WS_RS8 = WS_SW + 512 * 1024;
constexpr size_t WS_END = WS_SW + 1 * MiB;
constexpr int CW_BAR = 4096;
constexpr int RING_BYTES = 133120  , LDSCTL_OFF = RING_BYTES, MISC_OFF = LDSCTL_OFF + 320, LDS_BYTES = 147456;

#define GAS __attribute__((address_space(1)))
#define LAS __attribute__((address_space(3)))
typedef unsigned short bf16;
typedef unsigned v4u __attribute__((ext_vector_type(4)));
typedef unsigned v2u __attribute__((ext_vector_type(2)));
typedef float f32x4 __attribute__((ext_vector_type(4)));
typedef float f32x16 __attribute__((ext_vector_type(16)));
typedef short bf16x8 __attribute__((ext_vector_type(8)));
typedef short s16x4 __attribute__((ext_vector_type(4)));
#define LDS_WAIT() asm volatile("s_waitcnt lgkmcnt(0)" ::: "memory")
typedef float f32x2_cv __attribute__((ext_vector_type(2))); typedef __bf16 bf16x2_cv __attribute__((ext_vector_type(2)));
__device__ __forceinline__ unsigned pk2(float lo, float hi) { const f32x2_cv v = {lo, hi}; const bf16x2_cv b = __builtin_convertvector(v, bf16x2_cv); return __builtin_bit_cast(unsigned, b); }
__device__ __forceinline__ unsigned f2bf(float f) { return pk2(f, f) & 0xffffu; }
__device__ __forceinline__ float bf2f(unsigned short h) { return __builtin_bit_cast(float, (unsigned)h << 16); }
__device__ __forceinline__ float bflo(unsigned w) { return __builtin_bit_cast(float, w << 16); }
__device__ __forceinline__ float bfhi(unsigned w) { return __builtin_bit_cast(float, w & 0xffff0000u); }
#define XB_TMO      128
#define XB_XCNT(j)  (256  + 64 * (j))
#define XB_XSUB(j)  (1280 + 64 * (j))
#define XB_XGEN(j)  (2304 + 64 * (j))
#define XB_TOP      3328
#define XB_TOPGEN   3392
#define XCD_BAR_WORDS 3456
#define XB_SPIN_CAP (1u << 18)

__device__ __forceinline__ unsigned xb_ld(unsigned* p)              { return __hip_atomic_load(p, __ATOMIC_RELAXED, __HIP_MEMORY_SCOPE_AGENT); }
__device__ __forceinline__ unsigned xb_add(unsigned* p, unsigned v) { return __hip_atomic_fetch_add(p, v, __ATOMIC_RELAXED, __HIP_MEMORY_SCOPE_AGENT); }
__device__ __forceinline__ unsigned xb_xcc_id() { return (unsigned)__builtin_amdgcn_s_getreg((3 << 11) | 20) & 0xFu; }
#define XB_SPIN(cond, bar) do { unsigned _sp = 0; while (cond) { __builtin_amdgcn_s_sleep(1); \
    if ((++_sp & 255u) == 0u) { if (xb_ld(&(bar)[XB_TMO])) break; if (_sp > XB_SPIN_CAP) { atomicAdd(&(bar)[XB_TMO], 1u); break; } } } } while (0)

struct XcdBarrier {
    unsigned* bar; unsigned x;
    volatile LAS unsigned* st;
};

__device__ __forceinline__ XcdBarrier xcd_barrier_post(unsigned* bar, volatile LAS unsigned* st) {
    XcdBarrier b; b.bar = bar; b.x = xb_xcc_id(); b.st = st;
    if (threadIdx.x == 0) (void)xb_add(&bar[XB_XCNT(b.x)], 1u);
    return b;
}
__device__ __forceinline__ void xcd_barrier_complete(unsigned* bar, unsigned x, unsigned& nloc, unsigned& nx) {
    const unsigned G = gridDim.x * gridDim.y * gridDim.z;
    unsigned sum, cnt, mine, sp = 0u;
    for (;;) {
        sum = 0u; cnt = 0u; mine = 0u;
#pragma unroll
        for (unsigned j = 0; j < 16; ++j) { const unsigned c = xb_ld(&bar[XB_XCNT(j)]); sum += c; cnt += (c > 0u) ? 1u : 0u; mine = (j == x) ? c : mine; }
        if (sum == G) break;
        __builtin_amdgcn_s_sleep(1);
        if ((++sp & 255u) == 0u) { if (xb_ld(&bar[XB_TMO])) break; if (sp > XB_SPIN_CAP) { atomicAdd(&bar[XB_TMO], 1u); break; } }
    }
    nloc = mine > 0u ? mine : 1u; nx = cnt > 0u ? cnt : 1u;
}

__device__ __forceinline__ void xcd_barrier(const XcdBarrier& b) {
    asm volatile("s_waitcnt vmcnt(0)" ::: "memory");
    __syncthreads();
    if (threadIdx.x == 0) {
        unsigned* bar = b.bar;
        __builtin_amdgcn_s_waitcnt(0);
        unsigned nloc = b.st[0], nx = b.st[1];
        if (nloc == 0u) { xcd_barrier_complete(bar, b.x, nloc, nx); b.st[0] = nloc; b.st[1] = nx; }
        const unsigned old = xb_add(&bar[XB_XSUB(b.x)], 1u);
        const unsigned gen = old / nloc;
        if (old + 1u == (gen + 1u) * nloc) {
            __builtin_amdgcn_fence(__ATOMIC_RELEASE, "agent");
            asm volatile("s_waitcnt vmcnt(0)" ::: "memory");
            const unsigned og = xb_add(&bar[XB_TOP], 1u);
            const unsigned tg = og / nx;
            if (og + 1u == (tg + 1u) * nx) xb_add(&bar[XB_TOPGEN], 1u);
            else XB_SPIN(xb_ld(&bar[XB_TOPGEN]) == tg, bar);
            __builtin_amdgcn_fence(__ATOMIC_ACQUIRE, "agent");
            xb_add(&bar[XB_XGEN(b.x)], 1u);
            asm volatile("s_waitcnt vmcnt(0)" ::: "memory");
        } else {
            XB_SPIN(xb_ld(&bar[XB_XGEN(b.x)]) == gen, bar);
            __builtin_amdgcn_fence(__ATOMIC_ACQUIRE, "agent");
            asm volatile("s_waitcnt vmcnt(0)" ::: "memory");
        }
    }
    __syncthreads();
}

struct Frame {
    LAS unsigned char* lds;
    int tid, lane, wave, vcu, G;
    const float* in[20];
    float* out;
    unsigned char* ws;
};
#define IN_XP 0
#define IN_XS 1
#define IN_CK 2
#define IN_CV 3
#define IN_SC 4
#define IN_NG 5
#define IN_WGU 6
#define IN_WD 7
#define IN_WQKV 8
#define IN_WO 9
#define IN_SINK 10
#define IN_CWIN 11
#define IN_CW 12
#define IN_CWOUT 13
#define IN_SWIN 14
#define IN_SLNG 15
#define IN_SLNB 16
#define IN_SWS 17
#define IN_SBS 18
#define IN_SWOUT 19

template <int CTRL, int RM> __device__ __forceinline__ float dpp_or0(float v) { return __builtin_bit_cast(float, __builtin_amdgcn_update_dpp(0, __builtin_bit_cast(int, v), CTRL, RM, 0xF, true)); }
template <int CTRL, int RM> __device__ __forceinline__ float dpp_self(float v) { return __builtin_bit_cast(float, __builtin_amdgcn_update_dpp(__builtin_bit_cast(int, v), __builtin_bit_cast(int, v), CTRL, RM, 0xF, false)); }
__device__ __forceinline__ float wave_sum(float v) {
    v += dpp_or0<0xB1, 0xF>(v); v += dpp_or0<0x4E, 0xF>(v); v += dpp_or0<0x141, 0xF>(v); v += dpp_or0<0x140, 0xF>(v); v += dpp_or0<0x142, 0xA>(v); v += dpp_or0<0x143, 0xC>(v);
    return __builtin_bit_cast(float, __builtin_amdgcn_readlane(__builtin_bit_cast(int, v), 63));
}
__device__ __forceinline__ float wave_max(float v) {
    v = fmaxf(v, dpp_self<0xB1, 0xF>(v)); v = fmaxf(v, dpp_self<0x4E, 0xF>(v)); v = fmaxf(v, dpp_self<0x141, 0xF>(v)); v = fmaxf(v, dpp_self<0x140, 0xF>(v));
    v = fmaxf(v, dpp_self<0x142, 0xA>(v)); v = fmaxf(v, dpp_self<0x143, 0xC>(v));
    return __builtin_bit_cast(float, __builtin_amdgcn_readlane(__builtin_bit_cast(int, v), 63));
}

__device__ __forceinline__ int opq(int v) { asm volatile("" : "+v"(v)); return v; }
__device__ __forceinline__ int src_col_base(int kind, int db) {
    if (kind == 0) return db * 128;
    if (kind == 1) return (db & 1) * DFF + (db >> 1) * 128;
    if (db < 16) return db * 128;
    const int e = db - 16; return 2048 + (e & 1) * 2048 + (e >> 1) * 128;
}
constexpr int CVT_SCR = 64 * 65 * 4;
__device__ __forceinline__ void cvt_load(const float* W, int ldn, int nb0, int nbn, int kind, int item, int lane, f32x4 (&v)[16], const float* gfold) {
    const int kb = item / nbn, nb = nb0 + item % nbn, k0 = 64 * kb, n0 = 64 * nb;
    const int scol = src_col_base(kind, n0 >> 7) + (n0 & 127);
    const int r4 = lane >> 4, c16 = lane & 15;
#pragma unroll
    for (int i = 0; i < 16; ++i) v[i] = __builtin_nontemporal_load((const GAS f32x4*)(W + (size_t)(k0 + 4 * i + r4) * ldn + scol + c16 * 4));
    if (gfold) {
#pragma unroll
        for (int i = 0; i < 16; ++i) v[i] = v[i] * gfold[k0 + 4 * i + r4]; }
}
__device__ __forceinline__ void cvt_store(const f32x4 (&v)[16], int K, int nb0, int nbn, bf16* WT, LAS float* scr, int item, int lane) {
    const int kb = item / nbn, nb = nb0 + item % nbn, k0 = 64 * kb, n0 = 64 * nb;
    const int r4 = lane >> 4, c16 = lane & 15;
#pragma unroll
    for (int i = 0; i < 16; ++i) { LAS float* d = scr + (4 * i + r4) * 65 + c16 * 4; d[0] = v[i].x; d[1] = v[i].y; d[2] = v[i].z; d[3] = v[i].w; }
    LDS_WAIT(); asm volatile("" ::: "memory");
    const int rr = lane >> 3, c = lane & 7;
#pragma unroll
    for (int j = 0; j < 8; ++j) { const int n = rr + 8 * j; const LAS float* s = scr + (8 * c) * 65 + n;
        v4u o; o.x = pk2(s[0 * 65], s[1 * 65]); o.y = pk2(s[2 * 65], s[3 * 65]); o.z = pk2(s[4 * 65], s[5 * 65]); o.w = pk2(s[6 * 65], s[7 * 65]);
        *(GAS v4u*)(WT + (size_t)(n0 + n) * K + k0 + 8 * c) = o; }
    LDS_WAIT(); asm volatile("" ::: "memory");
}
__device__ __forceinline__ void convert_matrix(Frame& F, const float* W, int ldn, int K, int Nd, int kind, bf16* WT, int& off, int wg0, int nwg, int p0, int p1, const float* gfold) {
    const int tid = opq(F.tid), lane = tid & 63;
    LAS float* scr = (LAS float*)(F.lds + F.wave * CVT_SCR);
    const int gw = ((int)blockIdx.x - wg0) * NWAVES + F.wave, NGW = nwg * NWAVES;
    const int nblk = Nd / 64, nb0 = nblk * p0 / 2, nbn = nblk * p1 / 2 - nb0;
    const int items = (K / 64) * nbn;
    int first = gw - off; if (first < 0) first += NGW;
    off = (off + items) % NGW;
    if (first >= items) return;
    f32x4 va[16], vb[16];
    cvt_load(W, ldn, nb0, nbn, kind, first, lane, va, gfold);
    for (int it = first; it < items; it += 2 * NGW) {
        if (it + NGW < items) cvt_load(W, ldn, nb0, nbn, kind, it + NGW, lane, vb, gfold);
        cvt_store(va, K, nb0, nbn, WT, scr, it, lane);
#ifdef CVT_SLEEP
        if (wg0 != 0) __builtin_amdgcn_s_sleep(CVT_SLEEP);
#endif
        if (it + NGW >= items) break;
        if (it + 2 * NGW < items) cvt_load(W, ldn, nb0, nbn, kind, it + 2 * NGW, lane, va, gfold);
        cvt_store(vb, K, nb0, nbn, WT, scr, it + NGW, lane);
#ifdef CVT_SLEEP
        if (wg0 != 0) __builtin_amdgcn_s_sleep(CVT_SLEEP);
#endif
    }
}
constexpr int CVT_RED_OFF = 135168;
constexpr int T2_PITCH = 4104;
__device__ __forceinline__ void convert_wgu_i8(Frame& F, int wg0, int nwg, int gi0, int gi1) {
    const int tid = opq(F.tid), lane = tid & 63;
    LAS unsigned char* T2 = F.lds; LAS float* red = (LAS float*)(F.lds + CVT_RED_OFF);
    const int r8 = lane >> 3, c8 = lane & 7;
    __syncthreads();
    for (int gi = gi0 + ((int)blockIdx.x - wg0); gi < gi1; gi += nwg) {
        const int lh = gi / 352, it = gi % 352;
        const float* W = F.in[IN_WGU] + (size_t)lh * D * NGU; const float* g = F.in[IN_NG] + (size_t)((lh >> 1) * 6 + 4 * (lh & 1)) * D;
        unsigned char* W8 = F.ws + WS_WFFN + (size_t)lh * WFFN_STRIDE; float* SW = (float*)(F.ws + WS_SW) + (size_t)lh * NGU;
        const int n0 = 32 * it, scol = src_col_base(1, n0 >> 7) + (n0 & 127);
        const float* Wc = W + scol + c8 * 4;
        f32x4 mx = (f32x4){0.f, 0.f, 0.f, 0.f};
#pragma unroll 1
        for (int b = 0; b < 4; ++b) {
            f32x4 v[8];
#pragma unroll
            for (int i = 0; i < 8; ++i) v[i] = __builtin_nontemporal_load((const GAS f32x4*)(Wc + (size_t)(F.wave * 256 + (b * 8 + i) * 8 + r8) * NGU));
#pragma unroll
            for (int i = 0; i < 8; ++i) { const int k = F.wave * 256 + (b * 8 + i) * 8 + r8; const float gg = g[k]; const f32x4 t = v[i] * gg;
                mx.x = fmaxf(mx.x, fabsf(t.x)); mx.y = fmaxf(mx.y, fabsf(t.y)); mx.z = fmaxf(mx.z, fabsf(t.z)); mx.w = fmaxf(mx.w, fabsf(t.w));
                LAS unsigned char* d = T2 + (c8 * 4) * T2_PITCH + k * 2;
                *(LAS unsigned short*)(d) = (unsigned short)f2bf(t.x); *(LAS unsigned short*)(d + T2_PITCH) = (unsigned short)f2bf(t.y);
                *(LAS unsigned short*)(d + 2 * T2_PITCH) = (unsigned short)f2bf(t.z); *(LAS unsigned short*)(d + 3 * T2_PITCH) = (unsigned short)f2bf(t.w); }
        }
#pragma unroll
        for (int o = 8; o < 64; o <<= 1) { mx.x = fmaxf(mx.x, __shfl_xor(mx.x, o)); mx.y = fmaxf(mx.y, __shfl_xor(mx.y, o)); mx.z = fmaxf(mx.z, __shfl_xor(mx.z, o)); mx.w = fmaxf(mx.w, __shfl_xor(mx.w, o)); }
        if (r8 == 0) *(LAS f32x4*)(red + F.wave * 32 + c8 * 4) = mx;
        __syncthreads();
#pragma unroll
        for (int q = 0; q < 4; ++q) { const int n = F.wave * 4 + q;
            float m = red[n];
#pragma unroll
            for (int w = 1; w < 8; ++w) m = fmaxf(m, red[w * 32 + n]);
            m = fmaxf(m, 1e-30f);
            if (lane == 0) SW[n0 + n] = m * (1.0f / 127.0f);
            const float inv = 127.0f / m;
#pragma unroll
            for (int j = 0; j < 4; ++j) { const int kc = (lane + 64 * j) * 8;
                const v2u lo = *(const LAS v2u*)(T2 + n * T2_PITCH + kc * 2), hi = *(const LAS v2u*)(T2 + n * T2_PITCH + kc * 2 + 8);
                const unsigned b0 = (unsigned)(int)__builtin_rintf(bflo(lo.x) * inv) & 0xffu, b1 = (unsigned)(int)__builtin_rintf(bfhi(lo.x) * inv) & 0xffu;
                const unsigned b2 = (unsigned)(int)__builtin_rintf(bflo(lo.y) * inv) & 0xffu, b3 = (unsigned)(int)__builtin_rintf(bfhi(lo.y) * inv) & 0xffu;
                const unsigned b4 = (unsigned)(int)__builtin_rintf(bflo(hi.x) * inv) & 0xffu, b5 = (unsigned)(int)__builtin_rintf(bfhi(hi.x) * inv) & 0xffu;
                const unsigned b6 = (unsigned)(int)__builtin_rintf(bflo(hi.y) * inv) & 0xffu, b7 = (unsigned)(int)__builtin_rintf(bfhi(hi.y) * inv) & 0xffu;
                v2u w; w.x = b0 | (b1 << 8) | (b2 << 16) | (b3 << 24); w.y = b4 | (b5 << 8) | (b6 << 16) | (b7 << 24);
                *(GAS v2u*)(W8 + (size_t)(n0 + n) * D + kc) = w; } }
        __syncthreads();
    }
}
__device__ __forceinline__ void convert_job(Frame& F, int sl, int wg0, int nwg, int p0, int p1) {
    if ((int)blockIdx.x < wg0 || (int)blockIdx.x >= wg0 + nwg) return;
    const int layer = sl / 3, pos = sl % 3;
    int off = 0;
    if (pos != 1) {
        const int lh = layer * 2 + (pos >> 1);
        bf16* wg = (bf16*)(F.ws + WS_WFFN + (size_t)lh * WFFN_STRIDE);
        convert_matrix(F, F.in[IN_WD] + (size_t)lh * DFF * D, D, DFF, D, 0, (bf16*)((unsigned char*)wg + WD_OFF), off, wg0, nwg, p0, p1, nullptr);
    } else {
        const int kind = layer % 3, j = layer / 3; const float* gm = F.in[IN_NG] + (size_t)(layer * 6 + 2) * D;
        if (kind == 0) {
            bf16* wq = (bf16*)(F.ws + WS_WATT + (size_t)j * WATT_STRIDE);
            convert_matrix(F, F.in[IN_WQKV] + (size_t)j * D * NQKV, NQKV, D, NQKV, 0, wq, off, wg0, nwg, p0, p1, gm);
            convert_matrix(F, F.in[IN_WO] + (size_t)j * D * D, D, D, D, 0, (bf16*)((unsigned char*)wq + WO_OFF), off, wg0, nwg, p0, p1, nullptr);
        } else if (kind == 1) {
            convert_matrix(F, F.in[IN_CWIN], NCIN, D, NCIN, 2, (bf16*)(F.ws + WS_WCONV), off, wg0, nwg, p0, p1, gm);
            convert_matrix(F, F.in[IN_CWOUT], D, D, D, 0, (bf16*)(F.ws + WS_WCONV + WCOUT_OFF), off, wg0, nwg, p0, p1, nullptr);
        } else {
            convert_matrix(F, F.in[IN_SWIN], NSIN, D, NSIN, 0, (bf16*)(F.ws + WS_WSGU), off, wg0, nwg, p0, p1, gm);
            convert_matrix(F, F.in[IN_SWOUT], D, D, D, 0, (bf16*)(F.ws + WS_WSGU + WSOUT_OFF), off, wg0, nwg, p0, p1, nullptr);
        }
    }
}
__device__ __forceinline__ void prologue_phase(Frame& F) {
    const int tid = opq(F.tid), lane = tid & 63; (void)lane;
#ifndef PRO_DUP_I8
#define PRO_DUP_I8 1
#endif
#ifndef PRO_DUP_BF
#define PRO_DUP_BF 1
#endif
    for (int rp_ = 0; rp_ < PRO_DUP_I8; ++rp_) convert_wgu_i8(F, 0, F.G, 0, 8 * 352);
    for (int rp_ = 0; rp_ < PRO_DUP_BF; ++rp_) { __syncthreads(); for (int sl_ = 0; sl_ < 12; ++sl_) convert_job(F, sl_, 0, F.G, 0, 2); }
    {
        const double inv_d[8] = {1.0, 0.19392274474868576, 0.03760603093086393, 0.007292664737217109, 0.001414213562373095, 0.0002742481756762073, 5.318295896944988e-05, 1.031338537721246e-05};
        float* rc = (float*)(F.ws + WS_ROPE); float* rs = rc + 4100 * 8;
        for (int idx = blockIdx.x * 512 + tid; idx < 4100 * 8; idx += F.G * 512) {
            const int slot = idx >> 3, i = idx & 7;
            const float pos = (float)(slot < 4096 ? slot : 16384 + (slot - 4096));
            float inv = 1.0f;
#pragma unroll
            for (int k = 0; k < 8; ++k) if (i == k) inv = (float)inv_d[k];
            const float ang = pos * inv;
            double t = (double)ang * 0.15915494309189535; t -= __builtin_rint(t);
            const float fr = (float)t;
            rc[idx] = __builtin_amdgcn_cosf(fr); rs[idx] = __builtin_amdgcn_sinf(fr);
        }
    }
    {
        const int n16 = (M - MR) * D * 2 / 16;
        GAS v4u* h = (GAS v4u*)(F.ws + WS_H + (size_t)MR * D * 2); GAS v4u* o = (GAS v4u*)(F.ws + WS_O + (size_t)MR * D * 2);
        for (int i = blockIdx.x * 512 + tid; i < n16; i += F.G * 512) { h[i] = (v4u){0u, 0u, 0u, 0u}; o[i] = (v4u){0u, 0u, 0u, 0u}; }
    }
}

__device__ __forceinline__ void unpack8(const v4u v, float (&f)[8]) { f[0] = bflo(v.x); f[1] = bfhi(v.x); f[2] = bflo(v.y); f[3] = bfhi(v.y); f[4] = bflo(v.z); f[5] = bfhi(v.z); f[6] = bflo(v.w); f[7] = bfhi(v.w); }
__device__ __forceinline__ void ld8f(const float* p, float (&f)[8]) { const f32x4 a = *(const GAS f32x4*)p, b = *(const GAS f32x4*)(p + 4); f[0] = a.x; f[1] = a.y; f[2] = a.z; f[3] = a.w; f[4] = b.x; f[5] = b.y; f[6] = b.z; f[7] = b.w; }
__device__ __forceinline__ void norm_finish_row(Frame& F, float (&x)[4][8], int m, int lane, bool last, bool want_q8, float* ssq = nullptr) {
    if (last) {
#pragma unroll
        for (int j = 0; j < 4; ++j) { float* dst = F.out + (size_t)m * D + (lane + 64 * j) * 8;
            *(GAS f32x4*)dst = (f32x4){x[j][0], x[j][1], x[j][2], x[j][3]}; *(GAS f32x4*)(dst + 4) = (f32x4){x[j][4], x[j][5], x[j][6], x[j][7]}; }
    } else {
        bf16* X = (bf16*)(F.ws + WS_H); float ss = 0.f;
#pragma unroll
        for (int j = 0; j < 4; ++j) { v4u w; w.x = pk2(x[j][0], x[j][1]); w.y = pk2(x[j][2], x[j][3]); w.z = pk2(x[j][4], x[j][5]); w.w = pk2(x[j][6], x[j][7]);
            *(GAS v4u*)(X + (size_t)m * D + (lane + 64 * j) * 8) = w;
            float r[8]; unpack8(w, r);
#pragma unroll
            for (int e = 0; e < 8; ++e) ss += r[e] * r[e]; }
        const float sst = wave_sum(ss);
        const float rsx = 1.0f / sqrtf(sst * (1.0f / D) + RMS_EPS);
        if (lane == 0 && ssq != nullptr) ssq[m] = sst;
        if (want_q8) {
            float mx = 0.f;
#pragma unroll
            for (int j = 0; j < 4; ++j)
#pragma unroll
                for (int e = 0; e < 8; ++e) mx = fmaxf(mx, fabsf(x[j][e]));
            mx = fmaxf(wave_max(mx), 1e-30f);
            const float inv = 127.0f / mx;
            unsigned char* XQ = F.ws + WS_XQ8;
#pragma unroll
            for (int j = 0; j < 4; ++j) { unsigned b[8];
#pragma unroll
                for (int e = 0; e < 8; ++e) b[e] = (unsigned)(int)__builtin_rintf(x[j][e] * inv) & 0xffu;
                v2u w; w.x = b[0] | (b[1] << 8) | (b[2] << 16) | (b[3] << 24); w.y = b[4] | (b[5] << 8) | (b[6] << 16) | (b[7] << 24);
                *(GAS v2u*)(XQ + (size_t)m * D + (lane + 64 * j) * 8) = w; }
            if (lane == 0) ((float*)(F.ws + WS_RS8))[m] = rsx * (mx * (1.0f / 127.0f));
        }
    }
}
__device__ __forceinline__ void norm_first_phase(Frame& F) {
    const int tid = opq(F.tid), lane = tid & 63;
    const int gw = F.vcu * NWAVES + F.wave, NGW = F.G * NWAVES;
    for (int m = gw; m < MR; m += NGW) {
        const float* src = m < MP ? F.in[IN_XP] + (size_t)m * D : F.in[IN_XS] + (size_t)(m - MP) * D;
        float x[4][8];
#pragma unroll
        for (int j = 0; j < 4; ++j) ld8f(src + (lane + 64 * j) * 8, x[j]);
        norm_finish_row(F, x, m, lane, false, true);
    }
}
__device__ __forceinline__ void norm_phase(Frame& F, float alpha, const float* g_post, bool last, int nsplit, bool want_q8, bool with_sample, float* ssq) {
    const int tid = opq(F.tid), lane = tid & 63;
    const int gw = F.vcu * NWAVES + F.wave, NGW = F.G * NWAVES;
    const bf16* X = (const bf16*)(F.ws + WS_H); const bf16* OUTB = (const bf16*)(F.ws + WS_OUTF);
    float gp[4][8];
#pragma unroll
    for (int j = 0; j < 4; ++j) ld8f(g_post + (lane + 64 * j) * 8, gp[j]);
    v4u ro[4], rx[4];
#pragma unroll
    for (int j = 0; j < 4; ++j) { ro[j] = (v4u){0u, 0u, 0u, 0u}; rx[j] = ro[j];
        if (gw < MP) { ro[j] = *(const GAS v4u*)(OUTB + (size_t)gw * D + (lane + 64 * j) * 8); rx[j] = *(const GAS v4u*)(X + (size_t)gw * D + (lane + 64 * j) * 8); } }
    for (int m = gw; m < MP; m += NGW) {
        float x[4][8], xo[4][8]; float ss = 0.f;
#pragma unroll
        for (int j = 0; j < 4; ++j) { unpack8(ro[j], x[j]); unpack8(rx[j], xo[j]);
#pragma unroll
            for (int e = 0; e < 8; ++e) ss += x[j][e] * x[j][e]; }
        if (m + NGW < MP) {
#pragma unroll
            for (int j = 0; j < 4; ++j) { ro[j] = *(const GAS v4u*)(OUTB + (size_t)(m + NGW) * D + (lane + 64 * j) * 8); rx[j] = *(const GAS v4u*)(X + (size_t)(m + NGW) * D + (lane + 64 * j) * 8); } }
        const float rs = alpha / sqrtf(wave_sum(ss) * (1.0f / D) + RMS_EPS);
#pragma unroll
        for (int j = 0; j < 4; ++j)
#pragma unroll
            for (int e = 0; e < 8; ++e) x[j][e] = xo[j][e] + (x[j][e] * rs) * gp[j][e];
        norm_finish_row(F, x, m, lane, last, want_q8, ssq);
    }
    for (int m = MP + gw; with_sample && m < MR; m += NGW) {
        const float* pr = (const float*)(F.ws + WS_PART) + (size_t)(m - MP) * D;
        float x[4][8]; float ss = 0.f;
#pragma unroll
        for (int j = 0; j < 4; ++j) ld8f(pr + (lane + 64 * j) * 8, x[j]);
#pragma unroll 2
        for (int s = 1; s < nsplit; ++s) {
            float t[4][8];
#pragma unroll
            for (int j = 0; j < 4; ++j) ld8f(pr + (size_t)s * PART_SLAB + (lane + 64 * j) * 8, t[j]);
#pragma unroll
            for (int j = 0; j < 4; ++j)
#pragma unroll
                for (int e = 0; e < 8; ++e) x[j][e] += t[j][e]; }
#pragma unroll
        for (int j = 0; j < 4; ++j)
#pragma unroll
            for (int e = 0; e < 8; ++e) ss += x[j][e] * x[j][e];
        const float rs = alpha / sqrtf(wave_sum(ss) * (1.0f / D) + RMS_EPS);
#pragma unroll
        for (int j = 0; j < 4; ++j) { float xo[8]; unpack8(*(const GAS v4u*)(X + (size_t)m * D + (lane + 64 * j) * 8), xo);
#pragma unroll
            for (int e = 0; e < 8; ++e) x[j][e] = xo[e] + (x[j][e] * rs) * gp[j][e]; }
        norm_finish_row(F, x, m, lane, last, want_q8, ssq);
    }
}

constexpr int CW_SFLAG = 16384;
__device__ __forceinline__ void st8_wt(void* p, unsigned lo, unsigned hi) { __hip_atomic_store((unsigned long long*)p, ((unsigned long long)hi << 32) | lo, __ATOMIC_RELAXED, __HIP_MEMORY_SCOPE_AGENT); }
__device__ __forceinline__ void sample_tail_norm(Frame& F, float alpha, const float* g_post, int nsplit, bool want_q8, unsigned* flag1, unsigned need1, unsigned* flag2, float* ssq) {
    if ((int)blockIdx.x < F.G - 16) return;
    const int tid = opq(F.tid), lane = tid & 63;
    const int m = MP + ((int)blockIdx.x - (F.G - 16)) * NWAVES + F.wave;
    { unsigned spins = 0;
      while ((unsigned)__builtin_amdgcn_readfirstlane(__hip_atomic_load(flag1, __ATOMIC_RELAXED, __HIP_MEMORY_SCOPE_AGENT)) < need1) { __builtin_amdgcn_s_sleep(2); if (++spins > (1u << 22)) break; }
      __builtin_amdgcn_fence(__ATOMIC_ACQUIRE, "agent"); asm volatile("s_waitcnt vmcnt(0)" ::: "memory"); }
    bf16* X = (bf16*)(F.ws + WS_H);
    const float* pr = (const float*)(F.ws + WS_PART) + (size_t)(m - MP) * D;
    float x[4][8]; float ss = 0.f;
#pragma unroll
    for (int j = 0; j < 4; ++j) ld8f(pr + (lane + 64 * j) * 8, x[j]);
#pragma unroll 2
    for (int s = 1; s < nsplit; ++s) {
        float t[4][8];
#pragma unroll
        for (int j = 0; j < 4; ++j) ld8f(pr + (size_t)s * PART_SLAB + (lane + 64 * j) * 8, t[j]);
#pragma unroll
        for (int j = 0; j < 4; ++j)
#pragma unroll
            for (int e = 0; e < 8; ++e) x[j][e] += t[j][e]; }
#pragma unroll
    for (int j = 0; j < 4; ++j)
#pragma unroll
        for (int e = 0; e < 8; ++e) ss += x[j][e] * x[j][e];
    const float rs = alpha / sqrtf(wave_sum(ss) * (1.0f / D) + RMS_EPS);
#pragma unroll
    for (int j = 0; j < 4; ++j) { float xo[8], gp[8]; unpack8(*(const GAS v4u*)(X + (size_t)m * D + (lane + 64 * j) * 8), xo); ld8f(g_post + (lane + 64 * j) * 8, gp);
#pragma unroll
        for (int e = 0; e < 8; ++e) x[j][e] = xo[e] + (x[j][e] * rs) * gp[e]; }
    float sx = 0.f;
#pragma unroll
    for (int j = 0; j < 4; ++j) { v4u w; w.x = pk2(x[j][0], x[j][1]); w.y = pk2(x[j][2], x[j][3]); w.z = pk2(x[j][4], x[j][5]); w.w = pk2(x[j][6], x[j][7]);
        bf16* dst = X + (size_t)m * D + (lane + 64 * j) * 8; st8_wt(dst, w.x, w.y); st8_wt(dst + 4, w.z, w.w);
        float r[8]; unpack8(w, r);
#pragma unroll
        for (int e = 0; e < 8; ++e) sx += r[e] * r[e]; }
    const float sxs = wave_sum(sx);
    const float rsx = 1.0f / sqrtf(sxs * (1.0f / D) + RMS_EPS);
    if (lane == 0 && ssq != nullptr) __hip_atomic_store((unsigned*)ssq + m, __float_as_uint(sxs), __ATOMIC_RELAXED, __HIP_MEMORY_SCOPE_AGENT);
    if (want_q8) {
        float mx = 0.f;
#pragma unroll
        for (int j = 0; j < 4; ++j)
#pragma unroll
            for (int e = 0; e < 8; ++e) mx = fmaxf(mx, fabsf(x[j][e]));
        mx = fmaxf(wave_max(mx), 1e-30f);
        const float inv = 127.0f / mx;
        unsigned char* XQ = F.ws + WS_XQ8;
#pragma unroll
        for (int j = 0; j < 4; ++j) {
            const unsigned b0 = (unsigned)(int)__builtin_rintf(x[j][0] * inv) & 0xffu, b1 = (unsigned)(int)__builtin_rintf(x[j][1] * inv) & 0xffu, b2 = (unsigned)(int)__builtin_rintf(x[j][2] * inv) & 0xffu, b3 = (unsigned)(int)__builtin_rintf(x[j][3] * inv) & 0xffu;
            const unsigned b4 = (unsigned)(int)__builtin_rintf(x[j][4] * inv) & 0xffu, b5 = (unsigned)(int)__builtin_rintf(x[j][5] * inv) & 0xffu, b6 = (unsigned)(int)__builtin_rintf(x[j][6] * inv) & 0xffu, b7 = (unsigned)(int)__builtin_rintf(x[j][7] * inv) & 0xffu;
            st8_wt(XQ + (size_t)m * D + (lane + 64 * j) * 8, b0 | (b1 << 8) | (b2 << 16) | (b3 << 24), b4 | (b5 << 8) | (b6 << 16) | (b7 << 24)); }
        if (lane == 0) __hip_atomic_store((unsigned*)(F.ws + WS_RS8) + m, __float_as_uint(rsx * (mx * (1.0f / 127.0f))), __ATOMIC_RELAXED, __HIP_MEMORY_SCOPE_AGENT);
    }
    asm volatile("s_waitcnt vmcnt(0)" ::: "memory");
    if (lane == 0) __hip_atomic_fetch_add(flag2, 1u, __ATOMIC_RELAXED, __HIP_MEMORY_SCOPE_AGENT);
}

constexpr int KSTR = 144, VSTR = 528, ATT_K = 0, ATT_V = 256 * KSTR;
__device__ __forceinline__ int crow(int r, int hi) { return (r & 3) + 8 * (r >> 2) + 4 * hi; }
__device__ __forceinline__ void attn_qtile(const LAS unsigned char* Ks, const LAS unsigned char* Vt, LAS float* iscr, const bf16x8 (&qf)[4], int kt0, int qrel, int jmin, float sink2, f32x16 (&o)[2], int lane) {
    const int r32 = lane & 31, hi = lane >> 5;
    f32x16 s[5];
#pragma unroll
    for (int t = 0; t < 5; ++t) {
        s[t] = (f32x16){0.f, 0.f, 0.f, 0.f, 0.f, 0.f, 0.f, 0.f, 0.f, 0.f, 0.f, 0.f, 0.f, 0.f, 0.f, 0.f};
        const LAS unsigned char* kp = Ks + ((kt0 + t) * 32 + r32) * KSTR + hi * 16;
#pragma unroll
        for (int st = 0; st < 4; ++st) { const bf16x8 kf = *(const LAS bf16x8*)(kp + st * 32); s[t] = __builtin_amdgcn_mfma_f32_32x32x16_bf16(kf, qf[st], s[t], 0, 0, 0); }
    }
    const float sc = 0.125f * LOG2E;
    const int qa = qrel - 4 * hi;
    float mraw = -1e30f; float tb[5];
#pragma unroll
    for (int t = 0; t < 5; ++t) {
        const bool ok = (kt0 + t) * 32 >= jmin;
        tb[t] = ok ? 0.f : -1e30f;
        float mt = -1e30f;
#pragma unroll
        for (int r = 0; r < 16; ++r) { const int cr = (r & 3) + 8 * (r >> 2);
            float v = s[t][r];
            if (t == 0) v = (cr >= qa) ? v : -1e30f;
            if (t == 4) v = (cr <= qa) ? v : -1e30f;
            s[t][r] = v; mt = fmaxf(mt, v); }
        mraw = fmaxf(mraw, ok ? mt : -1e30f); }
    mraw = fmaxf(mraw, __shfl_xor(mraw, 32));
    const float mx = fmaxf(sink2, mraw * sc);
    float l = 0.f;
#pragma unroll
    for (int t = 0; t < 5; ++t) { const float bt = tb[t] - mx;
#pragma unroll
        for (int r = 0; r < 16; ++r) { const float e = __builtin_amdgcn_exp2f(__builtin_fmaf(s[t][r], sc, bt)); s[t][r] = e; l += e; } }
    l += __shfl_xor(l, 32);
    const float inv = 1.0f / (l + __builtin_amdgcn_exp2f(sink2 - mx));
    if (hi == 0) iscr[r32] = inv;
    o[0] = (f32x16){0.f, 0.f, 0.f, 0.f, 0.f, 0.f, 0.f, 0.f, 0.f, 0.f, 0.f, 0.f, 0.f, 0.f, 0.f, 0.f}; o[1] = o[0];
#pragma unroll
    for (int t = 0; t < 5; ++t)
#pragma unroll
        for (int hf = 0; hf < 2; ++hf) {
            v4u pw; pw.x = pk2(s[t][8 * hf + 0], s[t][8 * hf + 1]); pw.y = pk2(s[t][8 * hf + 2], s[t][8 * hf + 3]);
            pw.z = pk2(s[t][8 * hf + 4], s[t][8 * hf + 5]); pw.w = pk2(s[t][8 * hf + 6], s[t][8 * hf + 7]);
            const bf16x8 pa = __builtin_bit_cast(bf16x8, pw);
#pragma unroll
            for (int dt = 0; dt < 2; ++dt) {
                const LAS unsigned char* vp = Vt + (dt * 32 + r32) * VSTR + ((kt0 + t) * 32 + 16 * hf + 4 * hi) * 2;
                const s16x4 lo = *(const LAS s16x4*)vp, hh = *(const LAS s16x4*)(vp + 16);
                const bf16x8 vb = (bf16x8){lo[0], lo[1], lo[2], lo[3], hh[0], hh[1], hh[2], hh[3]};
                o[dt] = __builtin_amdgcn_mfma_f32_32x32x16_bf16(pa, vb, o[dt], 0, 0, 0);
            }
        }
#pragma unroll
    for (int k = 0; k < 4; ++k) { const f32x4 iv = *(const LAS f32x4*)(iscr + 8 * k + 4 * hi);
#pragma unroll
        for (int e = 0; e < 4; ++e) { o[0][4 * k + e] *= iv[e]; o[1][4 * k + e] *= iv[e]; } }
}
constexpr int ATT_K2 = ATT_V + 64 * VSTR, ATT_V2 = ATT_K2 + 160 * KSTR, ATT_ISCR = ATT_V2 + 64 * VSTR;
__device__ __forceinline__ void attn_unit(Frame& F, int u, int su, int ja) {
    const int tid = opq(F.tid), lane = tid & 63; (void)lane;
    const int kvh = u & 3, blk = (u >> 2) & 31, b = u >> 7;
    LAS unsigned char* Ks = F.lds + ATT_K; LAS unsigned char* Vt = F.lds + ATT_V; LAS unsigned char* Ks2 = F.lds + ATT_K2; LAS unsigned char* Vt2 = F.lds + ATT_V2;
    const bf16* qkv = (const bf16*)(F.ws + WS_QKV);
    bf16* O = (bf16*)(F.ws + WS_O);
    const int tok0 = blk * 128 - 128;
    const size_t rowb = (size_t)b * SEQ;
    const int h = kvh * 8 + F.wave, r32 = lane & 31, hi = lane >> 5;
    LAS float* iscr = (LAS float*)(F.lds + ATT_ISCR) + F.wave * 32;
    v4u kq[4], vq[4]; bf16x8 qf[4];
#pragma unroll
    for (int i = 0; i < 4; ++i) { const int c = tid + 512 * i, key = c >> 3, part = c & 7, t = tok0 + key;
        kq[i] = (v4u){0u, 0u, 0u, 0u}; if (t >= 0) kq[i] = *(const GAS v4u*)(qkv + (rowb + t) * NQKV + 2048 + kvh * 64 + part * 8); }
#pragma unroll
    for (int kg = 0; kg < 4; ++kg) { const int key = kg * 64 + lane, t = tok0 + key;
        vq[kg] = (v4u){0u, 0u, 0u, 0u}; if (t >= 0) vq[kg] = *(const GAS v4u*)(qkv + (rowb + t) * NQKV + 2304 + kvh * 64 + F.wave * 8); }
#pragma unroll
    for (int st = 0; st < 4; ++st) qf[st] = *(const GAS bf16x8*)(qkv + (rowb + blk * 128 + r32) * NQKV + h * 64 + st * 16 + hi * 8);
    const int skv = su & 3, sb = su >> 2;
    const float* ck = F.in[IN_CK] + (size_t)(ja * 32 + sb) * 128 * 256 + skv * 64;
    const float* cv = F.in[IN_CV] + (size_t)(ja * 32 + sb) * 128 * 256 + skv * 64;
    const size_t srow = (size_t)MP + sb * 4;
    f32x4 sk[4], sv[4]; v4u nk = (v4u){0u, 0u, 0u, 0u}; unsigned short nv[4] = {0, 0, 0, 0};
    if (su >= 0) {
#pragma unroll
        for (int i = 0; i < 4; ++i) { const int c = tid + 512 * i, key = c >> 4, part = c & 15; sk[i] = *(const GAS f32x4*)(ck + (size_t)key * 256 + part * 4); }
        if (tid < 256) { const int key = 128 + (tid >> 3), part = tid & 7; if (key < 132) nk = *(const GAS v4u*)(qkv + (srow + key - 128) * NQKV + 2048 + skv * 64 + part * 8); }
#pragma unroll
        for (int it = 0; it < 4; ++it) { const int dc = F.wave * 2 + (it >> 1), key = (it & 1) * 64 + lane; sv[it] = *(const GAS f32x4*)(cv + (size_t)key * 256 + dc * 4); }
        { const int d = tid & 63, jj0 = tid >> 6;
#pragma unroll
          for (int it = 0; it < 4; ++it) { const int jj = jj0 + 8 * it; if (jj < 4) nv[it] = qkv[(srow + jj) * NQKV + 2304 + skv * 64 + d]; } }
    }
#pragma unroll
    for (int i = 0; i < 4; ++i) { const int c = tid + 512 * i, key = c >> 3, part = c & 7; *(LAS v4u*)(Ks + key * KSTR + part * 16) = kq[i]; }
#pragma unroll
    for (int kg = 0; kg < 4; ++kg) { const int key = kg * 64 + lane;
#pragma unroll
        for (int e = 0; e < 8; ++e) { const unsigned w = vq[kg][e >> 1]; *(LAS unsigned short*)(Vt + (F.wave * 8 + e) * VSTR + key * 2) = (unsigned short)((e & 1) ? (w >> 16) : (w & 0xffffu)); } }
    if (su >= 0) {
#pragma unroll
        for (int i = 0; i < 4; ++i) { const int c = tid + 512 * i, key = c >> 4, part = c & 15;
            v2u w; w.x = pk2(sk[i].x, sk[i].y); w.y = pk2(sk[i].z, sk[i].w); *(LAS v2u*)(Ks2 + key * KSTR + part * 8) = w; }
        if (tid < 256) { const int key = 128 + (tid >> 3), part = tid & 7; *(LAS v4u*)(Ks2 + key * KSTR + part * 16) = nk; }
#pragma unroll
        for (int it = 0; it < 4; ++it) { const int dc = F.wave * 2 + (it >> 1), key = (it & 1) * 64 + lane;
#pragma unroll
            for (int e = 0; e < 4; ++e) *(LAS unsigned short*)(Vt2 + (dc * 4 + e) * VSTR + key * 2) = (unsigned short)f2bf(sv[it][e]); }
        { const int d = tid & 63, jj0 = tid >> 6;
#pragma unroll
          for (int it = 0; it < 4; ++it) { const int jj = jj0 + 8 * it, j = 128 + jj; *(LAS unsigned short*)(Vt2 + d * VSTR + j * 2) = nv[it]; } }
    }
    if (blk == 31) {
#pragma unroll
        for (int i = 0; i < 4; ++i) { const int c = tid + 512 * i, which = c >> 10, cc = c & 1023, jj = cc >> 3, part = cc & 7;
            const v4u v = *(const GAS v4u*)(qkv + (rowb + 3968 + jj) * NQKV + 2048 + which * 256 + kvh * 64 + part * 8);
            float* dst = F.out + (which ? OFF_VP : OFF_KP) + ((size_t)((ja * 2 + b) * 128 + jj) * 4 + kvh) * 64 + part * 8;
            *(GAS f32x4*)dst = (f32x4){bflo(v.x), bfhi(v.x), bflo(v.y), bfhi(v.y)}; *(GAS f32x4*)(dst + 4) = (f32x4){bflo(v.z), bfhi(v.z), bflo(v.w), bfhi(v.w)}; }
    }
    if (su >= 0) {
        f32x4 cp[8];
#pragma unroll
        for (int i = 0; i < 8; ++i) { const int c = tid + 512 * i, which = c >> 11, cc = c & 2047, jj = cc >> 4, part = cc & 15, j = jj + 4;
            if (j < 128) cp[i] = *(const GAS f32x4*)((which ? cv : ck) + (size_t)j * 256 + part * 4);
            else { const v2u w = *(const GAS v2u*)(qkv + (srow + j - 128) * NQKV + 2048 + which * 256 + skv * 64 + part * 4); cp[i] = (f32x4){bflo(w.x), bfhi(w.x), bflo(w.y), bfhi(w.y)}; } }
#pragma unroll
        for (int i = 0; i < 8; ++i) { const int c = tid + 512 * i, which = c >> 11, cc = c & 2047, jj = cc >> 4, part = cc & 15;
            *(GAS f32x4*)(F.out + (which ? OFF_VS : OFF_KS) + ((size_t)((ja * 32 + sb) * 128 + jj) * 4 + skv) * 64 + part * 4) = cp[i]; }
    }
    __syncthreads();
    const float sink2 = F.in[IN_SINK][ja * 32 + h] * LOG2E;
#pragma unroll 1
    for (int qt = 0; qt < 4; ++qt) {
        const size_t qrow = rowb + blk * 128 + qt * 32;
        f32x16 o[2];
        attn_qtile(Ks, Vt, iscr, qf, qt, r32, blk == 0 ? 128 : 0, sink2, o, lane);
        if (qt < 3) {
#pragma unroll
            for (int st = 0; st < 4; ++st) qf[st] = *(const GAS bf16x8*)(qkv + (qrow + 32 + r32) * NQKV + h * 64 + st * 16 + hi * 8); }
#pragma unroll
        for (int dt = 0; dt < 2; ++dt)
#pragma unroll
            for (int r = 0; r < 16; ++r) O[(qrow + crow(r, hi)) * D + h * 64 + dt * 32 + r32] = (bf16)f2bf(o[dt][r]);
    }
    if (su >= 0 && F.wave == 0) {
        const int g = r32 >> 2, l = r32 & 3, hs = skv * 8 + g;
        const float sink2s = F.in[IN_SINK][ja * 32 + hs] * LOG2E;
#pragma unroll
        for (int st = 0; st < 4; ++st) qf[st] = *(const GAS bf16x8*)(qkv + (srow + l) * NQKV + hs * 64 + st * 16 + hi * 8);
        f32x16 o[2];
        attn_qtile(Ks2, Vt2, iscr, qf, 0, l, 0, sink2s, o, lane);
#pragma unroll
        for (int dt = 0; dt < 2; ++dt)
#pragma unroll
            for (int r = 0; r < 16; ++r) { const int q = crow(r, hi); O[(srow + (q & 3)) * D + (skv * 8 + (q >> 2)) * 64 + dt * 32 + r32] = (bf16)f2bf(o[dt][r]); }
    }
    __syncthreads();
}
__device__ __forceinline__ void attn_phase(Frame& F, int ja) {
    for (int u = blockIdx.x; u < 256; u += F.G) attn_unit(F, u, u < 128 ? u : -1, ja);
}

__device__ __forceinline__ void ld8z(const bf16* p, bool ok, float (&f)[8]) { v4u v = (v4u){0u, 0u, 0u, 0u}; if (ok) v = *(const GAS v4u*)p; unpack8(v, f); }
__device__ __forceinline__ void convgate_phase(Frame& F) {
    const int tid = opq(F.tid), lane = tid & 63;
    const int gw = F.vcu * NWAVES + F.wave, NGW = F.G * NWAVES;
    const bf16* Z = (const bf16*)(F.ws + WS_Z); const bf16* BG = (const bf16*)(F.ws + WS_BG); bf16* GA = (bf16*)(F.ws + WS_O);
    const float* cw = F.in[IN_CW];
    float w0[4][8], w1[4][8], w2[4][8];
#pragma unroll
    for (int j = 0; j < 4; ++j) { const int ch = (lane + 64 * j) * 8; ld8f(cw + ch, w0[j]); ld8f(cw + D + ch, w1[j]); ld8f(cw + 2 * D + ch, w2[j]); }
    for (int m = gw; m < MR; m += NGW) {
        const bool samp = m >= MP; const int b = samp ? (m - MP) >> 2 : m >> 12, t = samp ? (m - MP) & 3 : m & 4095;
        float y[4][8], z0[4][8];
#pragma unroll
        for (int j = 0; j < 4; ++j) {
            const int ch = (lane + 64 * j) * 8;
            float z1[8], z2[8], bg[8];
            unpack8(*(const GAS v4u*)(Z + (size_t)m * D + ch), z0[j]);
            unpack8(*(const GAS v4u*)(BG + (size_t)m * D + ch), bg);
            if (samp && t < 1) ld8f(F.in[IN_SC] + (size_t)(b * 2 + 1) * D + ch, z1); else ld8z(Z + (size_t)(m - 1) * D + ch, t >= 1, z1);
            if (samp && t < 2) ld8f(F.in[IN_SC] + (size_t)(b * 2 + t) * D + ch, z2); else ld8z(Z + (size_t)(m - 2) * D + ch, t >= 2, z2);
#pragma unroll
            for (int e = 0; e < 8; ++e) y[j][e] = bg[e] * (w0[j][e] * z2[e] + w1[j][e] * z1[e] + w2[j][e] * z0[j][e]);
        }
#pragma unroll
        for (int j = 0; j < 4; ++j) {
            const int ch = (lane + 64 * j) * 8;
            v4u w; w.x = pk2(y[j][0], y[j][1]); w.y = pk2(y[j][2], y[j][3]); w.z = pk2(y[j][4], y[j][5]); w.w = pk2(y[j][6], y[j][7]);
            *(GAS v4u*)(GA + (size_t)m * D + ch) = w;
            float* dst = nullptr;
            if (!samp && t >= SEQ - 2) dst = F.out + OFF_CP + (size_t)(b * 2 + (t - (SEQ - 2))) * D + ch;
            if (samp && t >= 2) dst = F.out + OFF_CS + (size_t)(b * 2 + (t - 2)) * D + ch;
            if (dst) { *(GAS f32x4*)dst = (f32x4){z0[j][0], z0[j][1], z0[j][2], z0[j][3]}; *(GAS f32x4*)(dst + 4) = (f32x4){z0[j][4], z0[j][5], z0[j][6], z0[j][7]}; }
        }
    }
}

__device__ __forceinline__ void sgu_ln_phase(Frame& F) {
    const int tid = opq(F.tid), lane = tid & 63; (void)lane;
    const int gw = F.vcu * NWAVES + F.wave, NGW = F.G * NWAVES;
    const bf16* V = (const bf16*)(F.ws + WS_Z); bf16* VLN = (bf16*)(F.ws + WS_VLN);
    float lg[4][8], lb[4][8];
#pragma unroll
    for (int j = 0; j < 4; ++j) { ld8f(F.in[IN_SLNG] + (lane + 64 * j) * 8, lg[j]); ld8f(F.in[IN_SLNB] + (lane + 64 * j) * 8, lb[j]); }
    v4u raw[4];
#pragma unroll
    for (int j = 0; j < 4; ++j) raw[j] = (gw < MR) ? *(const GAS v4u*)(V + (size_t)gw * D + (lane + 64 * j) * 8) : (v4u){0u, 0u, 0u, 0u};
    for (int m = gw; m < MR; m += NGW) {
        float v[4][8]; float s = 0.f;
#pragma unroll
        for (int j = 0; j < 4; ++j) { unpack8(raw[j], v[j]);
#pragma unroll
            for (int e = 0; e < 8; ++e) s += v[j][e]; }
        if (m + NGW < MR) {
#pragma unroll
            for (int j = 0; j < 4; ++j) raw[j] = *(const GAS v4u*)(V + (size_t)(m + NGW) * D + (lane + 64 * j) * 8); }
        const float mean = wave_sum(s) * (1.0f / D); float q = 0.f;
#pragma unroll
        for (int j = 0; j < 4; ++j)
#pragma unroll
            for (int e = 0; e < 8; ++e) { v[j][e] -= mean; q += v[j][e] * v[j][e]; }
        const float rstd = 1.0f / sqrtf(wave_sum(q) * (1.0f / D) + LN_EPS);
#pragma unroll
        for (int j = 0; j < 4; ++j) { const int ch = (lane + 64 * j) * 8; float y[8];
#pragma unroll
            for (int e = 0; e < 8; ++e) y[e] = v[j][e] * rstd * lg[j][e] + lb[j][e];
            v4u w; w.x = pk2(y[0], y[1]); w.y = pk2(y[2], y[3]); w.z = pk2(y[4], y[5]); w.w = pk2(y[6], y[7]);
            *(GAS v4u*)(VLN + (size_t)m * D + ch) = w;
            if (m >= MP) { float* dst = F.out + OFF_SV + (size_t)(m - MP) * D + ch; *(GAS f32x4*)dst = (f32x4){y[0], y[1], y[2], y[3]}; *(GAS f32x4*)(dst + 4) = (f32x4){y[4], y[5], y[6], y[7]}; }
        }
    }
}
constexpr int MIX_STR = 272, MIX_W = 0, MIX_V = 128 * MIX_STR, MIX_B = MIX_V + 256 * MIX_STR;
__device__ __forceinline__ void sgu_mix_unit(Frame& F, int u) {
    const int tid = opq(F.tid), lane = tid & 63; (void)lane;
    const int g = u & 7, c = u >> 3;
    LAS unsigned char* Wl = F.lds + MIX_W; LAS unsigned char* Vl = F.lds + MIX_V; LAS float* bsl = (LAS float*)(F.lds + MIX_B);
    const float* ws = F.in[IN_SWS] + (size_t)g * 128 * 128;
    const bf16* VLN = (const bf16*)(F.ws + WS_VLN); const bf16* U = (const bf16*)(F.ws + WS_BG); bf16* A2 = (bf16*)(F.ws + WS_O);
    const int r32 = lane & 31, hi = lane >> 5;
    f32x4 wv[8];
#pragma unroll
    for (int i = 0; i < 8; ++i) { const int cc = tid + 512 * i, t = cc >> 5, s4 = (cc & 31) * 4; wv[i] = *(const GAS f32x4*)(ws + t * 128 + s4); }
    v4u vv[8];
#pragma unroll
    for (int it = 0; it < 8; ++it) { const int pi = it * 8 + F.wave, dc = pi >> 1, s = (pi & 1) * 64 + lane; vv[it] = *(const GAS v4u*)(VLN + (size_t)(c * 128 + s) * D + g * 256 + dc * 8); }
    if (tid < 128) bsl[tid] = F.in[IN_SBS][g * 128 + tid];
#pragma unroll
    for (int i = 0; i < 8; ++i) { const int cc = tid + 512 * i, t = cc >> 5, s4 = (cc & 31) * 4; f32x4 v = wv[i];
        if (s4 + 0 > t) v.x = 0.f; if (s4 + 1 > t) v.y = 0.f; if (s4 + 2 > t) v.z = 0.f; if (s4 + 3 > t) v.w = 0.f;
        v2u w; w.x = pk2(v.x, v.y); w.y = pk2(v.z, v.w); *(LAS v2u*)(Wl + t * MIX_STR + s4 * 2) = w; }
#pragma unroll
    for (int it = 0; it < 8; ++it) { const int pi = it * 8 + F.wave, dc = pi >> 1, s = (pi & 1) * 64 + lane; const v4u v = vv[it];
#pragma unroll
        for (int e = 0; e < 8; ++e) { const unsigned w = v[e >> 1]; *(LAS unsigned short*)(Vl + (dc * 8 + e) * MIX_STR + s * 2) = (unsigned short)((e & 1) ? (w >> 16) : (w & 0xffffu)); } }
    __syncthreads();
#pragma unroll
    for (int mt = 0; mt < 4; ++mt) {
        f32x16 acc = (f32x16){0.f, 0.f, 0.f, 0.f, 0.f, 0.f, 0.f, 0.f, 0.f, 0.f, 0.f, 0.f, 0.f, 0.f, 0.f, 0.f};
#pragma unroll
        for (int ks = 0; ks < 2 * mt + 2; ++ks) {
            const bf16x8 a = *(const LAS bf16x8*)(Wl + (32 * mt + r32) * MIX_STR + (16 * ks + 8 * hi) * 2);
            const bf16x8 bb = *(const LAS bf16x8*)(Vl + (32 * F.wave + r32) * MIX_STR + (16 * ks + 8 * hi) * 2);
            acc = __builtin_amdgcn_mfma_f32_32x32x16_bf16(a, bb, acc, 0, 0, 0);
        }
        const size_t ib = (size_t)(c * 128 + 32 * mt + 4 * hi) * D + g * 256 + 32 * F.wave + r32;
        unsigned short uu[16];
#pragma unroll
        for (int r = 0; r < 16; ++r) uu[r] = U[ib + (size_t)((r & 3) + 8 * (r >> 2)) * D];
#pragma unroll
        for (int r = 0; r < 16; ++r) { const int t = 32 * mt + crow(r, hi);
            A2[ib + (size_t)((r & 3) + 8 * (r >> 2)) * D] = (bf16)f2bf(bf2f(uu[r]) * (acc[r] + bsl[t])); }
    }
    __syncthreads();
}
__device__ __forceinline__ void sgu_mix_phase(Frame& F) {
    const int tid = opq(F.tid), lane = tid & 63; (void)lane;
    for (int u = blockIdx.x; u < 512; u += F.G) sgu_mix_unit(F, u);
    const int gw = F.vcu * NWAVES + F.wave, NGW = F.G * NWAVES;
    const bf16* VLN = (const bf16*)(F.ws + WS_VLN); const bf16* U = (const bf16*)(F.ws + WS_BG); bf16* A2 = (bf16*)(F.ws + WS_O);
    for (int r = gw; r < MS; r += NGW) {
        const int m = MP + r, l = r & 3, m0 = m - l;
#pragma unroll
        for (int j = 0; j < 4; ++j) { const int ch = (lane + 64 * j) * 8, g = ch >> 8;
            float mix[8], uu[8];
#pragma unroll
            for (int e = 0; e < 8; ++e) mix[e] = F.in[IN_SBS][g * 128 + l];
            for (int s = 0; s <= l; ++s) { float vv[8]; unpack8(*(const GAS v4u*)(VLN + (size_t)(m0 + s) * D + ch), vv); const float w = F.in[IN_SWS][(size_t)(g * 128 + l) * 128 + s];
#pragma unroll
                for (int e = 0; e < 8; ++e) mix[e] += w * vv[e]; }
            unpack8(*(const GAS v4u*)(U + (size_t)m * D + ch), uu);
            v4u w; w.x = pk2(uu[0] * mix[0], uu[1] * mix[1]); w.y = pk2(uu[2] * mix[2], uu[3] * mix[3]); w.z = pk2(uu[4] * mix[4], uu[5] * mix[5]); w.w = pk2(uu[6] * mix[6], uu[7] * mix[7]);
            *(GAS v4u*)(A2 + (size_t)m * D + ch) = w; }
    }
}

#ifdef SKIP_PRO
#define PRO(...)
#else
#define PRO(...) __VA_ARGS__
#endif
#ifdef SKIP_NRM
#define NRM(...)
#else
#define NRM(...) __VA_ARGS__
#endif
#ifdef SKIP_ATT
#define ATT(...)
#else
#define ATT(...) __VA_ARGS__
#endif
#ifdef SKIP_CNV
#define CNV(...)
#else
#define CNV(...) __VA_ARGS__
#endif
#ifdef SKIP_SGL
#define SGL(...)
#else
#define SGL(...) __VA_ARGS__
#endif
#ifdef SKIP_SGM
#define SGM(...)
#else
#define SGM(...) __VA_ARGS__
#endif
#ifdef SKIP_GM_EpiGated
#define GM_EpiGated(...)
#else
#define GM_EpiGated(...) __VA_ARGS__
#endif
#ifdef SKIP_GM_EpiF32
#define GM_EpiF32(...)
#else
#define GM_EpiF32(...) __VA_ARGS__
#endif
#ifdef SKIP_GM_EpiQKV
#define GM_EpiQKV(...)
#else
#define GM_EpiQKV(...) __VA_ARGS__
#endif
#ifdef SKIP_GM_EpiConvIn
#define GM_EpiConvIn(...)
#else
#define GM_EpiConvIn(...) __VA_ARGS__
#endif
#ifdef SKIP_GM_EpiGeluSplit
#define GM_EpiGeluSplit(...)
#else
#define GM_EpiGeluSplit(...) __VA_ARGS__
#endif

#ifndef MK_PER_PHASE
#define MK_PER_PHASE 0
#endif
constexpr int N_STEPS = 42;
struct Args { const float* in[20]; float* out; unsigned char* ws; int lo, hi, li, pad; };
__global__ void __launch_bounds__(NWAVES * 64, 2) mk_fwd(Args a) {
    extern __shared__ __attribute__((aligned(16))) unsigned char lds_raw[];
    Frame F;
    F.lds = (LAS unsigned char*)lds_raw;
    F.tid = threadIdx.x; F.lane = F.tid & 63; F.wave = __builtin_amdgcn_readfirstlane(F.tid >> 6);
    F.G = gridDim.x; { const int bx = blockIdx.x; F.vcu = (F.G % 8 == 0) ? (bx % 8) * (F.G / 8) + bx / 8 : bx; }
#pragma unroll
    for (int i = 0; i < 20; ++i) F.in[i] = a.in[i];
    F.out = a.out; F.ws = a.ws;
    for (int u = F.tid; u < (LDS_BYTES - LDSCTL_OFF) / 4; u += NWAVES * 64) ((LAS unsigned*)(F.lds + LDSCTL_OFF))[u] = 0u;
    __syncthreads();
    unsigned* barw = (unsigned*)(a.ws + WS_CTL) + CW_BAR + a.li * XCD_BAR_WORDS;
    XcdBarrier bar; bar.bar = barw; bar.x = 0; bar.st = nullptr;
    if (a.hi - a.lo > 1) bar = xcd_barrier_post(barw, (volatile LAS unsigned*)(F.lds + MISC_OFF) + 8);
    int st = 0;
#ifndef XBAR_EXTRA
#define XBAR_EXTRA 0
#endif
#ifndef DUP_MASK
#define DUP_MASK 0
#endif
#define DUPN(bit) (((DUP_MASK) >> (bit)) & 1 ? 2 : 1)
#define CVT(sl) do { } while (0)
#define REP(bit, ...) for (int rep_ = 0; rep_ < DUPN(bit); ++rep_) { __VA_ARGS__ }
#define RUN(...) do { if (st >= a.lo && st < a.hi) { __VA_ARGS__; if (st + 1 < a.hi) { xcd_barrier(bar); for (int xb_ = 0; xb_ < XBAR_EXTRA; ++xb_) xcd_barrier(bar); } } ++st; } while (0)
    const float* ng = F.in[IN_NG];
    bf16* H = (bf16*)(F.ws + WS_H); bf16* ACT = (bf16*)(F.ws + WS_ACT); bf16* OUTF = (bf16*)(F.ws + WS_OUTF); float* SSQ = (float*)(F.ws + WS_SSQ); bf16* OB = (bf16*)(F.ws + WS_O);

    RUN({ REP(0, PRO(prologue_phase(F);)) NRM(norm_first_phase(F);) });

    const bf16* stA = nullptr; const bf16* stB = nullptr; int stK = 0, stNs = 1, stT = -1; float stAlpha = 0.f; const float* stG = nullptr;
#define SAMP_TAIL(WQ8) do { if (stT >= 0) { \
        unsigned* f1_ = (unsigned*)(F.ws + WS_CTL) + CW_SFLAG + stT * 128; \
        pg8::Gemm gp_{stA, stB, stK}; pg8::PanelOrder SP_; SP_.init(D, stK, stNs, F.G, (int)blockIdx.x, 2); \
        pg8::EpiF32 EP_{OUTF, D, (float*)(F.ws + WS_PART), PART_SLAB}; \
        pg8::gemm_phase<pg8::EpiF32, pg8::PanelOrder, true, true>(F.lds, gp_, SP_, EP_); \
        const int npc_ = SP_.nS < F.G ? SP_.nS : F.G;                        \
        if (F.G - 1 - (int)blockIdx.x < npc_ && F.tid == 0) __hip_atomic_fetch_add(f1_, 1u, __ATOMIC_RELAXED, __HIP_MEMORY_SCOPE_AGENT); \
        sample_tail_norm(F, stAlpha, stG, stNs, WQ8, f1_, (unsigned)npc_, f1_ + 64, (WQ8) ? (float*)nullptr : SSQ + (size_t)layer * M); } } while (0)
#define SAMP_FLAG (stT >= 0 ? (const unsigned*)((unsigned*)(F.ws + WS_CTL) + CW_SFLAG + stT * 128 + 64) : (const unsigned*)nullptr)

    for (int layer = 0; layer < 4; ++layer) {
        const int kind = layer % 3, jm = layer / 3;
        const float* g = ng + (size_t)layer * 6 * D;
        for (int half = 0; half < 2; ++half) {
            const bf16* wgu = (const bf16*)(F.ws + WS_WFFN + (size_t)(layer * 2 + half) * WFFN_STRIDE);
            const bf16* wd = (const bf16*)((const unsigned char*)wgu + WD_OFF);
            const bool lastsl = (layer == 3 && half == 1);
            const float* gpost = g + (half == 0 ? 1 : 5) * D;
            RUN({ SAMP_TAIL(true);
                  pg8::Gemm gm{(const bf16*)(F.ws + WS_XQ8), wgu, D / 2}; pg8::PanelOrder S; S.init(NGU, D / 2, 1, F.G, (int)blockIdx.x, 0, SAMP_FLAG, 128u);
                  pg8::EpiGatedI8 E{ACT, DFF, (const float*)(F.ws + WS_RS8), (const float*)(F.ws + WS_SW) + (size_t)(layer * 2 + half) * NGU};
                  REP(2, GM_EpiGated(pg8::gemm_phase<pg8::EpiGatedI8, pg8::PanelOrder, true, true, true>(F.lds, gm, S, E);)) });
            if (half == 0 && F.G == 256) {
                RUN({ pg8::Gemm gm{ACT, wd, DFF}; pg8::PanelOrder S; S.init(D, DFF, NSPLIT_FFN, F.G, (int)blockIdx.x, 1);
                      pg8::EpiResNorm E{H, gpost, 0.5f, (float*)(F.ws + WS_PS), (unsigned*)(F.ws + WS_CTL) + CW_PCNT + 2048 * layer, SSQ + (size_t)layer * M};
                      pg8::gemm_phase<pg8::EpiResNorm, pg8::PanelOrder, true, true>(F.lds, gm, S, E); });
            } else {
            RUN({ pg8::Gemm gm{ACT, wd, DFF}; pg8::PanelOrder S; S.init(D, DFF, NSPLIT_FFN, F.G, (int)blockIdx.x, lastsl ? 0 : 1);
                  pg8::EpiF32 E{OUTF, D, (float*)(F.ws + WS_PART), PART_SLAB};
                  REP(3, GM_EpiF32(pg8::gemm_phase<pg8::EpiF32, pg8::PanelOrder, true, true>(F.lds, gm, S, E);))
                  });
            RUN({ NRM(norm_phase(F, 0.5f, gpost, lastsl, NSPLIT_FFN, half == 1 && !lastsl, lastsl, half == 0 ? SSQ + (size_t)layer * M : (float*)nullptr);) });
            }
            stA = ACT; stB = wd; stK = DFF; stNs = NSPLIT_FFN; stAlpha = 0.5f; stG = gpost; stT = layer * 3 + 2 * half;
            if (half == 1) break;
            const bf16* mixB = nullptr;
            if (kind == 0) {
                const bf16* wq = (const bf16*)(F.ws + WS_WATT + (size_t)jm * WATT_STRIDE); mixB = (const bf16*)((const unsigned char*)wq + WO_OFF);
                RUN({ SAMP_TAIL(false);
                      pg8::Gemm gm{H, wq, D}; pg8::PanelOrder S; S.init(NQKV, D, 1, F.G, (int)blockIdx.x, 0, SAMP_FLAG, 128u);
                      pg8::EpiQKV E{(bf16*)(F.ws + WS_QKV), (const float*)(F.ws + WS_ROPE), (const float*)(F.ws + WS_ROPE) + 4100 * 8, SSQ + (size_t)layer * M};
                      REP(5, GM_EpiQKV(pg8::gemm_phase<pg8::EpiQKV, pg8::PanelOrder, true, true>(F.lds, gm, S, E);)) });
                RUN({ REP(4, ATT(attn_phase(F, jm);)) });
            } else if (kind == 1) {
                mixB = (const bf16*)(F.ws + WS_WCONV + WCOUT_OFF);
                RUN({ SAMP_TAIL(false);
                      pg8::Gemm gm{H, (const bf16*)(F.ws + WS_WCONV), D}; pg8::PanelOrder S; S.init(NCIN, D, 1, F.G, (int)blockIdx.x, 0, SAMP_FLAG, 128u);
                      pg8::EpiConvIn E{(bf16*)(F.ws + WS_BG), (bf16*)(F.ws + WS_Z), SSQ + (size_t)layer * M};
                      REP(5, GM_EpiConvIn(pg8::gemm_phase<pg8::EpiConvIn, pg8::PanelOrder, true, true>(F.lds, gm, S, E);)) });
                RUN({ REP(6, CNV(convgate_phase(F);)) });
            } else {
                mixB = (const bf16*)(F.ws + WS_WSGU + WSOUT_OFF);
                RUN({ SAMP_TAIL(false);
                      pg8::Gemm gm{H, (const bf16*)(F.ws + WS_WSGU), D}; pg8::PanelOrder S; S.init(NSIN, D, 1, F.G, (int)blockIdx.x, 0, SAMP_FLAG, 128u);
                      pg8::EpiGeluSplit E{(bf16*)(F.ws + WS_BG), (bf16*)(F.ws + WS_Z), SSQ + (size_t)layer * M};
                      REP(5, GM_EpiGeluSplit(pg8::gemm_phase<pg8::EpiGeluSplit, pg8::PanelOrder, true, true>(F.lds, gm, S, E);)) });
                RUN({ REP(7, SGL(sgu_ln_phase(F);)) });
                RUN({ REP(8, SGM(sgu_mix_phase(F);)) });
            }
            RUN({ pg8::Gemm gm{OB, mixB, D}; pg8::PanelOrder S; S.init(D, D, NSPLIT_MIX, F.G, (int)blockIdx.x, 1);
                  pg8::EpiF32 E{OUTF, D, (float*)(F.ws + WS_PART), PART_SLAB};
                  REP(5, GM_EpiF32(pg8::gemm_phase<pg8::EpiF32, pg8::PanelOrder, true, true>(F.lds, gm, S, E);)) });
            RUN({ NRM(norm_phase(F, 1.0f, g + 3 * D, false, NSPLIT_MIX, true, false, nullptr);) });
            stA = OB; stB = mixB; stK = D; stNs = NSPLIT_MIX; stAlpha = 1.0f; stG = g + 3 * D; stT = layer * 3 + 1;
        }
    }
#undef SAMP_TAIL
#undef SAMP_FLAG
#undef RUN
}

extern "C" void kernel_launch(void* const* d_in, const int* in_sizes, int n_in, void* d_out, int out_size, void* d_ws, size_t ws_size, hipStream_t stream) {
    static int grid = 0;
    if (grid == 0) {
        if (n_in != 20 || (size_t)out_size != OUT_TOTAL || ws_size < WS_END) { fprintf(stderr, "kernel_launch: unexpected shapes: n_in %d out %d ws %zu (need %zu)\n", n_in, out_size, ws_size, (size_t)WS_END); grid = -1; return; }
        int dev = 0, cus = 0, per_cu = 0;
        if (hipGetDevice(&dev) != hipSuccess || hipDeviceGetAttribute(&cus, hipDeviceAttributeMultiprocessorCount, dev) != hipSuccess) { grid = -1; return; }
        if (hipFuncSetAttribute((const void*)mk_fwd, hipFuncAttributeMaxDynamicSharedMemorySize, LDS_BYTES) != hipSuccess) { fprintf(stderr, "kernel_launch: hipFuncSetAttribute failed\n"); grid = -1; return; }
        if (hipOccupancyMaxActiveBlocksPerMultiprocessor(&per_cu, (const void*)mk_fwd, NWAVES * 64, LDS_BYTES) != hipSuccess || per_cu < 1) fprintf(stderr, "kernel_launch: occupancy query says %d\n", per_cu);
        (void)hipGetLastError();
        grid = cus;
    }
    if (grid < 0) return;
    (void)hipMemsetAsync((char*)d_ws + WS_CTL, 0, CTL_ZERO_BYTES, stream);
    Args a{};
    for (int i = 0; i < 20; ++i) a.in[i] = (const float*)d_in[i];
    a.out = (float*)d_out; a.ws = (unsigned char*)d_ws; a.pad = 0;
#if MK_PER_PHASE
    for (int s = 0; s < ((grid == 256) ? N_STEPS - 4 : N_STEPS); ++s) { a.lo = s; a.hi = s + 1; a.li = 0; hipLaunchKernelGGL(mk_fwd, dim3(grid), dim3(NWAVES * 64), LDS_BYTES, stream, a); }
#else
    a.lo = 0; a.hi = (grid == 256) ? N_STEPS - 4 : N_STEPS; a.li = 0;
    hipLaunchKernelGGL(mk_fwd, dim3(grid), dim3(NWAVES * 64), LDS_BYTES, stream, a);
#endif
    const hipError_t le = hipPeekAtLastError();
    if (le != hipSuccess) fprintf(stderr, "kernel_launch: launch failed: %s\n", hipGetErrorName(le));
}
```

```cpp
#include <hip/hip_runtime.h>
#include <cstdio>
#include <cstdint>
namespace pg8 {
#define PG8_LAS __attribute__((address_space(3)))
typedef unsigned short bf16_t;
typedef short bf16x8 __attribute__((ext_vector_type(8)));
typedef float f32x4 __attribute__((ext_vector_type(4)));
typedef unsigned u32x4 __attribute__((ext_vector_type(4)));
typedef int i32x4 __attribute__((ext_vector_type(4)));
constexpr int BM = 256, BK = 64, HALF = 128, HTB = HALF * BK * 2  , STAGE_BYTES = 8 * HTB, NXCD = 8, WGM = 8;

__host__ __device__ __forceinline__ int lds_byte(int r, int c) { const int st = (r >> 4) * 2 + (c >> 5), rr = r & 15, cc = c & 31, ob = rr * 64 + cc * 2; return st * 1024 + (ob ^ (((ob >> 9) & 1) << 5)); }
__host__ __device__ __forceinline__ void stage_rc(int b, int& R, int& C) { const int st = b / 1024, sb = b % 1024, swz = sb ^ (((sb >> 9) & 1) << 5); R = (st >> 1) * 16 + swz / 64; C = (st & 1) * 32 + (swz % 64) / 2; }
__host__ __device__ __forceinline__ int perm32(int rho) { const int n = rho >> 4, i = rho & 15; return 8 * (i >> 2) + 4 * n + (i & 3); }

struct Unit { int pm, pn, ks, nt, hm, roff; };
struct Gemm { const bf16_t* A; const bf16_t* Bt; int K; };

struct StaticOrder {
    int nM, nN, nwg, G, c;
    __host__ __device__ void init(int M, int N, int G_, int c_) { nM = M / BM; nN = N / BM; nwg = nM * nN; G = G_; c = c_; }
    __host__ __device__ bool next(int i, Unit& u) const {
        const long L = (long)i * G + c; if (L >= nwg) return false;
        int wgid = (int)L; { const int q = nwg / NXCD, r = nwg % NXCD, xcd = wgid % NXCD, off = wgid / NXCD; wgid = (xcd < r ? xcd * (q + 1) : r * (q + 1) + (xcd - r) * q) + off; }
        const int nig = WGM * nN, gid = wgid / nig, fm = gid * WGM, gsz = (nM - fm) < WGM ? (nM - fm) : WGM;
        u.pm = fm + ((wgid % nig) % gsz); u.pn = (wgid % nig) / gsz; u.ks = 0; u.nt = 0; u.hm = 0; u.roff = 0; return true;
    }
    __device__ __forceinline__ void a_ready(const Unit&) const {}
    __device__ __forceinline__ void done(const Unit&) const {}
};
struct PanelOrder {
    int nN, nP, nS, nsplit, G, c, ntFull, L0, L1, nF, nH;
    const unsigned* flag; unsigned need;
    __device__ __forceinline__ void init(int N, int K, int nsplit_, int G_, int c_, int mode = 0, const unsigned* flag_ = nullptr, unsigned need_ = 0u) {
        nN = N / BM; nP = 32 * nN; nsplit = nsplit_; nS = (mode == 1) ? 0 : nN * nsplit_; G = G_; c = c_; ntFull = K / BK; flag = flag_; need = need_;
        if (mode == 2) { nF = 0; nH = 0; c = G_ - 1 - c_; L0 = 0; L1 = nS; return; }
        const int R = nP % G_;
        nH = (R > 0 && 2 * R + nS <= G_) ? 2 * R : 0; nF = nP - nH / 2; L0 = 0; L1 = nF + nH + nS; }
    __device__ __forceinline__ void prompt_unit(int b, Unit& u) const {
        int wgid = b; { const int q = nP / NXCD, r = nP % NXCD, xcd = wgid % NXCD, off = wgid / NXCD; wgid = (xcd < r ? xcd * (q + 1) : r * (q + 1) + (xcd - r) * q) + off; }
        const int nig = WGM * nN, gid = wgid / nig, fm = gid * WGM;
        u.pm = fm + ((wgid % nig) % WGM); u.pn = (wgid % nig) / WGM; u.ks = 0; u.nt = ntFull; }
    __device__ __forceinline__ bool next(int i, Unit& u) const {
        const int L = L0 + i * G + c; if (L >= L1) return false;
        if (L < nF) { prompt_unit(L, u); u.hm = 0; u.roff = 0; }
        else if (L < nF + nH) { const int j = L - nF; prompt_unit(nF + (j >> 1), u); u.hm = 1; u.roff = 128 * (j & 1); }
        else { const int j = L - nF - nH; u.pm = 32; u.pn = j % nN; u.ks = j / nN; u.nt = ntFull / nsplit; u.hm = 1; u.roff = 0; }
        return true;
    }
    __device__ __forceinline__ void a_ready(const Unit& u) const {
        if (flag == nullptr || u.pm != 32) return;
        if (threadIdx.x < 64) {
            unsigned spins = 0;
            while ((unsigned)__builtin_amdgcn_readfirstlane(__hip_atomic_load(flag, __ATOMIC_RELAXED, __HIP_MEMORY_SCOPE_AGENT)) < need) { __builtin_amdgcn_s_sleep(2); if (++spins > (1u << 22)) break; }
            __builtin_amdgcn_fence(__ATOMIC_ACQUIRE, "agent");
            asm volatile("s_waitcnt vmcnt(0)" ::: "memory");
        }
        asm volatile("" ::: "memory"); __builtin_amdgcn_s_barrier(); asm volatile("" ::: "memory");
    }
    __device__ __forceinline__ void done(const Unit&) const {}
};


#ifndef PG8_WT_STORES
#define PG8_WT_STORES 1
#endif
__device__ __forceinline__ void st16_wt(const void* base, const void* p, u32x4 v) {
#if PG8_WT_STORES
    const __amdgpu_buffer_rsrc_t rs = __builtin_amdgcn_make_buffer_rsrc((void*)base, (short)0, 0x7ffffff0, 0x00020000);
    __builtin_amdgcn_raw_buffer_store_b128(v, rs, (int)((const char*)p - (const char*)base), 0, 16);
#else
    *(u32x4*)p = v;
#endif
}
typedef float f32x2_cv __attribute__((ext_vector_type(2))); typedef __bf16 bf16x2_cv __attribute__((ext_vector_type(2)));
__device__ __forceinline__ unsigned cvt_pk_bf16(float lo, float hi) { const f32x2_cv v = {lo, hi}; const bf16x2_cv b = __builtin_convertvector(v, bf16x2_cv); return __builtin_bit_cast(unsigned, b); }
typedef unsigned u32x2 __attribute__((ext_vector_type(2)));
__device__ __forceinline__ float silu_f(float x) { return x * __builtin_amdgcn_rcpf(1.0f + __builtin_amdgcn_exp2f(-1.44269504089f * x)); }
__device__ __forceinline__ float gelu_tanh_f(float x) { const float t = x * (1.0f + 0.044715f * x * x) * (-2.0f * 0.7978845608f * 1.44269504089f); return x * __builtin_amdgcn_rcpf(1.0f + __builtin_amdgcn_exp2f(t)); }
__device__ __forceinline__ u32x4 pack8(const f32x4 a, const f32x4 b) { u32x4 w; w.x = cvt_pk_bf16(a[0], a[1]); w.y = cvt_pk_bf16(a[2], a[3]); w.z = cvt_pk_bf16(b[0], b[1]); w.w = cvt_pk_bf16(b[2], b[3]); return w; }

struct EpiF32 {
    static constexpr bool PERM = true, AFTER_DRAIN = false;
    bf16_t* O; int ldc; float* P; size_t slab;
    __device__ __forceinline__ void operator()(const f32x4 (&acc)[2][2][4][2], const Unit& u, int wr, int wc, int fr, int fq) const {
        const int col0 = u.pn * BM + wc * 32 + 8 * fq;
        if (u.pm == 32) {
            const int row0 = wr * 64 + fr; float* base = P + (size_t)u.ks * slab;
#pragma unroll
            for (int m = 0; m < 4; ++m) { float* rowp = base + (size_t)(row0 + m * 16) * ldc + col0;
#pragma unroll
                for (int bj = 0; bj < 2; ++bj)
#pragma unroll
                    for (int n = 0; n < 2; ++n) {
                        const f32x4 v = acc[0][bj][m][n]; const float v0 = v[0], v1 = v[1], v2 = v[2], v3 = v[3];
                        unsigned long long* p = (unsigned long long*)(rowp + bj * HALF + 4 * n);
                        __hip_atomic_store(p, ((unsigned long long)__float_as_uint(v1) << 32) | __float_as_uint(v0), __ATOMIC_RELAXED, __HIP_MEMORY_SCOPE_AGENT);
                        __hip_atomic_store(p + 1, ((unsigned long long)__float_as_uint(v3) << 32) | __float_as_uint(v2), __ATOMIC_RELAXED, __HIP_MEMORY_SCOPE_AGENT); } }
        } else {
            const int row0 = u.pm * BM + u.roff + wr * 64 + fr;
#pragma unroll
            for (int ai = 0; ai < 2; ++ai) { if (ai == 1 && u.hm) break;
#pragma unroll
                for (int m = 0; m < 4; ++m) { bf16_t* rowp = O + (size_t)(row0 + ai * HALF + m * 16) * ldc + col0;
#pragma unroll
                    for (int bj = 0; bj < 2; ++bj) st16_wt(O, rowp + bj * HALF, pack8(acc[ai][bj][m][0], acc[ai][bj][m][1])); } }
        }
    }
};
template <int ACT> struct EpiGated {
    static constexpr bool PERM = true, AFTER_DRAIN = false;
    bf16_t* O; int ldc; const float* rstd;
    __device__ __forceinline__ void operator()(const f32x4 (&acc)[2][2][4][2], const Unit& u, int wr, int wc, int fr, int fq) const {
        const int row0 = u.pm * BM + u.roff + wr * 64 + fr, col0 = u.pn * HALF + wc * 32 + 8 * fq;
        float rsr[2][4];
#pragma unroll
        for (int ai = 0; ai < 2; ++ai)
#pragma unroll
            for (int m = 0; m < 4; ++m) rsr[ai][m] = rstd[row0 + ai * HALF + m * 16];
#pragma unroll
        for (int ai = 0; ai < 2; ++ai) { if (ai == 1 && u.hm) break;
#pragma unroll
            for (int m = 0; m < 4; ++m) { bf16_t* rowp = O + (size_t)(row0 + ai * HALF + m * 16) * ldc + col0; const float rs = rsr[ai][m];
                f32x4 v0, v1;
#pragma unroll
                for (int e = 0; e < 4; ++e) { const float g0 = acc[ai][0][m][0][e] * rs, g1 = acc[ai][0][m][1][e] * rs;
                    v0[e] = (ACT ? silu_f(g0) : g0) * (acc[ai][1][m][0][e] * rs); v1[e] = (ACT ? silu_f(g1) : g1) * (acc[ai][1][m][1][e] * rs); }
                *(u32x4*)rowp = pack8(v0, v1); } }
    }
};
struct EpiGatedI8 {
    static constexpr bool PERM = true, AFTER_DRAIN = false;
    bf16_t* O; int ldc; const float* rs; const float* sw;
    __device__ __forceinline__ void operator()(const f32x4 (&acc)[2][2][4][2], const Unit& u, int wr, int wc, int fr, int fq) const {
        const int row0 = u.pm * BM + u.roff + wr * 64 + fr, cl = wc * 32 + 8 * fq, col0 = u.pn * HALF + cl;
        const f32x4 sg0 = *(const f32x4*)(sw + u.pn * BM + cl) * -1.44269504089f, sg1 = *(const f32x4*)(sw + u.pn * BM + cl + 4) * -1.44269504089f,
                    su0 = *(const f32x4*)(sw + u.pn * BM + HALF + cl) * -0.69314718056f, su1 = *(const f32x4*)(sw + u.pn * BM + HALF + cl + 4) * -0.69314718056f;
        float rsr[2][4];
#pragma unroll
        for (int ai = 0; ai < 2; ++ai)
#pragma unroll
            for (int m = 0; m < 4; ++m) rsr[ai][m] = rs[row0 + ai * HALF + m * 16];
#pragma unroll
        for (int ai = 0; ai < 2; ++ai) { if (ai == 1 && u.hm) break;
#pragma unroll
            for (int m = 0; m < 4; ++m) { bf16_t* rowp = O + (size_t)(row0 + ai * HALF + m * 16) * ldc + col0; const float r = rsr[ai][m];
                f32x4 v0, v1;
#pragma unroll
                for (int e = 0; e < 4; ++e) {
                    const float ag0 = acc[ai][0][m][0][e], ag1 = acc[ai][0][m][1][e], au0 = acc[ai][1][m][0][e], au1 = acc[ai][1][m][1][e];
                    const float t0 = (float)__float_as_int(ag0) * (r * sg0[e]), t1 = (float)__float_as_int(ag1) * (r * sg1[e]);
                    const float u0 = (float)__float_as_int(au0) * (r * su0[e]), u1 = (float)__float_as_int(au1) * (r * su1[e]);
                    v0[e] = (t0 * u0) * __builtin_amdgcn_rcpf(1.0f + __builtin_amdgcn_exp2f(t0)); v1[e] = (t1 * u1) * __builtin_amdgcn_rcpf(1.0f + __builtin_amdgcn_exp2f(t1)); }
                st16_wt(O, rowp, pack8(v0, v1)); } }
    }
};
struct EpiConvIn {
    static constexpr bool PERM = true, AFTER_DRAIN = false;
    bf16_t* BG; bf16_t* Z; const float* rstd;
    __device__ __forceinline__ void operator()(const f32x4 (&acc)[2][2][4][2], const Unit& u, int wr, int wc, int fr, int fq) const {
        const int row0 = u.pm * BM + u.roff + wr * 64 + fr;
        float rsr[2][4];
#pragma unroll
        for (int ai = 0; ai < 2; ++ai)
#pragma unroll
            for (int m = 0; m < 4; ++m) rsr[ai][m] = rstd[row0 + ai * HALF + m * 16];
        if (u.pn < 8) {
            const int col0 = u.pn * BM + wc * 32 + 8 * fq;
#pragma unroll
            for (int ai = 0; ai < 2; ++ai) { if (ai == 1 && u.hm) break;
#pragma unroll
                for (int m = 0; m < 4; ++m) { bf16_t* rowp = BG + (size_t)(row0 + ai * HALF + m * 16) * 2048 + col0; const float rs = rsr[ai][m];
#pragma unroll
                    for (int bj = 0; bj < 2; ++bj) st16_wt(BG, rowp + bj * HALF, pack8(acc[ai][bj][m][0] * rs, acc[ai][bj][m][1] * rs)); } }
        } else {
            const int col0 = (u.pn - 8) * HALF + wc * 32 + 8 * fq;
#pragma unroll
            for (int ai = 0; ai < 2; ++ai) { if (ai == 1 && u.hm) break;
#pragma unroll
                for (int m = 0; m < 4; ++m) { bf16_t* rowp = Z + (size_t)(row0 + ai * HALF + m * 16) * 2048 + col0; const float rs = rsr[ai][m], rs2 = rs * rs;
                    st16_wt(Z, rowp, pack8(acc[ai][0][m][0] * acc[ai][1][m][0] * rs2, acc[ai][0][m][1] * acc[ai][1][m][1] * rs2)); } }
        }
    }
};
struct EpiGeluSplit {
    static constexpr bool PERM = true, AFTER_DRAIN = false;
    bf16_t* U; bf16_t* V; const float* rstd;
    __device__ __forceinline__ void operator()(const f32x4 (&acc)[2][2][4][2], const Unit& u, int wr, int wc, int fr, int fq) const {
        const int row0 = u.pm * BM + u.roff + wr * 64 + fr, col0 = (u.pn & 7) * BM + wc * 32 + 8 * fq;
        bf16_t* base = (u.pn < 8) ? U : V;
        float rsr[2][4];
#pragma unroll
        for (int ai = 0; ai < 2; ++ai)
#pragma unroll
            for (int m = 0; m < 4; ++m) rsr[ai][m] = rstd[row0 + ai * HALF + m * 16];
#pragma unroll
        for (int ai = 0; ai < 2; ++ai) { if (ai == 1 && u.hm) break;
#pragma unroll
            for (int m = 0; m < 4; ++m) { bf16_t* rowp = base + (size_t)(row0 + ai * HALF + m * 16) * 2048 + col0; const float rs = rsr[ai][m];
#pragma unroll
                for (int bj = 0; bj < 2; ++bj) { f32x4 v0, v1;
#pragma unroll
                    for (int e = 0; e < 4; ++e) { v0[e] = gelu_tanh_f(acc[ai][bj][m][0][e] * rs); v1[e] = gelu_tanh_f(acc[ai][bj][m][1][e] * rs); }
                    st16_wt(base, rowp + bj * HALF, pack8(v0, v1)); } } }
    }
};
struct EpiQKV {
    static constexpr bool PERM = true, AFTER_DRAIN = false;
    bf16_t* O; const float* rope_c; const float* rope_s; const float* rstd;
    __device__ __forceinline__ void operator()(const f32x4 (&acc)[2][2][4][2], const Unit& u, int wr, int wc, int fr, int fq) const {
        const int row0 = u.pm * BM + u.roff + wr * 64 + fr, col0 = u.pn * BM + wc * 32 + 8 * fq;
        const bool rot_tile = (u.pn < 9) && ((wc & 1) == 0);
        const bool rot_lane = fq < 2;
        const float sgn = (fq == 0) ? -1.0f : 1.0f;
#pragma unroll
        for (int ai = 0; ai < 2; ++ai) { if (ai == 1 && u.hm) break;
#pragma unroll
            for (int m = 0; m < 4; ++m) { const int row = row0 + ai * HALF + m * 16; bf16_t* rowp = O + (size_t)row * 2560 + col0; const float rs = rstd[row];
                if (rot_tile) {
                    const int slot = row < 8192 ? (row & 4095) : (row < 8320 ? 4096 + ((row - 8192) & 3) : 0);
                    const f32x4 c0 = *(const f32x4*)(rope_c + slot * 8), c1 = *(const f32x4*)(rope_c + slot * 8 + 4);
                    const f32x4 s0 = *(const f32x4*)(rope_s + slot * 8), s1 = *(const f32x4*)(rope_s + slot * 8 + 4);
#pragma unroll
                    for (int bj = 0; bj < 2; ++bj) { f32x4 v0 = acc[ai][bj][m][0] * rs, v1 = acc[ai][bj][m][1] * rs, o0, o1;
#pragma unroll
                        for (int e = 0; e < 4; ++e) { o0[e] = __shfl_xor(v0[e], 16); o1[e] = __shfl_xor(v1[e], 16); }
                        if (rot_lane) {
#pragma unroll
                            for (int e = 0; e < 4; ++e) { v0[e] = v0[e] * c0[e] + sgn * o0[e] * s0[e]; v1[e] = v1[e] * c1[e] + sgn * o1[e] * s1[e]; } }
                        st16_wt(O, rowp + bj * HALF, pack8(v0, v1)); }
                } else {
#pragma unroll
                    for (int bj = 0; bj < 2; ++bj) st16_wt(O, rowp + bj * HALF, pack8(acc[ai][bj][m][0] * rs, acc[ai][bj][m][1] * rs));
                }
            } }
    }
};


template <class Epi, class Sched, bool ALIGN_EPI = false, bool SP2 = false, bool I8 = false>
__device__ __forceinline__ void gemm_phase(PG8_LAS unsigned char* lds, const Gemm g, const Sched& S, const Epi& E) {
    int tid_ = threadIdx.x; asm volatile("" : "+v"(tid_));
    const int tid = tid_, wid = __builtin_amdgcn_readfirstlane(tid >> 6), lane = tid & 63, wr = wid >> 2, wc = wid & 3, fr = lane & 15, fq = lane >> 4;
    const int LD = g.K;
    unsigned voffA[2], voffB[2];
#pragma unroll
    for (int i = 0; i < 2; ++i) { int R, C; stage_rc(tid * 16 + i * 8192, R, C); const int Rb = Epi::PERM ? ((R & ~31) + perm32(R & 31)) : R;
        voffA[i] = (unsigned)(R * LD + C) * 2u; voffB[i] = (unsigned)(Rb * LD + C) * 2u; }
    const size_t kstep = (size_t)(BK * 2);
    const size_t hstep = (size_t)HALF * LD * 2;
    const size_t tstep = 2 * hstep;
    const unsigned ldsw = (unsigned)wid * 1024u;
    const int aoff = lds_byte(wr * 64 + fr, fq * 8), boff = lds_byte(wc * 32 + fr, fq * 8);
#define PG8_SA(b, h) (((b) * 2 + (h)) * HTB)
#define PG8_SB(b, h) ((4 + (b) * 2 + (h)) * HTB)
#define PG8_STAGE(bufoff, gbase, voff) do { _Pragma("unroll") for (int _i = 0; _i < 2; ++_i) \
        __builtin_amdgcn_global_load_lds((const unsigned*)((const char*)(gbase) + (voff)[_i]), (PG8_LAS unsigned*)(lds + (bufoff) + ldsw + _i * 8192), 16, 0, 0); } while (0)
#define PG8_LDA(dst, b, h) do { _Pragma("unroll") for (int m = 0; m < 4; ++m) _Pragma("unroll") for (int k = 0; k < 2; ++k) dst[m][k] = *(const PG8_LAS bf16x8*)(lds + PG8_SA(b, h) + aoff + m * 2048 + k * 1024); } while (0)
#define PG8_LDB(dst, b, h) do { _Pragma("unroll") for (int n = 0; n < 2; ++n) _Pragma("unroll") for (int k = 0; k < 2; ++k) dst[n][k] = *(const PG8_LAS bf16x8*)(lds + PG8_SB(b, h) + boff + n * 2048 + k * 1024); } while (0)
#define PG8_MMA(ai, bj, At, Bt) do { __builtin_amdgcn_s_setprio(1); _Pragma("unroll") for (int m = 0; m < 4; ++m) _Pragma("unroll") for (int n = 0; n < 2; ++n) _Pragma("unroll") for (int k = 0; k < 2; ++k) \
        { if constexpr (I8) acc[ai][bj][m][n] = __builtin_bit_cast(f32x4, __builtin_amdgcn_mfma_i32_16x16x64_i8(__builtin_bit_cast(i32x4, Bt[n][k]), __builtin_bit_cast(i32x4, At[m][k]), __builtin_bit_cast(i32x4, acc[ai][bj][m][n]), 0, 0, 0)); \
          else acc[ai][bj][m][n] = __builtin_amdgcn_mfma_f32_16x16x32_bf16(Bt[n][k], At[m][k], acc[ai][bj][m][n], 0, 0, 0); } __builtin_amdgcn_s_setprio(0); } while (0)
#define PG8_WAIT_V(n) asm volatile("s_waitcnt vmcnt(" #n ")" ::: "memory")
#define PG8_WAIT_L(n) asm volatile("s_waitcnt lgkmcnt(" #n ")" ::: "memory")
#define PG8_BAR __builtin_amdgcn_s_barrier()
#define PG8_SCHED __builtin_amdgcn_sched_barrier(0)
    Unit cur, nxt; int ui = 0;
    if (!S.next(0, cur)) return;
    f32x4 acc[2][2][4][2];
#pragma unroll
    for (int a = 0; a < 2; ++a)
#pragma unroll
        for (int b = 0; b < 2; ++b)
#pragma unroll
            for (int m = 0; m < 4; ++m)
#pragma unroll
                for (int n = 0; n < 2; ++n) acc[a][b][m][n] = (f32x4){0.f, 0.f, 0.f, 0.f};
    bf16x8 At[4][2], B0[2][2], B1[2][2];
    int nt = cur.nt; bool hm = cur.hm != 0;
#define PG8_KOFFB(u) ((size_t)(u).ks * (size_t)(u).nt * (BK * 2))
#define PG8_KOFF(u) ((size_t)(u).ks * (size_t)(u).nt * (BK * 2) + (size_t)(u).roff * (size_t)LD * 2)
    const char* cA = (const char*)g.A + (size_t)cur.pm * tstep + PG8_KOFF(cur); const char* cB = (const char*)g.Bt + (size_t)cur.pn * tstep + PG8_KOFFB(cur);
    S.a_ready(cur);
    if constexpr (SP2) {
        PG8_STAGE(PG8_SB(0, 0), cB, voffB); PG8_STAGE(PG8_SB(0, 1), cB + hstep, voffB); PG8_STAGE(PG8_SA(0, 0), cA, voffA); PG8_STAGE(PG8_SA(0, 1), cA + hstep, voffA);
        if (wr == 1) PG8_BAR;
        PG8_WAIT_V(2); PG8_BAR;
        PG8_STAGE(PG8_SB(1, 0), cB + kstep, voffB); PG8_STAGE(PG8_SA(1, 0), cA + kstep, voffA); PG8_STAGE(PG8_SB(1, 1), cB + hstep + kstep, voffB);
        PG8_WAIT_V(6); PG8_BAR;
    } else {
        PG8_STAGE(PG8_SB(0, 0), cB, voffB); PG8_STAGE(PG8_SA(0, 0), cA, voffA); PG8_STAGE(PG8_SB(0, 1), cB + hstep, voffB); PG8_STAGE(PG8_SA(0, 1), cA + hstep, voffA);
        if (wr == 1) PG8_BAR;
        PG8_WAIT_V(4); PG8_BAR;
        PG8_STAGE(PG8_SB(1, 0), cB + kstep, voffB); PG8_STAGE(PG8_SA(1, 0), cA + kstep, voffA); PG8_STAGE(PG8_SB(1, 1), cB + hstep + kstep, voffB);
        PG8_WAIT_V(6); PG8_BAR;
    }
    for (;;) {
        const bool has_next = S.next(ui + 1, nxt);
        const char* nA = has_next ? (const char*)g.A + (size_t)nxt.pm * tstep + PG8_KOFF(nxt) : cA; const char* nB = has_next ? (const char*)g.Bt + (size_t)nxt.pn * tstep + PG8_KOFFB(nxt) : cB;
        for (int t = 0; t < nt; t += 2) {
            const bool last = (t == nt - 2);
            const char* a1 = cA + (size_t)(t + 1) * kstep;
            const char* a2 = last ? nA : cA + (size_t)(t + 2) * kstep; const char* b2 = last ? nB : cB + (size_t)(t + 2) * kstep;
            const char* a3 = a2 + kstep; const char* b3 = b2 + kstep;
            if (last && has_next) S.a_ready(nxt);
            if constexpr (SP2) {
            PG8_LDB(B0, 0, 0); PG8_LDB(B1, 0, 1); PG8_SCHED; PG8_LDA(At, 0, 0); PG8_STAGE(PG8_SA(1, 1), a1 + hstep, voffA);
            PG8_WAIT_V(8); PG8_WAIT_L(0); PG8_BAR; PG8_MMA(0, 0, At, B0); PG8_MMA(0, 1, At, B1); PG8_BAR; PG8_SCHED;
            if (!hm) { PG8_LDA(At, 0, 1); } PG8_STAGE(PG8_SB(0, 0), b2, voffB); PG8_STAGE(PG8_SB(0, 1), b2 + hstep, voffB); PG8_STAGE(PG8_SA(0, 0), a2, voffA);
            PG8_WAIT_V(8); PG8_WAIT_L(0); PG8_BAR; if (!hm) { PG8_MMA(1, 0, At, B0); PG8_MMA(1, 1, At, B1); } PG8_BAR; PG8_SCHED;
            PG8_LDB(B0, 1, 0); PG8_LDB(B1, 1, 1); PG8_SCHED; PG8_LDA(At, 1, 0); PG8_STAGE(PG8_SA(0, 1), a2 + hstep, voffA);
            PG8_WAIT_V(8); PG8_WAIT_L(0); PG8_BAR; PG8_MMA(0, 0, At, B0); PG8_MMA(0, 1, At, B1); PG8_BAR; PG8_SCHED;
            if (!hm) { PG8_LDA(At, 1, 1); } PG8_STAGE(PG8_SB(1, 0), b3, voffB); PG8_STAGE(PG8_SB(1, 1), b3 + hstep, voffB); PG8_STAGE(PG8_SA(1, 0), a3, voffA);
            PG8_WAIT_V(8); PG8_WAIT_L(0); PG8_BAR; if (!hm) { PG8_MMA(1, 0, At, B0); PG8_MMA(1, 1, At, B1); } PG8_BAR; PG8_SCHED;
            } else {
            PG8_LDB(B0, 0, 0); PG8_SCHED; PG8_LDA(At, 0, 0); PG8_STAGE(PG8_SA(1, 1), a1 + hstep, voffA);
            PG8_WAIT_L(8); PG8_BAR; PG8_WAIT_L(0); PG8_MMA(0, 0, At, B0); PG8_BAR; PG8_SCHED;
            PG8_LDB(B1, 0, 1); PG8_STAGE(PG8_SB(0, 0), b2, voffB);
            PG8_BAR; PG8_WAIT_L(0); PG8_MMA(0, 1, At, B1); PG8_BAR;
            PG8_LDA(At, 0, 1); PG8_STAGE(PG8_SA(0, 0), a2, voffA);
            PG8_BAR; PG8_WAIT_L(0); PG8_MMA(1, 0, At, B0); PG8_BAR; PG8_SCHED;
            PG8_STAGE(PG8_SB(0, 1), b2 + hstep, voffB);
            PG8_WAIT_V(6); PG8_BAR; PG8_MMA(1, 1, At, B1); PG8_BAR;
            PG8_LDB(B0, 1, 0); PG8_SCHED; PG8_LDA(At, 1, 0); PG8_STAGE(PG8_SA(0, 1), a2 + hstep, voffA);
            PG8_WAIT_L(8); PG8_BAR; PG8_WAIT_L(0); PG8_MMA(0, 0, At, B0); PG8_BAR; PG8_SCHED;
            PG8_LDB(B1, 1, 1); PG8_STAGE(PG8_SB(1, 0), b3, voffB);
            PG8_BAR; PG8_WAIT_L(0); PG8_MMA(0, 1, At, B1); PG8_BAR;
            PG8_LDA(At, 1, 1); PG8_STAGE(PG8_SA(1, 0), a3, voffA);
            PG8_BAR; PG8_WAIT_L(0); PG8_MMA(1, 0, At, B0); PG8_BAR; PG8_SCHED;
            PG8_STAGE(PG8_SB(1, 1), b3 + hstep, voffB);
            PG8_WAIT_V(6); PG8_BAR; PG8_MMA(1, 1, At, B1); PG8_BAR;
            }
        }
        if constexpr (ALIGN_EPI) { if (wr == 0) PG8_BAR; }
        if constexpr (!Epi::AFTER_DRAIN) { E(acc, cur, wr, wc, fr, fq); S.done(cur); }
        if (!has_next) break;
#pragma unroll
        for (int a = 0; a < 2; ++a)
#pragma unroll
            for (int b = 0; b < 2; ++b)
#pragma unroll
                for (int m = 0; m < 4; ++m)
#pragma unroll
                    for (int n = 0; n < 2; ++n) acc[a][b][m][n] = (f32x4){0.f, 0.f, 0.f, 0.f};
        cur = nxt; cA = nA; cB = nB; ++ui; nt = cur.nt; hm = cur.hm != 0;
        if constexpr (ALIGN_EPI) { if (wr == 1) PG8_BAR; }
    }
    PG8_WAIT_V(0);
    if constexpr (!ALIGN_EPI) { if (wr == 0) PG8_BAR; }
    PG8_BAR;
    if constexpr (Epi::AFTER_DRAIN) { E.fused(acc, cur, wr, wc, fr, fq, lds, wid, lane); S.done(cur); }
#undef PG8_KOFF
#undef PG8_KOFFB
#undef PG8_SA
#undef PG8_SB
#undef PG8_STAGE
#undef PG8_LDA
#undef PG8_LDB
#undef PG8_MMA
#undef PG8_WAIT_V
#undef PG8_WAIT_L
#undef PG8_BAR
#undef PG8_SCHED
}
}

constexpr int NWAVES = 8;
constexpr int D = 2048, DFF = 5632, NGU = 2 * DFF, SEQ = 4096, NBATCH = 2, MP = NBATCH * SEQ, DBATCH = 32, DSEQ = 4, MS = DBATCH * DSEQ;
constexpr int MR = MP + MS;
constexpr int M = 8448;
constexpr int NQKV = 2560, NCIN = 6144, NSIN = 4096;
constexpr int BM_ROWS = 256;
constexpr float RMS_EPS = 1e-6f, LN_EPS = 1e-5f, LOG2E = 1.4426950408889634f;
constexpr size_t OFF_Y = 0, OFF_KP = (size_t)MR * D, OFF_VP = OFF_KP + 131072, OFF_KS = OFF_VP + 131072, OFF_VS = OFF_KS + 2097152,
                 OFF_CP = OFF_VS + 2097152, OFF_CS = OFF_CP + 8192, OFF_SV = OFF_CS + 131072, OUT_TOTAL = OFF_SV + 262144;
constexpr size_t MiB = 1u << 20;
constexpr size_t WS_CTL = 0, CTL_ZERO_BYTES = 128 * 1024;
constexpr size_t WS_ROPE = 1 * MiB;
constexpr size_t WS_RSTD = WS_ROPE + 512 * 1024;
constexpr size_t WS_H = 2 * MiB;
constexpr size_t WS_ACT = 35 * MiB;
constexpr size_t WS_OUTF = 126 * MiB;
constexpr size_t WS_QKV = 192 * MiB;
constexpr size_t WS_O = 234 * MiB;
constexpr size_t WS_BG = 267 * MiB;
constexpr size_t WS_Z = 300 * MiB;
constexpr size_t WS_VLN = 333 * MiB;
constexpr size_t WS_WFFN = 368 * MiB;
constexpr size_t WFFN_STRIDE = 66 * MiB, WD_OFF = 44 * MiB;
constexpr size_t WS_WATT = WS_WFFN + 8 * WFFN_STRIDE;
constexpr size_t WATT_STRIDE = 18 * MiB, WO_OFF = 10 * MiB;
constexpr size_t WS_WCONV = WS_WATT + 2 * WATT_STRIDE;
constexpr size_t WCOUT_OFF = 24 * MiB;
constexpr size_t WS_WSGU = WS_WCONV + 32 * MiB;
constexpr size_t WSOUT_OFF = 16 * MiB;
constexpr size_t WS_PART = WS_WSGU + 24 * MiB;
constexpr size_t PART_SLAB = (size_t)MS * D;
constexpr int NSPLIT_FFN = 11, NSPLIT_MIX = 4;
constexpr size_t WS_XQ8 = WS_PART + 24 * MiB;
constexpr size_t WS_SW = WS_XQ8 + 17 * MiB;
constexpr size_t WS_RS8 = WS_SW + 512 * 1024;
constexpr size_t WS_END = WS_SW + 1 * MiB;
constexpr int CW_TICKET = 24576;
constexpr int CW_BAR = 4096;
constexpr int RING_BYTES = 133120  , LDSCTL_OFF = RING_BYTES, MISC_OFF = LDSCTL_OFF + 320, LDS_BYTES = 147456;

#define GAS __attribute__((address_space(1)))
#define LAS __attribute__((address_space(3)))
typedef unsigned short bf16;
typedef unsigned v4u __attribute__((ext_vector_type(4)));
typedef unsigned v2u __attribute__((ext_vector_type(2)));
typedef float f32x4 __attribute__((ext_vector_type(4)));
typedef float f32x16 __attribute__((ext_vector_type(16)));
typedef short bf16x8 __attribute__((ext_vector_type(8)));
typedef short s16x4 __attribute__((ext_vector_type(4)));
#define LDS_WAIT() asm volatile("s_waitcnt lgkmcnt(0)" ::: "memory")
typedef float f32x2_cv __attribute__((ext_vector_type(2))); typedef __bf16 bf16x2_cv __attribute__((ext_vector_type(2)));
__device__ __forceinline__ unsigned pk2(float lo, float hi) { const f32x2_cv v = {lo, hi}; const bf16x2_cv b = __builtin_convertvector(v, bf16x2_cv); return __builtin_bit_cast(unsigned, b); }
__device__ __forceinline__ unsigned f2bf(float f) { return pk2(f, f) & 0xffffu; }
__device__ __forceinline__ float bf2f(unsigned short h) { return __builtin_bit_cast(float, (unsigned)h << 16); }
__device__ __forceinline__ float bflo(unsigned w) { return __builtin_bit_cast(float, w << 16); }
__device__ __forceinline__ float bfhi(unsigned w) { return __builtin_bit_cast(float, w & 0xffff0000u); }
#define XB_TMO      128
#define XB_XCNT(j)  (256  + 64 * (j))
#define XB_XSUB(j)  (1280 + 64 * (j))
#define XB_XGEN(j)  (2304 + 64 * (j))
#define XB_TOP      3328
#define XB_TOPGEN   3392
#define XCD_BAR_WORDS 3456
#define XB_SPIN_CAP (1u << 18)

__device__ __forceinline__ unsigned xb_ld(unsigned* p)              { return __hip_atomic_load(p, __ATOMIC_RELAXED, __HIP_MEMORY_SCOPE_AGENT); }
__device__ __forceinline__ unsigned xb_add(unsigned* p, unsigned v) { return __hip_atomic_fetch_add(p, v, __ATOMIC_RELAXED, __HIP_MEMORY_SCOPE_AGENT); }
__device__ __forceinline__ unsigned xb_xcc_id() { return (unsigned)__builtin_amdgcn_s_getreg((3 << 11) | 20) & 0xFu; }
#define XB_SPIN(cond, bar) do { unsigned _sp = 0; while (cond) { __builtin_amdgcn_s_sleep(1); \
    if ((++_sp & 255u) == 0u) { if (xb_ld(&(bar)[XB_TMO])) break; if (_sp > XB_SPIN_CAP) { atomicAdd(&(bar)[XB_TMO], 1u); break; } } } } while (0)

struct XcdBarrier {
    unsigned* bar; unsigned x;
    volatile LAS unsigned* st;
};

__device__ __forceinline__ XcdBarrier xcd_barrier_post(unsigned* bar, volatile LAS unsigned* st) {
    XcdBarrier b; b.bar = bar; b.x = xb_xcc_id(); b.st = st;
    if (threadIdx.x == 0) (void)xb_add(&bar[XB_XCNT(b.x)], 1u);
    return b;
}
__device__ __forceinline__ void xcd_barrier_complete(unsigned* bar, unsigned x, unsigned& nloc, unsigned& nx) {
    const unsigned G = gridDim.x * gridDim.y * gridDim.z;
    unsigned sum, cnt, mine, sp = 0u;
    for (;;) {
        sum = 0u; cnt = 0u; mine = 0u;
#pragma unroll
        for (unsigned j = 0; j < 16; ++j) { const unsigned c = xb_ld(&bar[XB_XCNT(j)]); sum += c; cnt += (c > 0u) ? 1u : 0u; mine = (j == x) ? c : mine; }
        if (sum == G) break;
        __builtin_amdgcn_s_sleep(1);
        if ((++sp & 255u) == 0u) { if (xb_ld(&bar[XB_TMO])) break; if (sp > XB_SPIN_CAP) { atomicAdd(&bar[XB_TMO], 1u); break; } }
    }
    nloc = mine > 0u ? mine : 1u; nx = cnt > 0u ? cnt : 1u;
}

__device__ __forceinline__ void xcd_barrier(const XcdBarrier& b) {
    asm volatile("s_waitcnt vmcnt(0)" ::: "memory");
    __syncthreads();
    if (threadIdx.x == 0) {
        unsigned* bar = b.bar;
        __builtin_amdgcn_s_waitcnt(0);
        unsigned nloc = b.st[0], nx = b.st[1];
        if (nloc == 0u) { xcd_barrier_complete(bar, b.x, nloc, nx); b.st[0] = nloc; b.st[1] = nx; }
        const unsigned old = xb_add(&bar[XB_XSUB(b.x)], 1u);
        const unsigned gen = old / nloc;
        if (old + 1u == (gen + 1u) * nloc) {
            __builtin_amdgcn_fence(__ATOMIC_RELEASE, "agent");
            asm volatile("s_waitcnt vmcnt(0)" ::: "memory");
            const unsigned og = xb_add(&bar[XB_TOP], 1u);
            const unsigned tg = og / nx;
            if (og + 1u == (tg + 1u) * nx) xb_add(&bar[XB_TOPGEN], 1u);
            else XB_SPIN(xb_ld(&bar[XB_TOPGEN]) == tg, bar);
            __builtin_amdgcn_fence(__ATOMIC_ACQUIRE, "agent");
            xb_add(&bar[XB_XGEN(b.x)], 1u);
            asm volatile("s_waitcnt vmcnt(0)" ::: "memory");
        } else {
            XB_SPIN(xb_ld(&bar[XB_XGEN(b.x)]) == gen, bar);
            __builtin_amdgcn_fence(__ATOMIC_ACQUIRE, "agent");
            asm volatile("s_waitcnt vmcnt(0)" ::: "memory");
        }
    }
    __syncthreads();
}

struct Frame {
    LAS unsigned char* lds;
    int tid, lane, wave, vcu, G;
    const float* in[20];
    float* out;
    unsigned char* ws;
};
#define IN_XP 0
#define IN_XS 1
#define IN_CK 2
#define IN_CV 3
#define IN_SC 4
#define IN_NG 5
#define IN_WGU 6
#define IN_WD 7
#define IN_WQKV 8
#define IN_WO 9
#define IN_SINK 10
#define IN_CWIN 11
#define IN_CW 12
#define IN_CWOUT 13
#define IN_SWIN 14
#define IN_SLNG 15
#define IN_SLNB 16
#define IN_SWS 17
#define IN_SBS 18
#define IN_SWOUT 19

template <int CTRL, int RM> __device__ __forceinline__ float dpp_or0(float v) { return __builtin_bit_cast(float, __builtin_amdgcn_update_dpp(0, __builtin_bit_cast(int, v), CTRL, RM, 0xF, true)); }
template <int CTRL, int RM> __device__ __forceinline__ float dpp_self(float v) { return __builtin_bit_cast(float, __builtin_amdgcn_update_dpp(__builtin_bit_cast(int, v), __builtin_bit_cast(int, v), CTRL, RM, 0xF, false)); }
__device__ __forceinline__ float wave_sum(float v) {
    v += dpp_or0<0xB1, 0xF>(v); v += dpp_or0<0x4E, 0xF>(v); v += dpp_or0<0x141, 0xF>(v); v += dpp_or0<0x140, 0xF>(v); v += dpp_or0<0x142, 0xA>(v); v += dpp_or0<0x143, 0xC>(v);
    return __builtin_bit_cast(float, __builtin_amdgcn_readlane(__builtin_bit_cast(int, v), 63));
}
__device__ __forceinline__ float wave_max(float v) {
    v = fmaxf(v, dpp_self<0xB1, 0xF>(v)); v = fmaxf(v, dpp_self<0x4E, 0xF>(v)); v = fmaxf(v, dpp_self<0x141, 0xF>(v)); v = fmaxf(v, dpp_self<0x140, 0xF>(v));
    v = fmaxf(v, dpp_self<0x142, 0xA>(v)); v = fmaxf(v, dpp_self<0x143, 0xC>(v));
    return __builtin_bit_cast(float, __builtin_amdgcn_readlane(__builtin_bit_cast(int, v), 63));
}

__device__ __forceinline__ int opq(int v) { asm volatile("" : "+v"(v)); return v; }
__device__ __forceinline__ int src_col_base(int kind, int db) {
    if (kind == 0) return db * 128;
    if (kind == 1) return (db & 1) * DFF + (db >> 1) * 128;
    if (db < 16) return db * 128;
    const int e = db - 16; return 2048 + (e & 1) * 2048 + (e >> 1) * 128;
}
constexpr int CVT_SCR = 64 * 65 * 4;
__device__ __forceinline__ void cvt_load(const float* W, int ldn, int nb0, int nbn, int kind, int item, int lane, f32x4 (&v)[16], const float* gfold) {
    const int kb = item / nbn, nb = nb0 + item % nbn, k0 = 64 * kb, n0 = 64 * nb;
    const int scol = src_col_base(kind, n0 >> 7) + (n0 & 127);
    const int r4 = lane >> 4, c16 = lane & 15;
#pragma unroll
    for (int i = 0; i < 16; ++i) v[i] = __builtin_nontemporal_load((const GAS f32x4*)(W + (size_t)(k0 + 4 * i + r4) * ldn + scol + c16 * 4));
    if (gfold) {
#pragma unroll
        for (int i = 0; i < 16; ++i) v[i] = v[i] * gfold[k0 + 4 * i + r4]; }
}
__device__ __forceinline__ void cvt_store(const f32x4 (&v)[16], int K, int nb0, int nbn, bf16* WT, LAS float* scr, int item, int lane) {
    const int kb = item / nbn, nb = nb0 + item % nbn, k0 = 64 * kb, n0 = 64 * nb;
    const int r4 = lane >> 4, c16 = lane & 15;
#pragma unroll
    for (int i = 0; i < 16; ++i) { LAS float* d = scr + (4 * i + r4) * 65 + c16 * 4; d[0] = v[i].x; d[1] = v[i].y; d[2] = v[i].z; d[3] = v[i].w; }
    LDS_WAIT(); asm volatile("" ::: "memory");
    const int rr = lane >> 3, c = lane & 7;
#pragma unroll
    for (int j = 0; j < 8; ++j) { const int n = rr + 8 * j; const LAS float* s = scr + (8 * c) * 65 + n;
        v4u o; o.x = pk2(s[0 * 65], s[1 * 65]); o.y = pk2(s[2 * 65], s[3 * 65]); o.z = pk2(s[4 * 65], s[5 * 65]); o.w = pk2(s[6 * 65], s[7 * 65]);
        *(GAS v4u*)(WT + (size_t)(n0 + n) * K + k0 + 8 * c) = o; }
    LDS_WAIT(); asm volatile("" ::: "memory");
}
__device__ __forceinline__ void convert_matrix(Frame& F, const float* W, int ldn, int K, int Nd, int kind, bf16* WT, int& off, int wg0, int nwg, int p0, int p1, const float* gfold) {
    const int tid = opq(F.tid), lane = tid & 63;
    LAS float* scr = (LAS float*)(F.lds + F.wave * CVT_SCR);
    const int gw = ((int)blockIdx.x - wg0) * NWAVES + F.wave, NGW = nwg * NWAVES;
    const int nblk = Nd / 64, nb0 = nblk * p0 / 2, nbn = nblk * p1 / 2 - nb0;
    const int items = (K / 64) * nbn;
    int first = gw - off; if (first < 0) first += NGW;
    off = (off + items) % NGW;
    if (first >= items) return;
    f32x4 va[16], vb[16];
    cvt_load(W, ldn, nb0, nbn, kind, first, lane, va, gfold);
    for (int it = first; it < items; it += 2 * NGW) {
        if (it + NGW < items) cvt_load(W, ldn, nb0, nbn, kind, it + NGW, lane, vb, gfold);
        cvt_store(va, K, nb0, nbn, WT, scr, it, lane);
#ifdef CVT_SLEEP
        if (wg0 != 0) __builtin_amdgcn_s_sleep(CVT_SLEEP);
#endif
        if (it + NGW >= items) break;
        if (it + 2 * NGW < items) cvt_load(W, ldn, nb0, nbn, kind, it + 2 * NGW, lane, va, gfold);
        cvt_store(vb, K, nb0, nbn, WT, scr, it + NGW, lane);
#ifdef CVT_SLEEP
        if (wg0 != 0) __builtin_amdgcn_s_sleep(CVT_SLEEP);
#endif
    }
}
constexpr int CVT_RED_OFF = 135168;
constexpr int T2_PITCH = 4104;
__device__ __forceinline__ void convert_wgu_i8(Frame& F, int gi) {
    const int tid = opq(F.tid), lane = tid & 63;
    LAS unsigned char* T2 = F.lds; LAS float* red = (LAS float*)(F.lds + CVT_RED_OFF);
    const int r8 = lane >> 3, c8 = lane & 7;
    {
        const int lh = gi / 352, it = gi % 352;
        const float* W = F.in[IN_WGU] + (size_t)lh * D * NGU; const float* g = F.in[IN_NG] + (size_t)((lh >> 1) * 6 + 4 * (lh & 1)) * D;
        unsigned char* W8 = F.ws + WS_WFFN + (size_t)lh * WFFN_STRIDE; float* SW = (float*)(F.ws + WS_SW) + (size_t)lh * NGU;
        const int n0 = 32 * it, scol = src_col_base(1, n0 >> 7) + (n0 & 127);
        const float* Wc = W + scol + c8 * 4;
        f32x4 mx = (f32x4){0.f, 0.f, 0.f, 0.f};
#pragma unroll 1
        for (int b = 0; b < 4; ++b) {
            f32x4 v[8];
#pragma unroll
            for (int i = 0; i < 8; ++i) v[i] = __builtin_nontemporal_load((const GAS f32x4*)(Wc + (size_t)(F.wave * 256 + (b * 8 + i) * 8 + r8) * NGU));
#pragma unroll
            for (int i = 0; i < 8; ++i) { const int k = F.wave * 256 + (b * 8 + i) * 8 + r8; const float gg = g[k]; const f32x4 t = v[i] * gg;
                mx.x = fmaxf(mx.x, fabsf(t.x)); mx.y = fmaxf(mx.y, fabsf(t.y)); mx.z = fmaxf(mx.z, fabsf(t.z)); mx.w = fmaxf(mx.w, fabsf(t.w));
                LAS unsigned char* d = T2 + (c8 * 4) * T2_PITCH + k * 2;
                *(LAS unsigned short*)(d) = (unsigned short)f2bf(t.x); *(LAS unsigned short*)(d + T2_PITCH) = (unsigned short)f2bf(t.y);
                *(LAS unsigned short*)(d + 2 * T2_PITCH) = (unsigned short)f2bf(t.z); *(LAS unsigned short*)(d + 3 * T2_PITCH) = (unsigned short)f2bf(t.w); }
        }
#pragma unroll
        for (int o = 8; o < 64; o <<= 1) { mx.x = fmaxf(mx.x, __shfl_xor(mx.x, o)); mx.y = fmaxf(mx.y, __shfl_xor(mx.y, o)); mx.z = fmaxf(mx.z, __shfl_xor(mx.z, o)); mx.w = fmaxf(mx.w, __shfl_xor(mx.w, o)); }
        if (r8 == 0) *(LAS f32x4*)(red + F.wave * 32 + c8 * 4) = mx;
        __syncthreads();
#pragma unroll
        for (int q = 0; q < 4; ++q) { const int n = F.wave * 4 + q;
            float m = red[n];
#pragma unroll
            for (int w = 1; w < 8; ++w) m = fmaxf(m, red[w * 32 + n]);
            m = fmaxf(m, 1e-30f);
            if (lane == 0) SW[n0 + n] = m * (1.0f / 127.0f);
            const float inv = 127.0f / m;
#pragma unroll
            for (int j = 0; j < 4; ++j) { const int kc = (lane + 64 * j) * 8;
                const v2u lo = *(const LAS v2u*)(T2 + n * T2_PITCH + kc * 2), hi = *(const LAS v2u*)(T2 + n * T2_PITCH + kc * 2 + 8);
                const unsigned b0 = (unsigned)(int)__builtin_rintf(bflo(lo.x) * inv) & 0xffu, b1 = (unsigned)(int)__builtin_rintf(bfhi(lo.x) * inv) & 0xffu;
                const unsigned b2 = (unsigned)(int)__builtin_rintf(bflo(lo.y) * inv) & 0xffu, b3 = (unsigned)(int)__builtin_rintf(bfhi(lo.y) * inv) & 0xffu;
                const unsigned b4 = (unsigned)(int)__builtin_rintf(bflo(hi.x) * inv) & 0xffu, b5 = (unsigned)(int)__builtin_rintf(bfhi(hi.x) * inv) & 0xffu;
                const unsigned b6 = (unsigned)(int)__builtin_rintf(bflo(hi.y) * inv) & 0xffu, b7 = (unsigned)(int)__builtin_rintf(bfhi(hi.y) * inv) & 0xffu;
                v2u w; w.x = b0 | (b1 << 8) | (b2 << 16) | (b3 << 24); w.y = b4 | (b5 << 8) | (b6 << 16) | (b7 << 24);
                *(GAS v2u*)(W8 + (size_t)(n0 + n) * D + kc) = w; } }
        __syncthreads();
    }
}
constexpr int CVT_NI8 = 8 * 352, CVT_NCH = (8 * 2816 + 2 * (1280 + 1024) + (3072 + 1024) + (2048 + 1024)) / 16;
__device__ __forceinline__ void convert_bf_chunk(Frame& F, int c) {
    const int tid = opq(F.tid), lane = tid & 63;
    int it = c * 16;
    const float* W = nullptr; int ldn = 0, K = 0, Nd = 0, kind = 0; bf16* WT = nullptr; const float* gf = nullptr; bool found = false;
#pragma unroll 1
    for (int sl = 0; sl < 12 && !found; ++sl) {
        const int layer = sl / 3, pos = sl % 3;
        if (pos != 1) {
            if (it < 2816) { const int lh = layer * 2 + (pos >> 1);
                W = F.in[IN_WD] + (size_t)lh * DFF * D; ldn = D; K = DFF; Nd = D; kind = 0; WT = (bf16*)(F.ws + WS_WFFN + (size_t)lh * WFFN_STRIDE + WD_OFF); gf = nullptr; found = true; }
            else it -= 2816;
        } else {
            const int mk = layer % 3, j = layer / 3; const float* gm = F.in[IN_NG] + (size_t)(layer * 6 + 2) * D;
            const int n1 = (mk == 0) ? 1280 : (mk == 1 ? 3072 : 2048);
            if (it < n1) { found = true; gf = gm; K = D;
                if (mk == 0) { W = F.in[IN_WQKV] + (size_t)j * D * NQKV; ldn = NQKV; Nd = NQKV; kind = 0; WT = (bf16*)(F.ws + WS_WATT + (size_t)j * WATT_STRIDE); }
                else if (mk == 1) { W = F.in[IN_CWIN]; ldn = NCIN; Nd = NCIN; kind = 2; WT = (bf16*)(F.ws + WS_WCONV); }
                else { W = F.in[IN_SWIN]; ldn = NSIN; Nd = NSIN; kind = 0; WT = (bf16*)(F.ws + WS_WSGU); } }
            else { it -= n1;
                if (it < 1024) { found = true; gf = nullptr; K = D; ldn = D; Nd = D; kind = 0;
                    if (mk == 0) { W = F.in[IN_WO] + (size_t)j * D * D; WT = (bf16*)(F.ws + WS_WATT + (size_t)j * WATT_STRIDE + WO_OFF); }
                    else if (mk == 1) { W = F.in[IN_CWOUT]; WT = (bf16*)(F.ws + WS_WCONV + WCOUT_OFF); }
                    else { W = F.in[IN_SWOUT]; WT = (bf16*)(F.ws + WS_WSGU + WSOUT_OFF); } }
                else it -= 1024; }
        }
    }
    if (!found) return;
    LAS float* scr = (LAS float*)(F.lds + F.wave * CVT_SCR);
    const int nblk = Nd / 64, i0 = it + 2 * F.wave;
    f32x4 va[16], vb[16];
    cvt_load(W, ldn, 0, nblk, kind, i0, lane, va, gf);
    cvt_load(W, ldn, 0, nblk, kind, i0 + 1, lane, vb, gf);
    cvt_store(va, K, 0, nblk, WT, scr, i0, lane);
    cvt_store(vb, K, 0, nblk, WT, scr, i0 + 1, lane);
}
__device__ __forceinline__ void prologue_tables(Frame& F) {
    const int tid = opq(F.tid), lane = tid & 63; (void)lane;
    {
        const double inv_d[8] = {1.0, 0.19392274474868576, 0.03760603093086393, 0.007292664737217109, 0.001414213562373095, 0.0002742481756762073, 5.318295896944988e-05, 1.031338537721246e-05};
        float* rc = (float*)(F.ws + WS_ROPE); float* rs = rc + 4100 * 8;
        for (int idx = blockIdx.x * 512 + tid; idx < 4100 * 8; idx += F.G * 512) {
            const int slot = idx >> 3, i = idx & 7;
            const float pos = (float)(slot < 4096 ? slot : 16384 + (slot - 4096));
            float inv = 1.0f;
#pragma unroll
            for (int k = 0; k < 8; ++k) if (i == k) inv = (float)inv_d[k];
            const float ang = pos * inv;
            double t = (double)ang * 0.15915494309189535; t -= __builtin_rint(t);
            const float fr = (float)t;
            rc[idx] = __builtin_amdgcn_cosf(fr); rs[idx] = __builtin_amdgcn_sinf(fr);
        }
    }
    {
        const int n16 = (M - MR) * D * 2 / 16;
        GAS v4u* h = (GAS v4u*)(F.ws + WS_H + (size_t)MR * D * 2); GAS v4u* o = (GAS v4u*)(F.ws + WS_O + (size_t)MR * D * 2);
        for (int i = blockIdx.x * 512 + tid; i < n16; i += F.G * 512) { h[i] = (v4u){0u, 0u, 0u, 0u}; o[i] = (v4u){0u, 0u, 0u, 0u}; }
    }
}

__device__ __forceinline__ void unpack8(const v4u v, float (&f)[8]) { f[0] = bflo(v.x); f[1] = bfhi(v.x); f[2] = bflo(v.y); f[3] = bfhi(v.y); f[4] = bflo(v.z); f[5] = bfhi(v.z); f[6] = bflo(v.w); f[7] = bfhi(v.w); }
__device__ __forceinline__ void ld8f(const float* p, float (&f)[8]) { const f32x4 a = *(const GAS f32x4*)p, b = *(const GAS f32x4*)(p + 4); f[0] = a.x; f[1] = a.y; f[2] = a.z; f[3] = a.w; f[4] = b.x; f[5] = b.y; f[6] = b.z; f[7] = b.w; }
__device__ __forceinline__ void norm_finish_row(Frame& F, float (&x)[4][8], int m, int lane, bool last, bool want_q8) {
    if (last) {
#pragma unroll
        for (int j = 0; j < 4; ++j) { float* dst = F.out + (size_t)m * D + (lane + 64 * j) * 8;
            *(GAS f32x4*)dst = (f32x4){x[j][0], x[j][1], x[j][2], x[j][3]}; *(GAS f32x4*)(dst + 4) = (f32x4){x[j][4], x[j][5], x[j][6], x[j][7]}; }
    } else {
        bf16* X = (bf16*)(F.ws + WS_H); float ss = 0.f;
#pragma unroll
        for (int j = 0; j < 4; ++j) { v4u w; w.x = pk2(x[j][0], x[j][1]); w.y = pk2(x[j][2], x[j][3]); w.z = pk2(x[j][4], x[j][5]); w.w = pk2(x[j][6], x[j][7]);
            *(GAS v4u*)(X + (size_t)m * D + (lane + 64 * j) * 8) = w;
            float r[8]; unpack8(w, r);
#pragma unroll
            for (int e = 0; e < 8; ++e) ss += r[e] * r[e]; }
        const float rsx = 1.0f / sqrtf(wave_sum(ss) * (1.0f / D) + RMS_EPS);
        if (lane == 0) ((float*)(F.ws + WS_RSTD))[m] = rsx;
        if (want_q8) {
            float mx = 0.f;
#pragma unroll
            for (int j = 0; j < 4; ++j)
#pragma unroll
                for (int e = 0; e < 8; ++e) mx = fmaxf(mx, fabsf(x[j][e]));
            mx = fmaxf(wave_max(mx), 1e-30f);
            const float inv = 127.0f / mx;
            unsigned char* XQ = F.ws + WS_XQ8;
#pragma unroll
            for (int j = 0; j < 4; ++j) { unsigned b[8];
#pragma unroll
                for (int e = 0; e < 8; ++e) b[e] = (unsigned)(int)__builtin_rintf(x[j][e] * inv) & 0xffu;
                v2u w; w.x = b[0] | (b[1] << 8) | (b[2] << 16) | (b[3] << 24); w.y = b[4] | (b[5] << 8) | (b[6] << 16) | (b[7] << 24);
                *(GAS v2u*)(XQ + (size_t)m * D + (lane + 64 * j) * 8) = w; }
            if (lane == 0) ((float*)(F.ws + WS_RS8))[m] = rsx * (mx * (1.0f / 127.0f));
        }
    }
}
__device__ __forceinline__ void norm_first_rows(Frame& F, int chunk) {
    const int tid = opq(F.tid), lane = tid & 63;
    const int m = chunk * NWAVES + F.wave;
    if (m < MR) {
        const float* src = m < MP ? F.in[IN_XP] + (size_t)m * D : F.in[IN_XS] + (size_t)(m - MP) * D;
        float x[4][8];
#pragma unroll
        for (int j = 0; j < 4; ++j) ld8f(src + (lane + 64 * j) * 8, x[j]);
        norm_finish_row(F, x, m, lane, false, true);
    }
}
constexpr int CVT_NNR = (MR + NWAVES - 1) / NWAVES;
__device__ __forceinline__ void prologue_phase(Frame& F) {
    const int tid = opq(F.tid), lane = tid & 63; (void)lane;
    prologue_tables(F);
    unsigned* tk = (unsigned*)(F.ws + WS_CTL) + CW_TICKET;
    volatile LAS unsigned* tl = (volatile LAS unsigned*)(F.lds + MISC_OFF) + 12;
    if (tid == 0) tl[0] = __hip_atomic_fetch_add(tk, 1u, __ATOMIC_RELAXED, __HIP_MEMORY_SCOPE_AGENT);
    __syncthreads();
    int t = (int)tl[0];
    while (t < CVT_NI8 + CVT_NCH + CVT_NNR) {
        unsigned tn = 0u; if (tid == 0) tn = __hip_atomic_fetch_add(tk, 1u, __ATOMIC_RELAXED, __HIP_MEMORY_SCOPE_AGENT);
        __syncthreads();
        if (t < CVT_NI8) convert_wgu_i8(F, t); else if (t < CVT_NI8 + CVT_NCH) convert_bf_chunk(F, t - CVT_NI8); else norm_first_rows(F, t - CVT_NI8 - CVT_NCH);
        if (tid == 0) tl[0] = tn;
        __syncthreads();
        t = (int)tl[0];
    }
    __syncthreads();
}
__device__ __forceinline__ void norm_phase(Frame& F, float alpha, const float* g_post, bool last, int nsplit, bool want_q8, bool with_sample) {
    const int tid = opq(F.tid), lane = tid & 63;
    const int gw = F.vcu * NWAVES + F.wave, NGW = F.G * NWAVES;
    const bf16* X = (const bf16*)(F.ws + WS_H); const bf16* OUTB = (const bf16*)(F.ws + WS_OUTF);
    float gp[4][8];
#pragma unroll
    for (int j = 0; j < 4; ++j) ld8f(g_post + (lane + 64 * j) * 8, gp[j]);
    v4u ro[4], rx[4];
#pragma unroll
    for (int j = 0; j < 4; ++j) { ro[j] = (v4u){0u, 0u, 0u, 0u}; rx[j] = ro[j];
        if (gw < MP) { ro[j] = *(const GAS v4u*)(OUTB + (size_t)gw * D + (lane + 64 * j) * 8); rx[j] = *(const GAS v4u*)(X + (size_t)gw * D + (lane + 64 * j) * 8); } }
    for (int m = gw; m < MP; m += NGW) {
        float x[4][8], xo[4][8]; float ss = 0.f;
#pragma unroll
        for (int j = 0; j < 4; ++j) { unpack8(ro[j], x[j]); unpack8(rx[j], xo[j]);
#pragma unroll
            for (int e = 0; e < 8; ++e) ss += x[j][e] * x[j][e]; }
        if (m + NGW < MP) {
#pragma unroll
            for (int j = 0; j < 4; ++j) { ro[j] = *(const GAS v4u*)(OUTB + (size_t)(m + NGW) * D + (lane + 64 * j) * 8); rx[j] = *(const GAS v4u*)(X + (size_t)(m + NGW) * D + (lane + 64 * j) * 8); } }
        const float rs = alpha / sqrtf(wave_sum(ss) * (1.0f / D) + RMS_EPS);
#pragma unroll
        for (int j = 0; j < 4; ++j)
#pragma unroll
            for (int e = 0; e < 8; ++e) x[j][e] = xo[j][e] + (x[j][e] * rs) * gp[j][e];
        norm_finish_row(F, x, m, lane, last, want_q8);
    }
    for (int m = MP + gw; with_sample && m < MR; m += NGW) {
        const float* pr = (const float*)(F.ws + WS_PART) + (size_t)(m - MP) * D;
        float x[4][8]; float ss = 0.f;
#pragma unroll
        for (int j = 0; j < 4; ++j) ld8f(pr + (lane + 64 * j) * 8, x[j]);
#pragma unroll 2
        for (int s = 1; s < nsplit; ++s) {
            float t[4][8];
#pragma unroll
            for (int j = 0; j < 4; ++j) ld8f(pr + (size_t)s * PART_SLAB + (lane + 64 * j) * 8, t[j]);
#pragma unroll
            for (int j = 0; j < 4; ++j)
#pragma unroll
                for (int e = 0; e < 8; ++e) x[j][e] += t[j][e]; }
#pragma unroll
        for (int j = 0; j < 4; ++j)
#pragma unroll
            for (int e = 0; e < 8; ++e) ss += x[j][e] * x[j][e];
        const float rs = alpha / sqrtf(wave_sum(ss) * (1.0f / D) + RMS_EPS);
#pragma unroll
        for (int j = 0; j < 4; ++j) { float xo[8]; unpack8(*(const GAS v4u*)(X + (size_t)m * D + (lane + 64 * j) * 8), xo);
#pragma unroll
            for (int e = 0; e < 8; ++e) x[j][e] = xo[e] + (x[j][e] * rs) * gp[j][e]; }
        norm_finish_row(F, x, m, lane, last, want_q8);
    }
}

constexpr int CW_SFLAG = 16384;
__device__ __forceinline__ void st8_wt(void* p, unsigned lo, unsigned hi) { __hip_atomic_store((unsigned long long*)p, ((unsigned long long)hi << 32) | lo, __ATOMIC_RELAXED, __HIP_MEMORY_SCOPE_AGENT); }
__device__ __forceinline__ void sample_tail_norm(Frame& F, float alpha, const float* g_post, int nsplit, bool want_q8, unsigned* flag1, unsigned need1, unsigned* flag2) {
    if ((int)blockIdx.x < F.G - 16) return;
    const int tid = opq(F.tid), lane = tid & 63;
    const int m = MP + ((int)blockIdx.x - (F.G - 16)) * NWAVES + F.wave;
    { unsigned spins = 0;
      while ((unsigned)__builtin_amdgcn_readfirstlane(__hip_atomic_load(flag1, __ATOMIC_RELAXED, __HIP_MEMORY_SCOPE_AGENT)) < need1) { __builtin_amdgcn_s_sleep(2); if (++spins > (1u << 22)) break; }
      __builtin_amdgcn_fence(__ATOMIC_ACQUIRE, "agent"); asm volatile("s_waitcnt vmcnt(0)" ::: "memory"); }
    bf16* X = (bf16*)(F.ws + WS_H);
    const float* pr = (const float*)(F.ws + WS_PART) + (size_t)(m - MP) * D;
    float x[4][8]; float ss = 0.f;
#pragma unroll
    for (int j = 0; j < 4; ++j) ld8f(pr + (lane + 64 * j) * 8, x[j]);
#pragma unroll 2
    for (int s = 1; s < nsplit; ++s) {
        float t[4][8];
#pragma unroll
        for (int j = 0; j < 4; ++j) ld8f(pr + (size_t)s * PART_SLAB + (lane + 64 * j) * 8, t[j]);
#pragma unroll
        for (int j = 0; j < 4; ++j)
#pragma unroll
            for (int e = 0; e < 8; ++e) x[j][e] += t[j][e]; }
#pragma unroll
    for (int j = 0; j < 4; ++j)
#pragma unroll
        for (int e = 0; e < 8; ++e) ss += x[j][e] * x[j][e];
    const float rs = alpha / sqrtf(wave_sum(ss) * (1.0f / D) + RMS_EPS);
#pragma unroll
    for (int j = 0; j < 4; ++j) { float xo[8], gp[8]; unpack8(*(const GAS v4u*)(X + (size_t)m * D + (lane + 64 * j) * 8), xo); ld8f(g_post + (lane + 64 * j) * 8, gp);
#pragma unroll
        for (int e = 0; e < 8; ++e) x[j][e] = xo[e] + (x[j][e] * rs) * gp[e]; }
    float sx = 0.f;
#pragma unroll
    for (int j = 0; j < 4; ++j) { v4u w; w.x = pk2(x[j][0], x[j][1]); w.y = pk2(x[j][2], x[j][3]); w.z = pk2(x[j][4], x[j][5]); w.w = pk2(x[j][6], x[j][7]);
        bf16* dst = X + (size_t)m * D + (lane + 64 * j) * 8; st8_wt(dst, w.x, w.y); st8_wt(dst + 4, w.z, w.w);
        float r[8]; unpack8(w, r);
#pragma unroll
        for (int e = 0; e < 8; ++e) sx += r[e] * r[e]; }
    const float rsx = 1.0f / sqrtf(wave_sum(sx) * (1.0f / D) + RMS_EPS);
    if (lane == 0) __hip_atomic_store((unsigned*)(F.ws + WS_RSTD) + m, __float_as_uint(rsx), __ATOMIC_RELAXED, __HIP_MEMORY_SCOPE_AGENT);
    if (want_q8) {
        float mx = 0.f;
#pragma unroll
        for (int j = 0; j < 4; ++j)
#pragma unroll
            for (int e = 0; e < 8; ++e) mx = fmaxf(mx, fabsf(x[j][e]));
        mx = fmaxf(wave_max(mx), 1e-30f);
        const float inv = 127.0f / mx;
        unsigned char* XQ = F.ws + WS_XQ8;
#pragma unroll
        for (int j = 0; j < 4; ++j) {
            const unsigned b0 = (unsigned)(int)__builtin_rintf(x[j][0] * inv) & 0xffu, b1 = (unsigned)(int)__builtin_rintf(x[j][1] * inv) & 0xffu, b2 = (unsigned)(int)__builtin_rintf(x[j][2] * inv) & 0xffu, b3 = (unsigned)(int)__builtin_rintf(x[j][3] * inv) & 0xffu;
            const unsigned b4 = (unsigned)(int)__builtin_rintf(x[j][4] * inv) & 0xffu, b5 = (unsigned)(int)__builtin_rintf(x[j][5] * inv) & 0xffu, b6 = (unsigned)(int)__builtin_rintf(x[j][6] * inv) & 0xffu, b7 = (unsigned)(int)__builtin_rintf(x[j][7] * inv) & 0xffu;
            st8_wt(XQ + (size_t)m * D + (lane + 64 * j) * 8, b0 | (b1 << 8) | (b2 << 16) | (b3 << 24), b4 | (b5 << 8) | (b6 << 16) | (b7 << 24)); }
        if (lane == 0) __hip_atomic_store((unsigned*)(F.ws + WS_RS8) + m, __float_as_uint(rsx * (mx * (1.0f / 127.0f))), __ATOMIC_RELAXED, __HIP_MEMORY_SCOPE_AGENT);
    }
    asm volatile("s_waitcnt vmcnt(0)" ::: "memory");
    if (lane == 0) __hip_atomic_fetch_add(flag2, 1u, __ATOMIC_RELAXED, __HIP_MEMORY_SCOPE_AGENT);
}

constexpr int KSTR = 144, VSTR = 528, ATT_K = 0, ATT_V = 256 * KSTR;
__device__ __forceinline__ int crow(int r, int hi) { return (r & 3) + 8 * (r >> 2) + 4 * hi; }
__device__ __forceinline__ void attn_qtile(const LAS unsigned char* Ks, const LAS unsigned char* Vt, LAS float* iscr, const bf16x8 (&qf)[4], int kt0, int qrel, int jmin, float sink2, f32x16 (&o)[2], int lane) {
    const int r32 = lane & 31, hi = lane >> 5;
    f32x16 s[5];
#pragma unroll
    for (int t = 0; t < 5; ++t) {
        s[t] = (f32x16){0.f, 0.f, 0.f, 0.f, 0.f, 0.f, 0.f, 0.f, 0.f, 0.f, 0.f, 0.f, 0.f, 0.f, 0.f, 0.f};
        const LAS unsigned char* kp = Ks + ((kt0 + t) * 32 + r32) * KSTR + hi * 16;
#pragma unroll
        for (int st = 0; st < 4; ++st) { const bf16x8 kf = *(const LAS bf16x8*)(kp + st * 32); s[t] = __builtin_amdgcn_mfma_f32_32x32x16_bf16(kf, qf[st], s[t], 0, 0, 0); }
    }
    const float sc = 0.125f * LOG2E;
    const int qa = qrel - 4 * hi;
    float mraw = -1e30f; float tb[5];
#pragma unroll
    for (int t = 0; t < 5; ++t) {
        const bool ok = (kt0 + t) * 32 >= jmin;
        tb[t] = ok ? 0.f : -1e30f;
        float mt = -1e30f;
#pragma unroll
        for (int r = 0; r < 16; ++r) { const int cr = (r & 3) + 8 * (r >> 2);
            float v = s[t][r];
            if (t == 0) v = (cr >= qa) ? v : -1e30f;
            if (t == 4) v = (cr <= qa) ? v : -1e30f;
            s[t][r] = v; mt = fmaxf(mt, v); }
        mraw = fmaxf(mraw, ok ? mt : -1e30f); }
    mraw = fmaxf(mraw, __shfl_xor(mraw, 32));
    const float mx = fmaxf(sink2, mraw * sc);
    float l = 0.f;
#pragma unroll
    for (int t = 0; t < 5; ++t) { const float bt = tb[t] - mx;
#pragma unroll
        for (int r = 0; r < 16; ++r) { const float e = __builtin_amdgcn_exp2f(__builtin_fmaf(s[t][r], sc, bt)); s[t][r] = e; l += e; } }
    l += __shfl_xor(l, 32);
    const float inv = 1.0f / (l + __builtin_amdgcn_exp2f(sink2 - mx));
    if (hi == 0) iscr[r32] = inv;
    o[0] = (f32x16){0.f, 0.f, 0.f, 0.f, 0.f, 0.f, 0.f, 0.f, 0.f, 0.f, 0.f, 0.f, 0.f, 0.f, 0.f, 0.f}; o[1] = o[0];
#pragma unroll
    for (int t = 0; t < 5; ++t)
#pragma unroll
        for (int hf = 0; hf < 2; ++hf) {
            v4u pw; pw.x = pk2(s[t][8 * hf + 0], s[t][8 * hf + 1]); pw.y = pk2(s[t][8 * hf + 2], s[t][8 * hf + 3]);
            pw.z = pk2(s[t][8 * hf + 4], s[t][8 * hf + 5]); pw.w = pk2(s[t][8 * hf + 6], s[t][8 * hf + 7]);
            const bf16x8 pa = __builtin_bit_cast(bf16x8, pw);
#pragma unroll
            for (int dt = 0; dt < 2; ++dt) {
                const LAS unsigned char* vp = Vt + (dt * 32 + r32) * VSTR + ((kt0 + t) * 32 + 16 * hf + 4 * hi) * 2;
                const s16x4 lo = *(const LAS s16x4*)vp, hh = *(const LAS s16x4*)(vp + 16);
                const bf16x8 vb = (bf16x8){lo[0], lo[1], lo[2], lo[3], hh[0], hh[1], hh[2], hh[3]};
                o[dt] = __builtin_amdgcn_mfma_f32_32x32x16_bf16(pa, vb, o[dt], 0, 0, 0);
            }
        }
#pragma unroll
    for (int k = 0; k < 4; ++k) { const f32x4 iv = *(const LAS f32x4*)(iscr + 8 * k + 4 * hi);
#pragma unroll
        for (int e = 0; e < 4; ++e) { o[0][4 * k + e] *= iv[e]; o[1][4 * k + e] *= iv[e]; } }
}
constexpr int ATT_K2 = ATT_V + 64 * VSTR, ATT_V2 = ATT_K2 + 160 * KSTR, ATT_ISCR = ATT_V2 + 64 * VSTR;
__device__ __forceinline__ void attn_unit(Frame& F, int u, int su, int ja) {
    const int tid = opq(F.tid), lane = tid & 63; (void)lane;
    const int kvh = u & 3, blk = (u >> 2) & 31, b = u >> 7;
    LAS unsigned char* Ks = F.lds + ATT_K; LAS unsigned char* Vt = F.lds + ATT_V; LAS unsigned char* Ks2 = F.lds + ATT_K2; LAS unsigned char* Vt2 = F.lds + ATT_V2;
    const bf16* qkv = (const bf16*)(F.ws + WS_QKV);
    bf16* O = (bf16*)(F.ws + WS_O);
    const int tok0 = blk * 128 - 128;
    const size_t rowb = (size_t)b * SEQ;
    const int h = kvh * 8 + F.wave, r32 = lane & 31, hi = lane >> 5;
    LAS float* iscr = (LAS float*)(F.lds + ATT_ISCR) + F.wave * 32;
    v4u kq[4], vq[4]; bf16x8 qf[4];
#pragma unroll
    for (int i = 0; i < 4; ++i) { const int c = tid + 512 * i, key = c >> 3, part = c & 7, t = tok0 + key;
        kq[i] = (v4u){0u, 0u, 0u, 0u}; if (t >= 0) kq[i] = *(const GAS v4u*)(qkv + (rowb + t) * NQKV + 2048 + kvh * 64 + part * 8); }
#pragma unroll
    for (int kg = 0; kg < 4; ++kg) { const int key = kg * 64 + lane, t = tok0 + key;
        vq[kg] = (v4u){0u, 0u, 0u, 0u}; if (t >= 0) vq[kg] = *(const GAS v4u*)(qkv + (rowb + t) * NQKV + 2304 + kvh * 64 + F.wave * 8); }
#pragma unroll
    for (int st = 0; st < 4; ++st) qf[st] = *(const GAS bf16x8*)(qkv + (rowb + blk * 128 + r32) * NQKV + h * 64 + st * 16 + hi * 8);
    const int skv = su & 3, sb = su >> 2;
    const float* ck = F.in[IN_CK] + (size_t)(ja * 32 + sb) * 128 * 256 + skv * 64;
    const float* cv = F.in[IN_CV] + (size_t)(ja * 32 + sb) * 128 * 256 + skv * 64;
    const size_t srow = (size_t)MP + sb * 4;
    f32x4 sk[4], sv[4]; v4u nk = (v4u){0u, 0u, 0u, 0u}; unsigned short nv[4] = {0, 0, 0, 0};
    if (su >= 0) {
#pragma unroll
        for (int i = 0; i < 4; ++i) { const int c = tid + 512 * i, key = c >> 4, part = c & 15; sk[i] = *(const GAS f32x4*)(ck + (size_t)key * 256 + part * 4); }
        if (tid < 256) { const int key = 128 + (tid >> 3), part = tid & 7; if (key < 132) nk = *(const GAS v4u*)(qkv + (srow + key - 128) * NQKV + 2048 + skv * 64 + part * 8); }
#pragma unroll
        for (int it = 0; it < 4; ++it) { const int dc = F.wave * 2 + (it >> 1), key = (it & 1) * 64 + lane; sv[it] = *(const GAS f32x4*)(cv + (size_t)key * 256 + dc * 4); }
        { const int d = tid & 63, jj0 = tid >> 6;
#pragma unroll
          for (int it = 0; it < 4; ++it) { const int jj = jj0 + 8 * it; if (jj < 4) nv[it] = qkv[(srow + jj) * NQKV + 2304 + skv * 64 + d]; } }
    }
#pragma unroll
    for (int i = 0; i < 4; ++i) { const int c = tid + 512 * i, key = c >> 3, part = c & 7; *(LAS v4u*)(Ks + key * KSTR + part * 16) = kq[i]; }
#pragma unroll
    for (int kg = 0; kg < 4; ++kg) { const int key = kg * 64 + lane;
#pragma unroll
        for (int e = 0; e < 8; ++e) { const unsigned w = vq[kg][e >> 1]; *(LAS unsigned short*)(Vt + (F.wave * 8 + e) * VSTR + key * 2) = (unsigned short)((e & 1) ? (w >> 16) : (w & 0xffffu)); } }
    if (su >= 0) {
#pragma unroll
        for (int i = 0; i < 4; ++i) { const int c = tid + 512 * i, key = c >> 4, part = c & 15;
            v2u w; w.x = pk2(sk[i].x, sk[i].y); w.y = pk2(sk[i].z, sk[i].w); *(LAS v2u*)(Ks2 + key * KSTR + part * 8) = w; }
        if (tid < 256) { const int key = 128 + (tid >> 3), part = tid & 7; *(LAS v4u*)(Ks2 + key * KSTR + part * 16) = nk; }
#pragma unroll
        for (int it = 0; it < 4; ++it) { const int dc = F.wave * 2 + (it >> 1), key = (it & 1) * 64 + lane;
#pragma unroll
            for (int e = 0; e < 4; ++e) *(LAS unsigned short*)(Vt2 + (dc * 4 + e) * VSTR + key * 2) = (unsigned short)f2bf(sv[it][e]); }
        { const int d = tid & 63, jj0 = tid >> 6;
#pragma unroll
          for (int it = 0; it < 4; ++it) { const int jj = jj0 + 8 * it, j = 128 + jj; *(LAS unsigned short*)(Vt2 + d * VSTR + j * 2) = nv[it]; } }
    }
    if (blk == 31) {
#pragma unroll
        for (int i = 0; i < 4; ++i) { const int c = tid + 512 * i, which = c >> 10, cc = c & 1023, jj = cc >> 3, part = cc & 7;
            const v4u v = *(const GAS v4u*)(qkv + (rowb + 3968 + jj) * NQKV + 2048 + which * 256 + kvh * 64 + part * 8);
            float* dst = F.out + (which ? OFF_VP : OFF_KP) + ((size_t)((ja * 2 + b) * 128 + jj) * 4 + kvh) * 64 + part * 8;
            *(GAS f32x4*)dst = (f32x4){bflo(v.x), bfhi(v.x), bflo(v.y), bfhi(v.y)}; *(GAS f32x4*)(dst + 4) = (f32x4){bflo(v.z), bfhi(v.z), bflo(v.w), bfhi(v.w)}; }
    }
    if (su >= 0) {
        f32x4 cp[8];
#pragma unroll
        for (int i = 0; i < 8; ++i) { const int c = tid + 512 * i, which = c >> 11, cc = c & 2047, jj = cc >> 4, part = cc & 15, j = jj + 4;
            if (j < 128) cp[i] = *(const GAS f32x4*)((which ? cv : ck) + (size_t)j * 256 + part * 4);
            else { const v2u w = *(const GAS v2u*)(qkv + (srow + j - 128) * NQKV + 2048 + which * 256 + skv * 64 + part * 4); cp[i] = (f32x4){bflo(w.x), bfhi(w.x), bflo(w.y), bfhi(w.y)}; } }
#pragma unroll
        for (int i = 0; i < 8; ++i) { const int c = tid + 512 * i, which = c >> 11, cc = c & 2047, jj = cc >> 4, part = cc & 15;
            *(GAS f32x4*)(F.out + (which ? OFF_VS : OFF_KS) + ((size_t)((ja * 32 + sb) * 128 + jj) * 4 + skv) * 64 + part * 4) = cp[i]; }
    }
    __syncthreads();
    const float sink2 = F.in[IN_SINK][ja * 32 + h] * LOG2E;
#pragma unroll 1
    for (int qt = 0; qt < 4; ++qt) {
        const size_t qrow = rowb + blk * 128 + qt * 32;
        f32x16 o[2];
        attn_qtile(Ks, Vt, iscr, qf, qt, r32, blk == 0 ? 128 : 0, sink2, o, lane);
        if (qt < 3) {
#pragma unroll
            for (int st = 0; st < 4; ++st) qf[st] = *(const GAS bf16x8*)(qkv + (qrow + 32 + r32) * NQKV + h * 64 + st * 16 + hi * 8); }
#pragma unroll
        for (int dt = 0; dt < 2; ++dt)
#pragma unroll
            for (int r = 0; r < 16; ++r) O[(qrow + crow(r, hi)) * D + h * 64 + dt * 32 + r32] = (bf16)f2bf(o[dt][r]);
    }
    if (su >= 0 && F.wave == 0) {
        const int g = r32 >> 2, l = r32 & 3, hs = skv * 8 + g;
        const float sink2s = F.in[IN_SINK][ja * 32 + hs] * LOG2E;
#pragma unroll
        for (int st = 0; st < 4; ++st) qf[st] = *(const GAS bf16x8*)(qkv + (srow + l) * NQKV + hs * 64 + st * 16 + hi * 8);
        f32x16 o[2];
        attn_qtile(Ks2, Vt2, iscr, qf, 0, l, 0, sink2s, o, lane);
#pragma unroll
        for (int dt = 0; dt < 2; ++dt)
#pragma unroll
            for (int r = 0; r < 16; ++r) { const int q = crow(r, hi); O[(srow + (q & 3)) * D + (skv * 8 + (q >> 2)) * 64 + dt * 32 + r32] = (bf16)f2bf(o[dt][r]); }
    }
    __syncthreads();
}
__device__ __forceinline__ void attn_phase(Frame& F, int ja) {
    for (int u = blockIdx.x; u < 256; u += F.G) attn_unit(F, u, u < 128 ? u : -1, ja);
}

__device__ __forceinline__ void ld8z(const bf16* p, bool ok, float (&f)[8]) { v4u v = (v4u){0u, 0u, 0u, 0u}; if (ok) v = *(const GAS v4u*)p; unpack8(v, f); }
__device__ __forceinline__ void convgate_phase(Frame& F) {
    const int tid = opq(F.tid), lane = tid & 63;
    const int gw = F.vcu * NWAVES + F.wave, NGW = F.G * NWAVES;
    const bf16* Z = (const bf16*)(F.ws + WS_Z); const bf16* BG = (const bf16*)(F.ws + WS_BG); bf16* GA = (bf16*)(F.ws + WS_O);
    const float* cw = F.in[IN_CW];
    float w0[4][8], w1[4][8], w2[4][8];
#pragma unroll
    for (int j = 0; j < 4; ++j) { const int ch = (lane + 64 * j) * 8; ld8f(cw + ch, w0[j]); ld8f(cw + D + ch, w1[j]); ld8f(cw + 2 * D + ch, w2[j]); }
    for (int m = gw; m < MR; m += NGW) {
        const bool samp = m >= MP; const int b = samp ? (m - MP) >> 2 : m >> 12, t = samp ? (m - MP) & 3 : m & 4095;
        float y[4][8], z0[4][8];
#pragma unroll
        for (int j = 0; j < 4; ++j) {
            const int ch = (lane + 64 * j) * 8;
            float z1[8], z2[8], bg[8];
            unpack8(*(const GAS v4u*)(Z + (size_t)m * D + ch), z0[j]);
            unpack8(*(const GAS v4u*)(BG + (size_t)m * D + ch), bg);
            if (samp && t < 1) ld8f(F.in[IN_SC] + (size_t)(b * 2 + 1) * D + ch, z1); else ld8z(Z + (size_t)(m - 1) * D + ch, t >= 1, z1);
            if (samp && t < 2) ld8f(F.in[IN_SC] + (size_t)(b * 2 + t) * D + ch, z2); else ld8z(Z + (size_t)(m - 2) * D + ch, t >= 2, z2);
#pragma unroll
            for (int e = 0; e < 8; ++e) y[j][e] = bg[e] * (w0[j][e] * z2[e] + w1[j][e] * z1[e] + w2[j][e] * z0[j][e]);
        }
#pragma unroll
        for (int j = 0; j < 4; ++j) {
            const int ch = (lane + 64 * j) * 8;
            v4u w; w.x = pk2(y[j][0], y[j][1]); w.y = pk2(y[j][2], y[j][3]); w.z = pk2(y[j][4], y[j][5]); w.w = pk2(y[j][6], y[j][7]);
            *(GAS v4u*)(GA + (size_t)m * D + ch) = w;
            float* dst = nullptr;
            if (!samp && t >= SEQ - 2) dst = F.out + OFF_CP + (size_t)(b * 2 + (t - (SEQ - 2))) * D + ch;
            if (samp && t >= 2) dst = F.out + OFF_CS + (size_t)(b * 2 + (t - 2)) * D + ch;
            if (dst) { *(GAS f32x4*)dst = (f32x4){z0[j][0], z0[j][1], z0[j][2], z0[j][3]}; *(GAS f32x4*)(dst + 4) = (f32x4){z0[j][4], z0[j][5], z0[j][6], z0[j][7]}; }
        }
    }
}

__device__ __forceinline__ void sgu_ln_phase(Frame& F) {
    const int tid = opq(F.tid), lane = tid & 63; (void)lane;
    const int gw = F.vcu * NWAVES + F.wave, NGW = F.G * NWAVES;
    const bf16* V = (const bf16*)(F.ws + WS_Z); bf16* VLN = (bf16*)(F.ws + WS_VLN);
    float lg[4][8], lb[4][8];
#pragma unroll
    for (int j = 0; j < 4; ++j) { ld8f(F.in[IN_SLNG] + (lane + 64 * j) * 8, lg[j]); ld8f(F.in[IN_SLNB] + (lane + 64 * j) * 8, lb[j]); }
    v4u raw[4];
#pragma unroll
    for (int j = 0; j < 4; ++j) raw[j] = (gw < MR) ? *(const GAS v4u*)(V + (size_t)gw * D + (lane + 64 * j) * 8) : (v4u){0u, 0u, 0u, 0u};
    for (int m = gw; m < MR; m += NGW) {
        float v[4][8]; float s = 0.f;
#pragma unroll
        for (int j = 0; j < 4; ++j) { unpack8(raw[j], v[j]);
#pragma unroll
            for (int e = 0; e < 8; ++e) s += v[j][e]; }
        if (m + NGW < MR) {
#pragma unroll
            for (int j = 0; j < 4; ++j) raw[j] = *(const GAS v4u*)(V + (size_t)(m + NGW) * D + (lane + 64 * j) * 8); }
        const float mean = wave_sum(s) * (1.0f / D); float q = 0.f;
#pragma unroll
        for (int j = 0; j < 4; ++j)
#pragma unroll
            for (int e = 0; e < 8; ++e) { v[j][e] -= mean; q += v[j][e] * v[j][e]; }
        const float rstd = 1.0f / sqrtf(wave_sum(q) * (1.0f / D) + LN_EPS);
#pragma unroll
        for (int j = 0; j < 4; ++j) { const int ch = (lane + 64 * j) * 8; float y[8];
#pragma unroll
            for (int e = 0; e < 8; ++e) y[e] = v[j][e] * rstd * lg[j][e] + lb[j][e];
            v4u w; w.x = pk2(y[0], y[1]); w.y = pk2(y[2], y[3]); w.z = pk2(y[4], y[5]); w.w = pk2(y[6], y[7]);
            *(GAS v4u*)(VLN + (size_t)m * D + ch) = w;
            if (m >= MP) { float* dst = F.out + OFF_SV + (size_t)(m - MP) * D + ch; *(GAS f32x4*)dst = (f32x4){y[0], y[1], y[2], y[3]}; *(GAS f32x4*)(dst + 4) = (f32x4){y[4], y[5], y[6], y[7]}; }
        }
    }
}
constexpr int MIX_STR = 272, MIX_W = 0, MIX_V = 128 * MIX_STR, MIX_B = MIX_V + 256 * MIX_STR;
__device__ __forceinline__ void sgu_mix_unit(Frame& F, int u) {
    const int tid = opq(F.tid), lane = tid & 63; (void)lane;
    const int g = u & 7, c = u >> 3;
    LAS unsigned char* Wl = F.lds + MIX_W; LAS unsigned char* Vl = F.lds + MIX_V; LAS float* bsl = (LAS float*)(F.lds + MIX_B);
    const float* ws = F.in[IN_SWS] + (size_t)g * 128 * 128;
    const bf16* VLN = (const bf16*)(F.ws + WS_VLN); const bf16* U = (const bf16*)(F.ws + WS_BG); bf16* A2 = (bf16*)(F.ws + WS_O);
    const int r32 = lane & 31, hi = lane >> 5;
    f32x4 wv[8];
#pragma unroll
    for (int i = 0; i < 8; ++i) { const int cc = tid + 512 * i, t = cc >> 5, s4 = (cc & 31) * 4; wv[i] = *(const GAS f32x4*)(ws + t * 128 + s4); }
    v4u vv[8];
#pragma unroll
    for (int it = 0; it < 8; ++it) { const int pi = it * 8 + F.wave, dc = pi >> 1, s = (pi & 1) * 64 + lane; vv[it] = *(const GAS v4u*)(VLN + (size_t)(c * 128 + s) * D + g * 256 + dc * 8); }
    if (tid < 128) bsl[tid] = F.in[IN_SBS][g * 128 + tid];
#pragma unroll
    for (int i = 0; i < 8; ++i) { const int cc = tid + 512 * i, t = cc >> 5, s4 = (cc & 31) * 4; f32x4 v = wv[i];
        if (s4 + 0 > t) v.x = 0.f; if (s4 + 1 > t) v.y = 0.f; if (s4 + 2 > t) v.z = 0.f; if (s4 + 3 > t) v.w = 0.f;
        v2u w; w.x = pk2(v.x, v.y); w.y = pk2(v.z, v.w); *(LAS v2u*)(Wl + t * MIX_STR + s4 * 2) = w; }
#pragma unroll
    for (int it = 0; it < 8; ++it) { const int pi = it * 8 + F.wave, dc = pi >> 1, s = (pi & 1) * 64 + lane; const v4u v = vv[it];
#pragma unroll
        for (int e = 0; e < 8; ++e) { const unsigned w = v[e >> 1]; *(LAS unsigned short*)(Vl + (dc * 8 + e) * MIX_STR + s * 2) = (unsigned short)((e & 1) ? (w >> 16) : (w & 0xffffu)); } }
    __syncthreads();
#pragma unroll
    for (int mt = 0; mt < 4; ++mt) {
        f32x16 acc = (f32x16){0.f, 0.f, 0.f, 0.f, 0.f, 0.f, 0.f, 0.f, 0.f, 0.f, 0.f, 0.f, 0.f, 0.f, 0.f, 0.f};
#pragma unroll
        for (int ks = 0; ks < 2 * mt + 2; ++ks) {
            const bf16x8 a = *(const LAS bf16x8*)(Wl + (32 * mt + r32) * MIX_STR + (16 * ks + 8 * hi) * 2);
            const bf16x8 bb = *(const LAS bf16x8*)(Vl + (32 * F.wave + r32) * MIX_STR + (16 * ks + 8 * hi) * 2);
            acc = __builtin_amdgcn_mfma_f32_32x32x16_bf16(a, bb, acc, 0, 0, 0);
        }
        const size_t ib = (size_t)(c * 128 + 32 * mt + 4 * hi) * D + g * 256 + 32 * F.wave + r32;
        unsigned short uu[16];
#pragma unroll
        for (int r = 0; r < 16; ++r) uu[r] = U[ib + (size_t)((r & 3) + 8 * (r >> 2)) * D];
#pragma unroll
        for (int r = 0; r < 16; ++r) { const int t = 32 * mt + crow(r, hi);
            A2[ib + (size_t)((r & 3) + 8 * (r >> 2)) * D] = (bf16)f2bf(bf2f(uu[r]) * (acc[r] + bsl[t])); }
    }
    __syncthreads();
}
__device__ __forceinline__ void sgu_mix_phase(Frame& F) {
    const int tid = opq(F.tid), lane = tid & 63; (void)lane;
    for (int u = blockIdx.x; u < 512; u += F.G) sgu_mix_unit(F, u);
    const int gw = F.vcu * NWAVES + F.wave, NGW = F.G * NWAVES;
    const bf16* VLN = (const bf16*)(F.ws + WS_VLN); const bf16* U = (const bf16*)(F.ws + WS_BG); bf16* A2 = (bf16*)(F.ws + WS_O);
    for (int r = gw; r < MS; r += NGW) {
        const int m = MP + r, l = r & 3, m0 = m - l;
#pragma unroll
        for (int j = 0; j < 4; ++j) { const int ch = (lane + 64 * j) * 8, g = ch >> 8;
            float mix[8], uu[8];
#pragma unroll
            for (int e = 0; e < 8; ++e) mix[e] = F.in[IN_SBS][g * 128 + l];
            for (int s = 0; s <= l; ++s) { float vv[8]; unpack8(*(const GAS v4u*)(VLN + (size_t)(m0 + s) * D + ch), vv); const float w = F.in[IN_SWS][(size_t)(g * 128 + l) * 128 + s];
#pragma unroll
                for (int e = 0; e < 8; ++e) mix[e] += w * vv[e]; }
            unpack8(*(const GAS v4u*)(U + (size_t)m * D + ch), uu);
            v4u w; w.x = pk2(uu[0] * mix[0], uu[1] * mix[1]); w.y = pk2(uu[2] * mix[2], uu[3] * mix[3]); w.z = pk2(uu[4] * mix[4], uu[5] * mix[5]); w.w = pk2(uu[6] * mix[6], uu[7] * mix[7]);
            *(GAS v4u*)(A2 + (size_t)m * D + ch) = w; }
    }
}

#ifdef SKIP_PRO
#define PRO(...)
#else
#define PRO(...) __VA_ARGS__
#endif
#ifdef SKIP_NRM
#define NRM(...)
#else
#define NRM(...) __VA_ARGS__
#endif
#ifdef SKIP_ATT
#define ATT(...)
#else
#define ATT(...) __VA_ARGS__
#endif
#ifdef SKIP_CNV
#define CNV(...)
#else
#define CNV(...) __VA_ARGS__
#endif
#ifdef SKIP_SGL
#define SGL(...)
#else
#define SGL(...) __VA_ARGS__
#endif
#ifdef SKIP_SGM
#define SGM(...)
#else
#define SGM(...) __VA_ARGS__
#endif
#ifdef SKIP_GM_EpiGated
#define GM_EpiGated(...)
#else
#define GM_EpiGated(...) __VA_ARGS__
#endif
#ifdef SKIP_GM_EpiF32
#define GM_EpiF32(...)
#else
#define GM_EpiF32(...) __VA_ARGS__
#endif
#ifdef SKIP_GM_EpiQKV
#define GM_EpiQKV(...)
#else
#define GM_EpiQKV(...) __VA_ARGS__
#endif
#ifdef SKIP_GM_EpiConvIn
#define GM_EpiConvIn(...)
#else
#define GM_EpiConvIn(...) __VA_ARGS__
#endif
#ifdef SKIP_GM_EpiGeluSplit
#define GM_EpiGeluSplit(...)
#else
#define GM_EpiGeluSplit(...) __VA_ARGS__
#endif

#ifndef MK_PER_PHASE
#define MK_PER_PHASE 0
#endif
constexpr int N_STEPS = 42;
struct Args { const float* in[20]; float* out; unsigned char* ws; int lo, hi, li, pad; };
__global__ void __launch_bounds__(NWAVES * 64, 2) mk_fwd(Args a) {
    extern __shared__ __attribute__((aligned(16))) unsigned char lds_raw[];
    Frame F;
    F.lds = (LAS unsigned char*)lds_raw;
    F.tid = threadIdx.x; F.lane = F.tid & 63; F.wave = __builtin_amdgcn_readfirstlane(F.tid >> 6);
    F.G = gridDim.x; { const int bx = blockIdx.x; F.vcu = (F.G % 8 == 0) ? (bx % 8) * (F.G / 8) + bx / 8 : bx; }
#pragma unroll
    for (int i = 0; i < 20; ++i) F.in[i] = a.in[i];
    F.out = a.out; F.ws = a.ws;
    for (int u = F.tid; u < (LDS_BYTES - LDSCTL_OFF) / 4; u += NWAVES * 64) ((LAS unsigned*)(F.lds + LDSCTL_OFF))[u] = 0u;
    __syncthreads();
    unsigned* barw = (unsigned*)(a.ws + WS_CTL) + CW_BAR + a.li * XCD_BAR_WORDS;
    XcdBarrier bar; bar.bar = barw; bar.x = 0; bar.st = nullptr;
    if (a.hi - a.lo > 1) bar = xcd_barrier_post(barw, (volatile LAS unsigned*)(F.lds + MISC_OFF) + 8);
    int st = 0;
#ifndef XBAR_EXTRA
#define XBAR_EXTRA 0
#endif
#ifndef DUP_MASK
#define DUP_MASK 0
#endif
#define DUPN(bit) (((DUP_MASK) >> (bit)) & 1 ? 2 : 1)
#define CVT(sl) do { } while (0)
#define REP(bit, ...) for (int rep_ = 0; rep_ < DUPN(bit); ++rep_) { __VA_ARGS__ }
#ifdef PROBE_WAIT
#define PT(k) ptype_ = (k);
#define RUN(...) do { if (st >= a.lo && st < a.hi) { __VA_ARGS__; if (st + 1 < a.hi) { const unsigned long long t0_ = __builtin_amdgcn_s_memrealtime(); xcd_barrier(bar); if ((PROBE_WAIT) & ptype_) wacc_ += (unsigned)(__builtin_amdgcn_s_memrealtime() - t0_); } } ++st; } while (0)
    int ptype_ = 0; unsigned wacc_ = 0u;
#elif defined(PROBE_DUR)
#define PT(k) ptype_ = (k);
#define RUN(...) do { if (st >= a.lo && st < a.hi) { const unsigned long long t0_ = __builtin_amdgcn_s_memrealtime(); __VA_ARGS__; if (st + 1 < a.hi) xcd_barrier(bar); if ((PROBE_DUR) & ptype_) dacc_ += (unsigned)(__builtin_amdgcn_s_memrealtime() - t0_); } ++st; } while (0)
    int ptype_ = 0; unsigned dacc_ = 0u;
#else
#define PT(k)
#define RUN(...) do { if (st >= a.lo && st < a.hi) { __VA_ARGS__; if (st + 1 < a.hi) { xcd_barrier(bar); for (int xb_ = 0; xb_ < XBAR_EXTRA; ++xb_) xcd_barrier(bar); } } ++st; } while (0)
#endif
    const float* ng = F.in[IN_NG];
    bf16* H = (bf16*)(F.ws + WS_H); bf16* ACT = (bf16*)(F.ws + WS_ACT); bf16* OUTF = (bf16*)(F.ws + WS_OUTF); const float* RSTD = (const float*)(F.ws + WS_RSTD); bf16* OB = (bf16*)(F.ws + WS_O);

    PT(32) RUN({ REP(0, PRO(prologue_phase(F);)) });

    const bf16* stA = nullptr; const bf16* stB = nullptr; int stK = 0, stNs = 1, stT = -1; float stAlpha = 0.f; const float* stG = nullptr;
#define SAMP_TAIL(WQ8) do { if (stT >= 0) { \
        unsigned* f1_ = (unsigned*)(F.ws + WS_CTL) + CW_SFLAG + stT * 128; \
        pg8::Gemm gp_{stA, stB, stK}; pg8::PanelOrder SP_; SP_.init(D, stK, stNs, F.G, (int)blockIdx.x, 2); \
        pg8::EpiF32 EP_{OUTF, D, (float*)(F.ws + WS_PART), PART_SLAB}; \
        pg8::gemm_phase<pg8::EpiF32, pg8::PanelOrder, true, true>(F.lds, gp_, SP_, EP_); \
        const int npc_ = SP_.nS < F.G ? SP_.nS : F.G;                        \
        if (F.G - 1 - (int)blockIdx.x < npc_ && F.tid == 0) __hip_atomic_fetch_add(f1_, 1u, __ATOMIC_RELAXED, __HIP_MEMORY_SCOPE_AGENT); \
        sample_tail_norm(F, stAlpha, stG, stNs, WQ8, f1_, (unsigned)npc_, f1_ + 64); } } while (0)
#define SAMP_FLAG (stT >= 0 ? (const unsigned*)((unsigned*)(F.ws + WS_CTL) + CW_SFLAG + stT * 128 + 64) : (const unsigned*)nullptr)

    for (int layer = 0; layer < 4; ++layer) {
        const int kind = layer % 3, jm = layer / 3;
        const float* g = ng + (size_t)layer * 6 * D;
        for (int half = 0; half < 2; ++half) {
            const bf16* wgu = (const bf16*)(F.ws + WS_WFFN + (size_t)(layer * 2 + half) * WFFN_STRIDE);
            const bf16* wd = (const bf16*)((const unsigned char*)wgu + WD_OFF);
            const bool lastsl = (layer == 3 && half == 1);
            const float* gpost = g + (half == 0 ? 1 : 5) * D;
            PT(1) RUN({ SAMP_TAIL(true);
                  pg8::Gemm gm{(const bf16*)(F.ws + WS_XQ8), wgu, D / 2}; pg8::PanelOrder S; S.init(NGU, D / 2, 1, F.G, (int)blockIdx.x, 0, SAMP_FLAG, 128u);
                  pg8::EpiGatedI8 E{ACT, DFF, (const float*)(F.ws + WS_RS8), (const float*)(F.ws + WS_SW) + (size_t)(layer * 2 + half) * NGU};
                  REP(2, GM_EpiGated(pg8::gemm_phase<pg8::EpiGatedI8, pg8::PanelOrder, true, true, true>(F.lds, gm, S, E);)) });
            PT(2) RUN({ pg8::Gemm gm{ACT, wd, DFF}; pg8::PanelOrder S; S.init(D, DFF, NSPLIT_FFN, F.G, (int)blockIdx.x, lastsl ? 0 : 1);
                  pg8::EpiF32 E{OUTF, D, (float*)(F.ws + WS_PART), PART_SLAB};
                  REP(3, GM_EpiF32(pg8::gemm_phase<pg8::EpiF32, pg8::PanelOrder, true, true>(F.lds, gm, S, E);))
                  });
            PT(4) RUN({ NRM(norm_phase(F, 0.5f, gpost, lastsl, NSPLIT_FFN, half == 1 && !lastsl, lastsl);) });
            stA = ACT; stB = wd; stK = DFF; stNs = NSPLIT_FFN; stAlpha = 0.5f; stG = gpost; stT = layer * 3 + 2 * half;
            if (half == 1) break;
            const bf16* mixB = nullptr;
            if (kind == 0) {
                const bf16* wq = (const bf16*)(F.ws + WS_WATT + (size_t)jm * WATT_STRIDE); mixB = (const bf16*)((const unsigned char*)wq + WO_OFF);
                PT(8) RUN({ SAMP_TAIL(false);
                      pg8::Gemm gm{H, wq, D}; pg8::PanelOrder S; S.init(NQKV, D, 1, F.G, (int)blockIdx.x, 0, SAMP_FLAG, 128u);
                      pg8::EpiQKV E{(bf16*)(F.ws + WS_QKV), (const float*)(F.ws + WS_ROPE), (const float*)(F.ws + WS_ROPE) + 4100 * 8, RSTD};
                      REP(5, GM_EpiQKV(pg8::gemm_phase<pg8::EpiQKV, pg8::PanelOrder, true, true>(F.lds, gm, S, E);)) });
                PT(16) RUN({ REP(4, ATT(attn_phase(F, jm);)) });
            } else if (kind == 1) {
                mixB = (const bf16*)(F.ws + WS_WCONV + WCOUT_OFF);
                PT(8) RUN({ SAMP_TAIL(false);
                      pg8::Gemm gm{H, (const bf16*)(F.ws + WS_WCONV), D}; pg8::PanelOrder S; S.init(NCIN, D, 1, F.G, (int)blockIdx.x, 0, SAMP_FLAG, 128u);
                      pg8::EpiConvIn E{(bf16*)(F.ws + WS_BG), (bf16*)(F.ws + WS_Z), RSTD};
                      REP(5, GM_EpiConvIn(pg8::gemm_phase<pg8::EpiConvIn, pg8::PanelOrder, true, true>(F.lds, gm, S, E);)) });
                PT(16) RUN({ REP(6, CNV(convgate_phase(F);)) });
            } else {
                mixB = (const bf16*)(F.ws + WS_WSGU + WSOUT_OFF);
                PT(8) RUN({ SAMP_TAIL(false);
                      pg8::Gemm gm{H, (const bf16*)(F.ws + WS_WSGU), D}; pg8::PanelOrder S; S.init(NSIN, D, 1, F.G, (int)blockIdx.x, 0, SAMP_FLAG, 128u);
                      pg8::EpiGeluSplit E{(bf16*)(F.ws + WS_BG), (bf16*)(F.ws + WS_Z), RSTD};
                      REP(5, GM_EpiGeluSplit(pg8::gemm_phase<pg8::EpiGeluSplit, pg8::PanelOrder, true, true>(F.lds, gm, S, E);)) });
                PT(16) RUN({ REP(7, SGL(sgu_ln_phase(F);)) });
                PT(16) RUN({ REP(8, SGM(sgu_mix_phase(F);)) });
            }
            PT(8) RUN({ pg8::Gemm gm{OB, mixB, D}; pg8::PanelOrder S; S.init(D, D, NSPLIT_MIX, F.G, (int)blockIdx.x, 1);
                  pg8::EpiF32 E{OUTF, D, (float*)(F.ws + WS_PART), PART_SLAB};
                  REP(5, GM_EpiF32(pg8::gemm_phase<pg8::EpiF32, pg8::PanelOrder, true, true>(F.lds, gm, S, E);)) });
            PT(4) RUN({ NRM(norm_phase(F, 1.0f, g + 3 * D, false, NSPLIT_MIX, true, false);) });
            stA = OB; stB = mixB; stK = D; stNs = NSPLIT_MIX; stAlpha = 1.0f; stG = g + 3 * D; stT = layer * 3 + 1;
        }
    }
#ifdef PROBE_WAIT
    {
        unsigned* tw = (unsigned*)(a.ws + WS_CTL) + 30000;
        if (threadIdx.x == 0) __hip_atomic_fetch_add(tw, wacc_, __ATOMIC_RELAXED, __HIP_MEMORY_SCOPE_AGENT);
        xcd_barrier(bar);
        const unsigned tot = __hip_atomic_load(tw, __ATOMIC_RELAXED, __HIP_MEMORY_SCOPE_AGENT);
        const unsigned long long t0 = __builtin_amdgcn_s_memrealtime(), dt = (unsigned long long)(tot / (unsigned)F.G);
        while (__builtin_amdgcn_s_memrealtime() - t0 < dt) __builtin_amdgcn_s_sleep(8);
    }
#endif
#ifdef PROBE_DUR
    { const unsigned long long t0 = __builtin_amdgcn_s_memrealtime(); while (__builtin_amdgcn_s_memrealtime() - t0 < (unsigned long long)dacc_) __builtin_amdgcn_s_sleep(8); }
#endif
#undef SAMP_TAIL
#undef SAMP_FLAG
#undef RUN
}

extern "C" void kernel_launch(void* const* d_in, const int* in_sizes, int n_in, void* d_out, int out_size, void* d_ws, size_t ws_size, hipStream_t stream) {
    static int grid = 0;
    if (grid == 0) {
        if (n_in != 20 || (size_t)out_size != OUT_TOTAL || ws_size < WS_END) { fprintf(stderr, "kernel_launch: unexpected shapes: n_in %d out %d ws %zu (need %zu)\n", n_in, out_size, ws_size, (size_t)WS_END); grid = -1; return; }
        int dev = 0, cus = 0, per_cu = 0;
        if (hipGetDevice(&dev) != hipSuccess || hipDeviceGetAttribute(&cus, hipDeviceAttributeMultiprocessorCount, dev) != hipSuccess) { grid = -1; return; }
        if (hipFuncSetAttribute((const void*)mk_fwd, hipFuncAttributeMaxDynamicSharedMemorySize, LDS_BYTES) != hipSuccess) { fprintf(stderr, "kernel_launch: hipFuncSetAttribute failed\n"); grid = -1; return; }
        if (hipOccupancyMaxActiveBlocksPerMultiprocessor(&per_cu, (const void*)mk_fwd, NWAVES * 64, LDS_BYTES) != hipSuccess || per_cu < 1) fprintf(stderr, "kernel_launch: occupancy query says %d\n", per_cu);
        (void)hipGetLastError();
        grid = cus;
    }
    if (grid < 0) return;
    (void)hipMemsetAsync((char*)d_ws + WS_CTL, 0, CTL_ZERO_BYTES, stream);
    Args a{};
    for (int i = 0; i < 20; ++i) a.in[i] = (const float*)d_in[i];
    a.out = (float*)d_out; a.ws = (unsigned char*)d_ws; a.pad = 0;
#if MK_PER_PHASE
    for (int s = 0; s < N_STEPS; ++s) { a.lo = s; a.hi = s + 1; a.li = 0; hipLaunchKernelGGL(mk_fwd, dim3(grid), dim3(NWAVES * 64), LDS_BYTES, stream, a); }
#else
    a.lo = 0; a.hi = N_STEPS; a.li = 0;
    hipLaunchKernelGGL(mk_fwd, dim3(grid), dim3(NWAVES * 64), LDS_BYTES, stream, a);
#endif
    const hipError_t le = hipPeekAtLastError();
    if (le != hipSuccess) fprintf(stderr, "kernel_launch: launch failed: %s\n", hipGetErrorName(le));
}
```

```cpp
#include <hip/hip_runtime.h>
#include <cstdio>
#include <cstdint>
namespace pg8 {
#define PG8_LAS __attribute__((address_space(3)))
typedef unsigned short bf16_t;
typedef short bf16x8 __attribute__((ext_vector_type(8)));
typedef float f32x4 __attribute__((ext_vector_type(4)));
typedef unsigned u32x4 __attribute__((ext_vector_type(4)));
typedef int i32x4 __attribute__((ext_vector_type(4)));
constexpr int BM = 256, BK = 64, HALF = 128, HTB = HALF * BK * 2  , STAGE_BYTES = 8 * HTB, NXCD = 8, WGM = 8;

__host__ __device__ __forceinline__ int lds_byte(int r, int c) { const int st = (r >> 4) * 2 + (c >> 5), rr = r & 15, cc = c & 31, ob = rr * 64 + cc * 2; return st * 1024 + (ob ^ (((ob >> 9) & 1) << 5)); }
__host__ __device__ __forceinline__ void stage_rc(int b, int& R, int& C) { const int st = b / 1024, sb = b % 1024, swz = sb ^ (((sb >> 9) & 1) << 5); R = (st >> 1) * 16 + swz / 64; C = (st & 1) * 32 + (swz % 64) / 2; }
__host__ __device__ __forceinline__ int perm32(int rho) { const int n = rho >> 4, i = rho & 15; return 8 * (i >> 2) + 4 * n + (i & 3); }

struct Unit { int pm, pn, ks, nt, hm, roff; };
struct Gemm { const bf16_t* A; const bf16_t* Bt; int K; };

struct StaticOrder {
    int nM, nN, nwg, G, c;
    __host__ __device__ void init(int M, int N, int G_, int c_) { nM = M / BM; nN = N / BM; nwg = nM * nN; G = G_; c = c_; }
    __host__ __device__ bool next(int i, Unit& u) const {
        const long L = (long)i * G + c; if (L >= nwg) return false;
        int wgid = (int)L; { const int q = nwg / NXCD, r = nwg % NXCD, xcd = wgid % NXCD, off = wgid / NXCD; wgid = (xcd < r ? xcd * (q + 1) : r * (q + 1) + (xcd - r) * q) + off; }
        const int nig = WGM * nN, gid = wgid / nig, fm = gid * WGM, gsz = (nM - fm) < WGM ? (nM - fm) : WGM;
        u.pm = fm + ((wgid % nig) % gsz); u.pn = (wgid % nig) / gsz; u.ks = 0; u.nt = 0; u.hm = 0; u.roff = 0; return true;
    }
    __device__ __forceinline__ void a_ready(const Unit&) const {}
    __device__ __forceinline__ void done(const Unit&) const {}
};
struct PanelOrder {
    int nN, nP, nS, nsplit, G, c, ntFull, L0, L1, nF, nH;
    const unsigned* flag; unsigned need;
    __device__ __forceinline__ void init(int N, int K, int nsplit_, int G_, int c_, int mode = 0, const unsigned* flag_ = nullptr, unsigned need_ = 0u) {
        nN = N / BM; nP = 32 * nN; nsplit = nsplit_; nS = (mode == 1) ? 0 : nN * nsplit_; G = G_; c = c_; ntFull = K / BK; flag = flag_; need = need_;
        if (mode == 2) { nF = 0; nH = 0; c = G_ - 1 - c_; L0 = 0; L1 = nS; return; }
        const int R = nP % G_;
        nH = (R > 0 && 2 * R + nS <= G_) ? 2 * R : 0; nF = nP - nH / 2; L0 = 0; L1 = nF + nH + nS; }
    __device__ __forceinline__ void prompt_unit(int b, Unit& u) const {
        int wgid = b; { const int q = nP / NXCD, r = nP % NXCD, xcd = wgid % NXCD, off = wgid / NXCD; wgid = (xcd < r ? xcd * (q + 1) : r * (q + 1) + (xcd - r) * q) + off; }
        const int nig = WGM * nN, gid = wgid / nig, fm = gid * WGM;
        u.pm = fm + ((wgid % nig) % WGM); u.pn = (wgid % nig) / WGM; u.ks = 0; u.nt = ntFull; }
    __device__ __forceinline__ bool next(int i, Unit& u) const {
        const int L = L0 + i * G + c; if (L >= L1) return false;
        if (L < nF) { prompt_unit(L, u); u.hm = 0; u.roff = 0; }
        else if (L < nF + nH) { const int j = L - nF; prompt_unit(nF + (j >> 1), u); u.hm = 1; u.roff = 128 * (j & 1); }
        else { const int j = L - nF - nH; u.pm = 32; u.pn = j % nN; u.ks = j / nN; u.nt = ntFull / nsplit; u.hm = 1; u.roff = 0; }
        return true;
    }
    __device__ __forceinline__ void a_ready(const Unit& u) const {
        if (flag == nullptr || u.pm != 32) return;
        if (threadIdx.x < 64) {
            unsigned spins = 0;
            while ((unsigned)__builtin_amdgcn_readfirstlane(__hip_atomic_load(flag, __ATOMIC_RELAXED, __HIP_MEMORY_SCOPE_AGENT)) < need) { __builtin_amdgcn_s_sleep(2); if (++spins > (1u << 22)) break; }
            __builtin_amdgcn_fence(__ATOMIC_ACQUIRE, "agent");
            asm volatile("s_waitcnt vmcnt(0)" ::: "memory");
        }
        asm volatile("" ::: "memory"); __builtin_amdgcn_s_barrier(); asm volatile("" ::: "memory");
    }
    __device__ __forceinline__ void done(const Unit&) const {}
};


typedef float f32x2_cv __attribute__((ext_vector_type(2))); typedef __bf16 bf16x2_cv __attribute__((ext_vector_type(2)));
__device__ __forceinline__ unsigned cvt_pk_bf16(float lo, float hi) { const f32x2_cv v = {lo, hi}; const bf16x2_cv b = __builtin_convertvector(v, bf16x2_cv); return __builtin_bit_cast(unsigned, b); }
typedef unsigned u32x2 __attribute__((ext_vector_type(2)));
__device__ __forceinline__ float silu_f(float x) { return x * __builtin_amdgcn_rcpf(1.0f + __builtin_amdgcn_exp2f(-1.44269504089f * x)); }
__device__ __forceinline__ float gelu_tanh_f(float x) { const float t = x * (1.0f + 0.044715f * x * x) * (-2.0f * 0.7978845608f * 1.44269504089f); return x * __builtin_amdgcn_rcpf(1.0f + __builtin_amdgcn_exp2f(t)); }
__device__ __forceinline__ u32x4 pack8(const f32x4 a, const f32x4 b) { u32x4 w; w.x = cvt_pk_bf16(a[0], a[1]); w.y = cvt_pk_bf16(a[2], a[3]); w.z = cvt_pk_bf16(b[0], b[1]); w.w = cvt_pk_bf16(b[2], b[3]); return w; }

struct EpiF32 {
    static constexpr bool PERM = true, AFTER_DRAIN = false;
    bf16_t* O; int ldc; float* P; size_t slab;
    __device__ __forceinline__ void operator()(const f32x4 (&acc)[2][2][4][2], const Unit& u, int wr, int wc, int fr, int fq) const {
        const int col0 = u.pn * BM + wc * 32 + 8 * fq;
        if (u.pm == 32) {
            const int row0 = wr * 64 + fr; float* base = P + (size_t)u.ks * slab;
#pragma unroll
            for (int m = 0; m < 4; ++m) { float* rowp = base + (size_t)(row0 + m * 16) * ldc + col0;
#pragma unroll
                for (int bj = 0; bj < 2; ++bj)
#pragma unroll
                    for (int n = 0; n < 2; ++n) {
                        const f32x4 v = acc[0][bj][m][n]; const float v0 = v[0], v1 = v[1], v2 = v[2], v3 = v[3];
                        unsigned long long* p = (unsigned long long*)(rowp + bj * HALF + 4 * n);
                        __hip_atomic_store(p, ((unsigned long long)__float_as_uint(v1) << 32) | __float_as_uint(v0), __ATOMIC_RELAXED, __HIP_MEMORY_SCOPE_AGENT);
                        __hip_atomic_store(p + 1, ((unsigned long long)__float_as_uint(v3) << 32) | __float_as_uint(v2), __ATOMIC_RELAXED, __HIP_MEMORY_SCOPE_AGENT); } }
        } else {
            const int row0 = u.pm * BM + u.roff + wr * 64 + fr;
#pragma unroll
            for (int ai = 0; ai < 2; ++ai) { if (ai == 1 && u.hm) break;
#pragma unroll
                for (int m = 0; m < 4; ++m) { bf16_t* rowp = O + (size_t)(row0 + ai * HALF + m * 16) * ldc + col0;
#pragma unroll
                    for (int bj = 0; bj < 2; ++bj) *(u32x4*)(rowp + bj * HALF) = pack8(acc[ai][bj][m][0], acc[ai][bj][m][1]); } }
        }
    }
};
template <int ACT> struct EpiGated {
    static constexpr bool PERM = true, AFTER_DRAIN = false;
    bf16_t* O; int ldc; const float* rstd;
    __device__ __forceinline__ void operator()(const f32x4 (&acc)[2][2][4][2], const Unit& u, int wr, int wc, int fr, int fq) const {
        const int row0 = u.pm * BM + u.roff + wr * 64 + fr, col0 = u.pn * HALF + wc * 32 + 8 * fq;
        float rsr[2][4];
#pragma unroll
        for (int ai = 0; ai < 2; ++ai)
#pragma unroll
            for (int m = 0; m < 4; ++m) rsr[ai][m] = rstd[row0 + ai * HALF + m * 16];
#pragma unroll
        for (int ai = 0; ai < 2; ++ai) { if (ai == 1 && u.hm) break;
#pragma unroll
            for (int m = 0; m < 4; ++m) { bf16_t* rowp = O + (size_t)(row0 + ai * HALF + m * 16) * ldc + col0; const float rs = rsr[ai][m];
                f32x4 v0, v1;
#pragma unroll
                for (int e = 0; e < 4; ++e) { const float g0 = acc[ai][0][m][0][e] * rs, g1 = acc[ai][0][m][1][e] * rs;
                    v0[e] = (ACT ? silu_f(g0) : g0) * (acc[ai][1][m][0][e] * rs); v1[e] = (ACT ? silu_f(g1) : g1) * (acc[ai][1][m][1][e] * rs); }
                *(u32x4*)rowp = pack8(v0, v1); } }
    }
};
struct EpiGatedI8 {
    static constexpr bool PERM = true, AFTER_DRAIN = false;
    bf16_t* O; int ldc; const float* rs; const float* sw;
    __device__ __forceinline__ void operator()(const f32x4 (&acc)[2][2][4][2], const Unit& u, int wr, int wc, int fr, int fq) const {
        const int row0 = u.pm * BM + u.roff + wr * 64 + fr, cl = wc * 32 + 8 * fq, col0 = u.pn * HALF + cl;
        const f32x4 sg0 = *(const f32x4*)(sw + u.pn * BM + cl) * -1.44269504089f, sg1 = *(const f32x4*)(sw + u.pn * BM + cl + 4) * -1.44269504089f,
                    su0 = *(const f32x4*)(sw + u.pn * BM + HALF + cl) * -0.69314718056f, su1 = *(const f32x4*)(sw + u.pn * BM + HALF + cl + 4) * -0.69314718056f;
        float rsr[2][4];
#pragma unroll
        for (int ai = 0; ai < 2; ++ai)
#pragma unroll
            for (int m = 0; m < 4; ++m) rsr[ai][m] = rs[row0 + ai * HALF + m * 16];
#pragma unroll
        for (int ai = 0; ai < 2; ++ai) { if (ai == 1 && u.hm) break;
#pragma unroll
            for (int m = 0; m < 4; ++m) { bf16_t* rowp = O + (size_t)(row0 + ai * HALF + m * 16) * ldc + col0; const float r = rsr[ai][m];
                f32x4 v0, v1;
#pragma unroll
                for (int e = 0; e < 4; ++e) {
                    const float ag0 = acc[ai][0][m][0][e], ag1 = acc[ai][0][m][1][e], au0 = acc[ai][1][m][0][e], au1 = acc[ai][1][m][1][e];
                    const float t0 = (float)__float_as_int(ag0) * (r * sg0[e]), t1 = (float)__float_as_int(ag1) * (r * sg1[e]);
                    const float u0 = (float)__float_as_int(au0) * (r * su0[e]), u1 = (float)__float_as_int(au1) * (r * su1[e]);
                    v0[e] = (t0 * u0) * __builtin_amdgcn_rcpf(1.0f + __builtin_amdgcn_exp2f(t0)); v1[e] = (t1 * u1) * __builtin_amdgcn_rcpf(1.0f + __builtin_amdgcn_exp2f(t1)); }
                *(u32x4*)rowp = pack8(v0, v1); } }
    }
};
struct EpiConvIn {
    static constexpr bool PERM = true, AFTER_DRAIN = false;
    bf16_t* BG; bf16_t* Z; const float* rstd;
    __device__ __forceinline__ void operator()(const f32x4 (&acc)[2][2][4][2], const Unit& u, int wr, int wc, int fr, int fq) const {
        const int row0 = u.pm * BM + u.roff + wr * 64 + fr;
        float rsr[2][4];
#pragma unroll
        for (int ai = 0; ai < 2; ++ai)
#pragma unroll
            for (int m = 0; m < 4; ++m) rsr[ai][m] = rstd[row0 + ai * HALF + m * 16];
        if (u.pn < 8) {
            const int col0 = u.pn * BM + wc * 32 + 8 * fq;
#pragma unroll
            for (int ai = 0; ai < 2; ++ai) { if (ai == 1 && u.hm) break;
#pragma unroll
                for (int m = 0; m < 4; ++m) { bf16_t* rowp = BG + (size_t)(row0 + ai * HALF + m * 16) * 2048 + col0; const float rs = rsr[ai][m];
#pragma unroll
                    for (int bj = 0; bj < 2; ++bj) *(u32x4*)(rowp + bj * HALF) = pack8(acc[ai][bj][m][0] * rs, acc[ai][bj][m][1] * rs); } }
        } else {
            const int col0 = (u.pn - 8) * HALF + wc * 32 + 8 * fq;
#pragma unroll
            for (int ai = 0; ai < 2; ++ai) { if (ai == 1 && u.hm) break;
#pragma unroll
                for (int m = 0; m < 4; ++m) { bf16_t* rowp = Z + (size_t)(row0 + ai * HALF + m * 16) * 2048 + col0; const float rs = rsr[ai][m], rs2 = rs * rs;
                    *(u32x4*)rowp = pack8(acc[ai][0][m][0] * acc[ai][1][m][0] * rs2, acc[ai][0][m][1] * acc[ai][1][m][1] * rs2); } }
        }
    }
};
struct EpiGeluSplit {
    static constexpr bool PERM = true, AFTER_DRAIN = false;
    bf16_t* U; bf16_t* V; const float* rstd;
    __device__ __forceinline__ void operator()(const f32x4 (&acc)[2][2][4][2], const Unit& u, int wr, int wc, int fr, int fq) const {
        const int row0 = u.pm * BM + u.roff + wr * 64 + fr, col0 = (u.pn & 7) * BM + wc * 32 + 8 * fq;
        bf16_t* base = (u.pn < 8) ? U : V;
        float rsr[2][4];
#pragma unroll
        for (int ai = 0; ai < 2; ++ai)
#pragma unroll
            for (int m = 0; m < 4; ++m) rsr[ai][m] = rstd[row0 + ai * HALF + m * 16];
#pragma unroll
        for (int ai = 0; ai < 2; ++ai) { if (ai == 1 && u.hm) break;
#pragma unroll
            for (int m = 0; m < 4; ++m) { bf16_t* rowp = base + (size_t)(row0 + ai * HALF + m * 16) * 2048 + col0; const float rs = rsr[ai][m];
#pragma unroll
                for (int bj = 0; bj < 2; ++bj) { f32x4 v0, v1;
#pragma unroll
                    for (int e = 0; e < 4; ++e) { v0[e] = gelu_tanh_f(acc[ai][bj][m][0][e] * rs); v1[e] = gelu_tanh_f(acc[ai][bj][m][1][e] * rs); }
                    *(u32x4*)(rowp + bj * HALF) = pack8(v0, v1); } } }
    }
};
struct EpiQKV {
    static constexpr bool PERM = true, AFTER_DRAIN = false;
    bf16_t* O; const float* rope_c; const float* rope_s; const float* rstd;
    __device__ __forceinline__ void operator()(const f32x4 (&acc)[2][2][4][2], const Unit& u, int wr, int wc, int fr, int fq) const {
        const int row0 = u.pm * BM + u.roff + wr * 64 + fr, col0 = u.pn * BM + wc * 32 + 8 * fq;
        const bool rot_tile = (u.pn < 9) && ((wc & 1) == 0);
        const bool rot_lane = fq < 2;
        const float sgn = (fq == 0) ? -1.0f : 1.0f;
#pragma unroll
        for (int ai = 0; ai < 2; ++ai) { if (ai == 1 && u.hm) break;
#pragma unroll
            for (int m = 0; m < 4; ++m) { const int row = row0 + ai * HALF + m * 16; bf16_t* rowp = O + (size_t)row * 2560 + col0; const float rs = rstd[row];
                if (rot_tile) {
                    const int slot = row < 8192 ? (row & 4095) : (row < 8320 ? 4096 + ((row - 8192) & 3) : 0);
                    const f32x4 c0 = *(const f32x4*)(rope_c + slot * 8), c1 = *(const f32x4*)(rope_c + slot * 8 + 4);
                    const f32x4 s0 = *(const f32x4*)(rope_s + slot * 8), s1 = *(const f32x4*)(rope_s + slot * 8 + 4);
#pragma unroll
                    for (int bj = 0; bj < 2; ++bj) { f32x4 v0 = acc[ai][bj][m][0] * rs, v1 = acc[ai][bj][m][1] * rs, o0, o1;
#pragma unroll
                        for (int e = 0; e < 4; ++e) { o0[e] = __shfl_xor(v0[e], 16); o1[e] = __shfl_xor(v1[e], 16); }
                        if (rot_lane) {
#pragma unroll
                            for (int e = 0; e < 4; ++e) { v0[e] = v0[e] * c0[e] + sgn * o0[e] * s0[e]; v1[e] = v1[e] * c1[e] + sgn * o1[e] * s1[e]; } }
                        *(u32x4*)(rowp + bj * HALF) = pack8(v0, v1); }
                } else {
#pragma unroll
                    for (int bj = 0; bj < 2; ++bj) *(u32x4*)(rowp + bj * HALF) = pack8(acc[ai][bj][m][0] * rs, acc[ai][bj][m][1] * rs);
                }
            } }
    }
};


template <class Epi, class Sched, bool ALIGN_EPI = false, bool SP2 = false, bool I8 = false>
__device__ __forceinline__ void gemm_phase(PG8_LAS unsigned char* lds, const Gemm g, const Sched& S, const Epi& E) {
    int tid_ = threadIdx.x; asm volatile("" : "+v"(tid_));
    const int tid = tid_, wid = __builtin_amdgcn_readfirstlane(tid >> 6), lane = tid & 63, wr = wid >> 2, wc = wid & 3, fr = lane & 15, fq = lane >> 4;
    const int LD = g.K;
    unsigned voffA[2], voffB[2];
#pragma unroll
    for (int i = 0; i < 2; ++i) { int R, C; stage_rc(tid * 16 + i * 8192, R, C); const int Rb = Epi::PERM ? ((R & ~31) + perm32(R & 31)) : R;
        voffA[i] = (unsigned)(R * LD + C) * 2u; voffB[i] = (unsigned)(Rb * LD + C) * 2u; }
    const size_t kstep = (size_t)(BK * 2);
    const size_t hstep = (size_t)HALF * LD * 2;
    const size_t tstep = 2 * hstep;
    const unsigned ldsw = (unsigned)wid * 1024u;
    const int aoff = lds_byte(wr * 64 + fr, fq * 8), boff = lds_byte(wc * 32 + fr, fq * 8);
#define PG8_SA(b, h) (((b) * 2 + (h)) * HTB)
#define PG8_SB(b, h) ((4 + (b) * 2 + (h)) * HTB)
#define PG8_STAGE(bufoff, gbase, voff) do { _Pragma("unroll") for (int _i = 0; _i < 2; ++_i) \
        __builtin_amdgcn_global_load_lds((const unsigned*)((const char*)(gbase) + (voff)[_i]), (PG8_LAS unsigned*)(lds + (bufoff) + ldsw + _i * 8192), 16, 0, 0); } while (0)
#define PG8_LDA(dst, b, h) do { _Pragma("unroll") for (int m = 0; m < 4; ++m) _Pragma("unroll") for (int k = 0; k < 2; ++k) dst[m][k] = *(const PG8_LAS bf16x8*)(lds + PG8_SA(b, h) + aoff + m * 2048 + k * 1024); } while (0)
#define PG8_LDB(dst, b, h) do { _Pragma("unroll") for (int n = 0; n < 2; ++n) _Pragma("unroll") for (int k = 0; k < 2; ++k) dst[n][k] = *(const PG8_LAS bf16x8*)(lds + PG8_SB(b, h) + boff + n * 2048 + k * 1024); } while (0)
#define PG8_MMA(ai, bj, At, Bt) do { __builtin_amdgcn_s_setprio(1); _Pragma("unroll") for (int m = 0; m < 4; ++m) _Pragma("unroll") for (int n = 0; n < 2; ++n) _Pragma("unroll") for (int k = 0; k < 2; ++k) \
        { if constexpr (I8) acc[ai][bj][m][n] = __builtin_bit_cast(f32x4, __builtin_amdgcn_mfma_i32_16x16x64_i8(__builtin_bit_cast(i32x4, Bt[n][k]), __builtin_bit_cast(i32x4, At[m][k]), __builtin_bit_cast(i32x4, acc[ai][bj][m][n]), 0, 0, 0)); \
          else acc[ai][bj][m][n] = __builtin_amdgcn_mfma_f32_16x16x32_bf16(Bt[n][k], At[m][k], acc[ai][bj][m][n], 0, 0, 0); } __builtin_amdgcn_s_setprio(0); } while (0)
#define PG8_WAIT_V(n) asm volatile("s_waitcnt vmcnt(" #n ")" ::: "memory")
#define PG8_WAIT_L(n) asm volatile("s_waitcnt lgkmcnt(" #n ")" ::: "memory")
#define PG8_BAR __builtin_amdgcn_s_barrier()
#define PG8_SCHED __builtin_amdgcn_sched_barrier(0)
    Unit cur, nxt; int ui = 0;
    if (!S.next(0, cur)) return;
    f32x4 acc[2][2][4][2];
#pragma unroll
    for (int a = 0; a < 2; ++a)
#pragma unroll
        for (int b = 0; b < 2; ++b)
#pragma unroll
            for (int m = 0; m < 4; ++m)
#pragma unroll
                for (int n = 0; n < 2; ++n) acc[a][b][m][n] = (f32x4){0.f, 0.f, 0.f, 0.f};
    bf16x8 At[4][2], B0[2][2], B1[2][2];
    int nt = cur.nt; bool hm = cur.hm != 0;
#define PG8_KOFFB(u) ((size_t)(u).ks * (size_t)(u).nt * (BK * 2))
#define PG8_KOFF(u) ((size_t)(u).ks * (size_t)(u).nt * (BK * 2) + (size_t)(u).roff * (size_t)LD * 2)
    const char* cA = (const char*)g.A + (size_t)cur.pm * tstep + PG8_KOFF(cur); const char* cB = (const char*)g.Bt + (size_t)cur.pn * tstep + PG8_KOFFB(cur);
    S.a_ready(cur);
    if constexpr (SP2) {
        PG8_STAGE(PG8_SB(0, 0), cB, voffB); PG8_STAGE(PG8_SB(0, 1), cB + hstep, voffB); PG8_STAGE(PG8_SA(0, 0), cA, voffA); PG8_STAGE(PG8_SA(0, 1), cA + hstep, voffA);
        if (wr == 1) PG8_BAR;
        PG8_WAIT_V(2); PG8_BAR;
        PG8_STAGE(PG8_SB(1, 0), cB + kstep, voffB); PG8_STAGE(PG8_SA(1, 0), cA + kstep, voffA); PG8_STAGE(PG8_SB(1, 1), cB + hstep + kstep, voffB);
        PG8_WAIT_V(6); PG8_BAR;
    } else {
        PG8_STAGE(PG8_SB(0, 0), cB, voffB); PG8_STAGE(PG8_SA(0, 0), cA, voffA); PG8_STAGE(PG8_SB(0, 1), cB + hstep, voffB); PG8_STAGE(PG8_SA(0, 1), cA + hstep, voffA);
        if (wr == 1) PG8_BAR;
        PG8_WAIT_V(4); PG8_BAR;
        PG8_STAGE(PG8_SB(1, 0), cB + kstep, voffB); PG8_STAGE(PG8_SA(1, 0), cA + kstep, voffA); PG8_STAGE(PG8_SB(1, 1), cB + hstep + kstep, voffB);
        PG8_WAIT_V(6); PG8_BAR;
    }
    for (;;) {
        const bool has_next = S.next(ui + 1, nxt);
        const char* nA = has_next ? (const char*)g.A + (size_t)nxt.pm * tstep + PG8_KOFF(nxt) : cA; const char* nB = has_next ? (const char*)g.Bt + (size_t)nxt.pn * tstep + PG8_KOFFB(nxt) : cB;
        for (int t = 0; t < nt; t += 2) {
            const bool last = (t == nt - 2);
            const char* a1 = cA + (size_t)(t + 1) * kstep;
            const char* a2 = last ? nA : cA + (size_t)(t + 2) * kstep; const char* b2 = last ? nB : cB + (size_t)(t + 2) * kstep;
            const char* a3 = a2 + kstep; const char* b3 = b2 + kstep;
            if (last && has_next) S.a_ready(nxt);
            if constexpr (SP2) {
            PG8_LDB(B0, 0, 0); PG8_LDB(B1, 0, 1); PG8_SCHED; PG8_LDA(At, 0, 0); PG8_STAGE(PG8_SA(1, 1), a1 + hstep, voffA);
            PG8_WAIT_V(8); PG8_WAIT_L(0); PG8_BAR; PG8_MMA(0, 0, At, B0); PG8_MMA(0, 1, At, B1); PG8_BAR; PG8_SCHED;
            if (!hm) { PG8_LDA(At, 0, 1); } PG8_STAGE(PG8_SB(0, 0), b2, voffB); PG8_STAGE(PG8_SB(0, 1), b2 + hstep, voffB); PG8_STAGE(PG8_SA(0, 0), a2, voffA);
            PG8_WAIT_V(8); PG8_WAIT_L(0); PG8_BAR; if (!hm) { PG8_MMA(1, 0, At, B0); PG8_MMA(1, 1, At, B1); } PG8_BAR; PG8_SCHED;
            PG8_LDB(B0, 1, 0); PG8_LDB(B1, 1, 1); PG8_SCHED; PG8_LDA(At, 1, 0); PG8_STAGE(PG8_SA(0, 1), a2 + hstep, voffA);
            PG8_WAIT_V(8); PG8_WAIT_L(0); PG8_BAR; PG8_MMA(0, 0, At, B0); PG8_MMA(0, 1, At, B1); PG8_BAR; PG8_SCHED;
            if (!hm) { PG8_LDA(At, 1, 1); } PG8_STAGE(PG8_SB(1, 0), b3, voffB); PG8_STAGE(PG8_SB(1, 1), b3 + hstep, voffB); PG8_STAGE(PG8_SA(1, 0), a3, voffA);
            PG8_WAIT_V(8); PG8_WAIT_L(0); PG8_BAR; if (!hm) { PG8_MMA(1, 0, At, B0); PG8_MMA(1, 1, At, B1); } PG8_BAR; PG8_SCHED;
            } else {
            PG8_LDB(B0, 0, 0); PG8_SCHED; PG8_LDA(At, 0, 0); PG8_STAGE(PG8_SA(1, 1), a1 + hstep, voffA);
            PG8_WAIT_L(8); PG8_BAR; PG8_WAIT_L(0); PG8_MMA(0, 0, At, B0); PG8_BAR; PG8_SCHED;
            PG8_LDB(B1, 0, 1); PG8_STAGE(PG8_SB(0, 0), b2, voffB);
            PG8_BAR; PG8_WAIT_L(0); PG8_MMA(0, 1, At, B1); PG8_BAR;
            PG8_LDA(At, 0, 1); PG8_STAGE(PG8_SA(0, 0), a2, voffA);
            PG8_BAR; PG8_WAIT_L(0); PG8_MMA(1, 0, At, B0); PG8_BAR; PG8_SCHED;
            PG8_STAGE(PG8_SB(0, 1), b2 + hstep, voffB);
            PG8_WAIT_V(6); PG8_BAR; PG8_MMA(1, 1, At, B1); PG8_BAR;
            PG8_LDB(B0, 1, 0); PG8_SCHED; PG8_LDA(At, 1, 0); PG8_STAGE(PG8_SA(0, 1), a2 + hstep, voffA);
            PG8_WAIT_L(8); PG8_BAR; PG8_WAIT_L(0); PG8_MMA(0, 0, At, B0); PG8_BAR; PG8_SCHED;
            PG8_LDB(B1, 1, 1); PG8_STAGE(PG8_SB(1, 0), b3, voffB);
            PG8_BAR; PG8_WAIT_L(0); PG8_MMA(0, 1, At, B1); PG8_BAR;
            PG8_LDA(At, 1, 1); PG8_STAGE(PG8_SA(1, 0), a3, voffA);
            PG8_BAR; PG8_WAIT_L(0); PG8_MMA(1, 0, At, B0); PG8_BAR; PG8_SCHED;
            PG8_STAGE(PG8_SB(1, 1), b3 + hstep, voffB);
            PG8_WAIT_V(6); PG8_BAR; PG8_MMA(1, 1, At, B1); PG8_BAR;
            }
        }
        if constexpr (ALIGN_EPI) { if (wr == 0) PG8_BAR; }
        if constexpr (!Epi::AFTER_DRAIN) { E(acc, cur, wr, wc, fr, fq); S.done(cur); }
        if (!has_next) break;
#pragma unroll
        for (int a = 0; a < 2; ++a)
#pragma unroll
            for (int b = 0; b < 2; ++b)
#pragma unroll
                for (int m = 0; m < 4; ++m)
#pragma unroll
                    for (int n = 0; n < 2; ++n) acc[a][b][m][n] = (f32x4){0.f, 0.f, 0.f, 0.f};
        cur = nxt; cA = nA; cB = nB; ++ui; nt = cur.nt; hm = cur.hm != 0;
        if constexpr (ALIGN_EPI) { if (wr == 1) PG8_BAR; }
    }
    PG8_WAIT_V(0);
    if constexpr (!ALIGN_EPI) { if (wr == 0) PG8_BAR; }
    PG8_BAR;
    if constexpr (Epi::AFTER_DRAIN) { E.fused(acc, cur, wr, wc, fr, fq, lds, wid, lane); S.done(cur); }
#undef PG8_KOFF
#undef PG8_KOFFB
#undef PG8_SA
#undef PG8_SB
#undef PG8_STAGE
#undef PG8_LDA
#undef PG8_LDB
#undef PG8_MMA
#undef PG8_WAIT_V
#undef PG8_WAIT_L
#undef PG8_BAR
#undef PG8_SCHED
}
}

constexpr int NWAVES = 8;
constexpr int D = 2048, DFF = 5632, NGU = 2 * DFF, SEQ = 4096, NBATCH = 2, MP = NBATCH * SEQ, DBATCH = 32, DSEQ = 4, MS = DBATCH * DSEQ;
constexpr int MR = MP + MS;
constexpr int M = 8448;
constexpr int NQKV = 2560, NCIN = 6144, NSIN = 4096;
constexpr int BM_ROWS = 256;
constexpr float RMS_EPS = 1e-6f, LN_EPS = 1e-5f, LOG2E = 1.4426950408889634f;
constexpr size_t OFF_Y = 0, OFF_KP = (size_t)MR * D, OFF_VP = OFF_KP + 131072, OFF_KS = OFF_VP + 131072, OFF_VS = OFF_KS + 2097152,
                 OFF_CP = OFF_VS + 2097152, OFF_CS = OFF_CP + 8192, OFF_SV = OFF_CS + 131072, OUT_TOTAL = OFF_SV + 262144;
constexpr size_t MiB = 1u << 20;
constexpr size_t WS_CTL = 0, CTL_ZERO_BYTES = 128 * 1024;
constexpr size_t WS_ROPE = 1 * MiB;
constexpr size_t WS_RSTD = WS_ROPE + 512 * 1024;
constexpr size_t WS_H = 2 * MiB;
constexpr size_t WS_ACT = 35 * MiB;
constexpr size_t WS_OUTF = 126 * MiB;
constexpr size_t WS_QKV = 192 * MiB;
constexpr size_t WS_O = 234 * MiB;
constexpr size_t WS_BG = 267 * MiB;
constexpr size_t WS_Z = 300 * MiB;
constexpr size_t WS_VLN = 333 * MiB;
constexpr size_t WS_WFFN = 368 * MiB;
constexpr size_t WFFN_STRIDE = 66 * MiB, WD_OFF = 44 * MiB;
constexpr size_t WS_WATT = WS_WFFN + 8 * WFFN_STRIDE;
constexpr size_t WATT_STRIDE = 18 * MiB, WO_OFF = 10 * MiB;
constexpr size_t WS_WCONV = WS_WATT + 2 * WATT_STRIDE;
constexpr size_t WCOUT_OFF = 24 * MiB;
constexpr size_t WS_WSGU = WS_WCONV + 32 * MiB;
constexpr size_t WSOUT_OFF = 16 * MiB;
constexpr size_t WS_PART = WS_WSGU + 24 * MiB;
constexpr size_t PART_SLAB = (size_t)MS * D;
constexpr int NSPLIT_FFN = 11, NSPLIT_MIX = 4;
constexpr size_t WS_XQ8 = WS_PART + 24 * MiB;
constexpr size_t WS_SW = WS_XQ8 + 17 * MiB;
constexpr size_t WS_RS8 = WS_SW + 512 * 1024;
constexpr size_t WS_END = WS_SW + 1 * MiB;
constexpr int CW_TICKET = 24576;
constexpr int CW_BAR = 4096;
constexpr int RING_BYTES = 133120  , LDSCTL_OFF = RING_BYTES, MISC_OFF = LDSCTL_OFF + 320, LDS_BYTES = 147456;

#define GAS __attribute__((address_space(1)))
#define LAS __attribute__((address_space(3)))
typedef unsigned short bf16;
typedef unsigned v4u __attribute__((ext_vector_type(4)));
typedef unsigned v2u __attribute__((ext_vector_type(2)));
typedef float f32x4 __attribute__((ext_vector_type(4)));
typedef float f32x16 __attribute__((ext_vector_type(16)));
typedef short bf16x8 __attribute__((ext_vector_type(8)));
typedef short s16x4 __attribute__((ext_vector_type(4)));
#define LDS_WAIT() asm volatile("s_waitcnt lgkmcnt(0)" ::: "memory")
typedef float f32x2_cv __attribute__((ext_vector_type(2))); typedef __bf16 bf16x2_cv __attribute__((ext_vector_type(2)));
__device__ __forceinline__ unsigned pk2(float lo, float hi) { const f32x2_cv v = {lo, hi}; const bf16x2_cv b = __builtin_convertvector(v, bf16x2_cv); return __builtin_bit_cast(unsigned, b); }
__device__ __forceinline__ unsigned f2bf(float f) { return pk2(f, f) & 0xffffu; }
__device__ __forceinline__ float bf2f(unsigned short h) { return __builtin_bit_cast(float, (unsigned)h << 16); }
__device__ __forceinline__ float bflo(unsigned w) { return __builtin_bit_cast(float, w << 16); }
__device__ __forceinline__ float bfhi(unsigned w) { return __builtin_bit_cast(float, w & 0xffff0000u); }
#define XB_TMO      128
#define XB_XCNT(j)  (256  + 64 * (j))
#define XB_XSUB(j)  (1280 + 64 * (j))
#define XB_XGEN(j)  (2304 + 64 * (j))
#define XB_TOP      3328
#define XB_TOPGEN   3392
#define XCD_BAR_WORDS 3456
#define XB_SPIN_CAP (1u << 18)

__device__ __forceinline__ unsigned xb_ld(unsigned* p)              { return __hip_atomic_load(p, __ATOMIC_RELAXED, __HIP_MEMORY_SCOPE_AGENT); }
__device__ __forceinline__ unsigned xb_add(unsigned* p, unsigned v) { return __hip_atomic_fetch_add(p, v, __ATOMIC_RELAXED, __HIP_MEMORY_SCOPE_AGENT); }
__device__ __forceinline__ unsigned xb_xcc_id() { return (unsigned)__builtin_amdgcn_s_getreg((3 << 11) | 20) & 0xFu; }
#define XB_SPIN(cond, bar) do { unsigned _sp = 0; while (cond) { __builtin_amdgcn_s_sleep(1); \
    if ((++_sp & 255u) == 0u) { if (xb_ld(&(bar)[XB_TMO])) break; if (_sp > XB_SPIN_CAP) { atomicAdd(&(bar)[XB_TMO], 1u); break; } } } } while (0)

struct XcdBarrier {
    unsigned* bar; unsigned x;
    volatile LAS unsigned* st;
};

__device__ __forceinline__ XcdBarrier xcd_barrier_post(unsigned* bar, volatile LAS unsigned* st) {
    XcdBarrier b; b.bar = bar; b.x = xb_xcc_id(); b.st = st;
    if (threadIdx.x == 0) (void)xb_add(&bar[XB_XCNT(b.x)], 1u);
    return b;
}
__device__ __forceinline__ void xcd_barrier_complete(unsigned* bar, unsigned x, unsigned& nloc, unsigned& nx) {
    const unsigned G = gridDim.x * gridDim.y * gridDim.z;
    unsigned sum, cnt, mine, sp = 0u;
    for (;;) {
        sum = 0u; cnt = 0u; mine = 0u;
#pragma unroll
        for (unsigned j = 0; j < 16; ++j) { const unsigned c = xb_ld(&bar[XB_XCNT(j)]); sum += c; cnt += (c > 0u) ? 1u : 0u; mine = (j == x) ? c : mine; }
        if (sum == G) break;
        __builtin_amdgcn_s_sleep(1);
        if ((++sp & 255u) == 0u) { if (xb_ld(&bar[XB_TMO])) break; if (sp > XB_SPIN_CAP) { atomicAdd(&bar[XB_TMO], 1u); break; } }
    }
    nloc = mine > 0u ? mine : 1u; nx = cnt > 0u ? cnt : 1u;
}

__device__ __forceinline__ void xcd_barrier(const XcdBarrier& b) {
    asm volatile("s_waitcnt vmcnt(0)" ::: "memory");
    __syncthreads();
    if (threadIdx.x == 0) {
        unsigned* bar = b.bar;
        __builtin_amdgcn_s_waitcnt(0);
        unsigned nloc = b.st[0], nx = b.st[1];
        if (nloc == 0u) { xcd_barrier_complete(bar, b.x, nloc, nx); b.st[0] = nloc; b.st[1] = nx; }
        const unsigned old = xb_add(&bar[XB_XSUB(b.x)], 1u);
        const unsigned gen = old / nloc;
#ifdef XB_EARLY_WB_AT
        if (old - gen * nloc == (unsigned)(XB_EARLY_WB_AT) * nloc / 32u && old + 1u != (gen + 1u) * nloc) {
            __builtin_amdgcn_fence(__ATOMIC_RELEASE, "agent");
            asm volatile("s_waitcnt vmcnt(0)" ::: "memory"); }
#endif
        if (old + 1u == (gen + 1u) * nloc) {
            __builtin_amdgcn_fence(__ATOMIC_RELEASE, "agent");
            asm volatile("s_waitcnt vmcnt(0)" ::: "memory");
            const unsigned og = xb_add(&bar[XB_TOP], 1u);
            const unsigned tg = og / nx;
            if (og + 1u == (tg + 1u) * nx) xb_add(&bar[XB_TOPGEN], 1u);
            else XB_SPIN(xb_ld(&bar[XB_TOPGEN]) == tg, bar);
            __builtin_amdgcn_fence(__ATOMIC_ACQUIRE, "agent");
            xb_add(&bar[XB_XGEN(b.x)], 1u);
            asm volatile("s_waitcnt vmcnt(0)" ::: "memory");
        } else {
            XB_SPIN(xb_ld(&bar[XB_XGEN(b.x)]) == gen, bar);
            __builtin_amdgcn_fence(__ATOMIC_ACQUIRE, "agent");
            asm volatile("s_waitcnt vmcnt(0)" ::: "memory");
        }
    }
    __syncthreads();
}

struct Frame {
    LAS unsigned char* lds;
    int tid, lane, wave, vcu, G;
    const float* in[20];
    float* out;
    unsigned char* ws;
};
#define IN_XP 0
#define IN_XS 1
#define IN_CK 2
#define IN_CV 3
#define IN_SC 4
#define IN_NG 5
#define IN_WGU 6
#define IN_WD 7
#define IN_WQKV 8
#define IN_WO 9
#define IN_SINK 10
#define IN_CWIN 11
#define IN_CW 12
#define IN_CWOUT 13
#define IN_SWIN 14
#define IN_SLNG 15
#define IN_SLNB 16
#define IN_SWS 17
#define IN_SBS 18
#define IN_SWOUT 19

template <int CTRL, int RM> __device__ __forceinline__ float dpp_or0(float v) { return __builtin_bit_cast(float, __builtin_amdgcn_update_dpp(0, __builtin_bit_cast(int, v), CTRL, RM, 0xF, true)); }
template <int CTRL, int RM> __device__ __forceinline__ float dpp_self(float v) { return __builtin_bit_cast(float, __builtin_amdgcn_update_dpp(__builtin_bit_cast(int, v), __builtin_bit_cast(int, v), CTRL, RM, 0xF, false)); }
__device__ __forceinline__ float wave_sum(float v) {
    v += dpp_or0<0xB1, 0xF>(v); v += dpp_or0<0x4E, 0xF>(v); v += dpp_or0<0x141, 0xF>(v); v += dpp_or0<0x140, 0xF>(v); v += dpp_or0<0x142, 0xA>(v); v += dpp_or0<0x143, 0xC>(v);
    return __builtin_bit_cast(float, __builtin_amdgcn_readlane(__builtin_bit_cast(int, v), 63));
}
__device__ __forceinline__ float wave_max(float v) {
    v = fmaxf(v, dpp_self<0xB1, 0xF>(v)); v = fmaxf(v, dpp_self<0x4E, 0xF>(v)); v = fmaxf(v, dpp_self<0x141, 0xF>(v)); v = fmaxf(v, dpp_self<0x140, 0xF>(v));
    v = fmaxf(v, dpp_self<0x142, 0xA>(v)); v = fmaxf(v, dpp_self<0x143, 0xC>(v));
    return __builtin_bit_cast(float, __builtin_amdgcn_readlane(__builtin_bit_cast(int, v), 63));
}

__device__ __forceinline__ int opq(int v) { asm volatile("" : "+v"(v)); return v; }
__device__ __forceinline__ int src_col_base(int kind, int db) {
    if (kind == 0) return db * 128;
    if (kind == 1) return (db & 1) * DFF + (db >> 1) * 128;
    if (db < 16) return db * 128;
    const int e = db - 16; return 2048 + (e & 1) * 2048 + (e >> 1) * 128;
}
constexpr int CVT_SCR = 64 * 65 * 4;
__device__ __forceinline__ void cvt_load(const float* W, int ldn, int nb0, int nbn, int kind, int item, int lane, f32x4 (&v)[16], const float* gfold) {
    const int kb = item / nbn, nb = nb0 + item % nbn, k0 = 64 * kb, n0 = 64 * nb;
    const int scol = src_col_base(kind, n0 >> 7) + (n0 & 127);
    const int r4 = lane >> 4, c16 = lane & 15;
#pragma unroll
    for (int i = 0; i < 16; ++i) v[i] = __builtin_nontemporal_load((const GAS f32x4*)(W + (size_t)(k0 + 4 * i + r4) * ldn + scol + c16 * 4));
    if (gfold) {
#pragma unroll
        for (int i = 0; i < 16; ++i) v[i] = v[i] * gfold[k0 + 4 * i + r4]; }
}
__device__ __forceinline__ void cvt_store(const f32x4 (&v)[16], int K, int nb0, int nbn, bf16* WT, LAS float* scr, int item, int lane) {
    const int kb = item / nbn, nb = nb0 + item % nbn, k0 = 64 * kb, n0 = 64 * nb;
    const int r4 = lane >> 4, c16 = lane & 15;
#pragma unroll
    for (int i = 0; i < 16; ++i) { LAS float* d = scr + (4 * i + r4) * 65 + c16 * 4; d[0] = v[i].x; d[1] = v[i].y; d[2] = v[i].z; d[3] = v[i].w; }
    LDS_WAIT(); asm volatile("" ::: "memory");
    const int rr = lane >> 3, c = lane & 7;
#pragma unroll
    for (int j = 0; j < 8; ++j) { const int n = rr + 8 * j; const LAS float* s = scr + (8 * c) * 65 + n;
        v4u o; o.x = pk2(s[0 * 65], s[1 * 65]); o.y = pk2(s[2 * 65], s[3 * 65]); o.z = pk2(s[4 * 65], s[5 * 65]); o.w = pk2(s[6 * 65], s[7 * 65]);
        *(GAS v4u*)(WT + (size_t)(n0 + n) * K + k0 + 8 * c) = o; }
    LDS_WAIT(); asm volatile("" ::: "memory");
}
__device__ __forceinline__ void convert_matrix(Frame& F, const float* W, int ldn, int K, int Nd, int kind, bf16* WT, int& off, int wg0, int nwg, int p0, int p1, const float* gfold) {
    const int tid = opq(F.tid), lane = tid & 63;
    LAS float* scr = (LAS float*)(F.lds + F.wave * CVT_SCR);
    const int gw = ((int)blockIdx.x - wg0) * NWAVES + F.wave, NGW = nwg * NWAVES;
    const int nblk = Nd / 64, nb0 = nblk * p0 / 2, nbn = nblk * p1 / 2 - nb0;
    const int items = (K / 64) * nbn;
    int first = gw - off; if (first < 0) first += NGW;
    off = (off + items) % NGW;
    if (first >= items) return;
    f32x4 va[16], vb[16];
    cvt_load(W, ldn, nb0, nbn, kind, first, lane, va, gfold);
    for (int it = first; it < items; it += 2 * NGW) {
        if (it + NGW < items) cvt_load(W, ldn, nb0, nbn, kind, it + NGW, lane, vb, gfold);
        cvt_store(va, K, nb0, nbn, WT, scr, it, lane);
#ifdef CVT_SLEEP
        if (wg0 != 0) __builtin_amdgcn_s_sleep(CVT_SLEEP);
#endif
        if (it + NGW >= items) break;
        if (it + 2 * NGW < items) cvt_load(W, ldn, nb0, nbn, kind, it + 2 * NGW, lane, va, gfold);
        cvt_store(vb, K, nb0, nbn, WT, scr, it + NGW, lane);
#ifdef CVT_SLEEP
        if (wg0 != 0) __builtin_amdgcn_s_sleep(CVT_SLEEP);
#endif
    }
}
constexpr int CVT_RED_OFF = 135168;
constexpr int T2_PITCH = 4104;
__device__ __forceinline__ void convert_wgu_i8(Frame& F, int gi) {
    const int tid = opq(F.tid), lane = tid & 63;
    LAS unsigned char* T2 = F.lds; LAS float* red = (LAS float*)(F.lds + CVT_RED_OFF);
    const int r8 = lane >> 3, c8 = lane & 7;
    {
        const int lh = gi / 352, it = gi % 352;
        const float* W = F.in[IN_WGU] + (size_t)lh * D * NGU; const float* g = F.in[IN_NG] + (size_t)((lh >> 1) * 6 + 4 * (lh & 1)) * D;
        unsigned char* W8 = F.ws + WS_WFFN + (size_t)lh * WFFN_STRIDE; float* SW = (float*)(F.ws + WS_SW) + (size_t)lh * NGU;
        const int n0 = 32 * it, scol = src_col_base(1, n0 >> 7) + (n0 & 127);
        const float* Wc = W + scol + c8 * 4;
        f32x4 mx = (f32x4){0.f, 0.f, 0.f, 0.f};
#pragma unroll 1
        for (int b = 0; b < 4; ++b) {
            f32x4 v[8];
#pragma unroll
            for (int i = 0; i < 8; ++i) v[i] = __builtin_nontemporal_load((const GAS f32x4*)(Wc + (size_t)(F.wave * 256 + (b * 8 + i) * 8 + r8) * NGU));
#pragma unroll
            for (int i = 0; i < 8; ++i) { const int k = F.wave * 256 + (b * 8 + i) * 8 + r8; const float gg = g[k]; const f32x4 t = v[i] * gg;
                mx.x = fmaxf(mx.x, fabsf(t.x)); mx.y = fmaxf(mx.y, fabsf(t.y)); mx.z = fmaxf(mx.z, fabsf(t.z)); mx.w = fmaxf(mx.w, fabsf(t.w));
                LAS unsigned char* d = T2 + (c8 * 4) * T2_PITCH + k * 2;
                *(LAS unsigned short*)(d) = (unsigned short)f2bf(t.x); *(LAS unsigned short*)(d + T2_PITCH) = (unsigned short)f2bf(t.y);
                *(LAS unsigned short*)(d + 2 * T2_PITCH) = (unsigned short)f2bf(t.z); *(LAS unsigned short*)(d + 3 * T2_PITCH) = (unsigned short)f2bf(t.w); }
        }
#pragma unroll
        for (int o = 8; o < 64; o <<= 1) { mx.x = fmaxf(mx.x, __shfl_xor(mx.x, o)); mx.y = fmaxf(mx.y, __shfl_xor(mx.y, o)); mx.z = fmaxf(mx.z, __shfl_xor(mx.z, o)); mx.w = fmaxf(mx.w, __shfl_xor(mx.w, o)); }
        if (r8 == 0) *(LAS f32x4*)(red + F.wave * 32 + c8 * 4) = mx;
        __syncthreads();
#pragma unroll
        for (int q = 0; q < 4; ++q) { const int n = F.wave * 4 + q;
            float m = red[n];
#pragma unroll
            for (int w = 1; w < 8; ++w) m = fmaxf(m, red[w * 32 + n]);
            m = fmaxf(m, 1e-30f);
            if (lane == 0) SW[n0 + n] = m * (1.0f / 127.0f);
            const float inv = 127.0f / m;
#pragma unroll
            for (int j = 0; j < 4; ++j) { const int kc = (lane + 64 * j) * 8;
                const v2u lo = *(const LAS v2u*)(T2 + n * T2_PITCH + kc * 2), hi = *(const LAS v2u*)(T2 + n * T2_PITCH + kc * 2 + 8);
                const unsigned b0 = (unsigned)(int)__builtin_rintf(bflo(lo.x) * inv) & 0xffu, b1 = (unsigned)(int)__builtin_rintf(bfhi(lo.x) * inv) & 0xffu;
                const unsigned b2 = (unsigned)(int)__builtin_rintf(bflo(lo.y) * inv) & 0xffu, b3 = (unsigned)(int)__builtin_rintf(bfhi(lo.y) * inv) & 0xffu;
                const unsigned b4 = (unsigned)(int)__builtin_rintf(bflo(hi.x) * inv) & 0xffu, b5 = (unsigned)(int)__builtin_rintf(bfhi(hi.x) * inv) & 0xffu;
                const unsigned b6 = (unsigned)(int)__builtin_rintf(bflo(hi.y) * inv) & 0xffu, b7 = (unsigned)(int)__builtin_rintf(bfhi(hi.y) * inv) & 0xffu;
                v2u w; w.x = b0 | (b1 << 8) | (b2 << 16) | (b3 << 24); w.y = b4 | (b5 << 8) | (b6 << 16) | (b7 << 24);
                *(GAS v2u*)(W8 + (size_t)(n0 + n) * D + kc) = w; } }
        __syncthreads();
    }
}
constexpr int CVT_NI8 = 8 * 352, CVT_NCH = (8 * 2816 + 2 * (1280 + 1024) + (3072 + 1024) + (2048 + 1024)) / 16;
__device__ __forceinline__ void convert_bf_chunk(Frame& F, int c) {
    const int tid = opq(F.tid), lane = tid & 63;
    int it = c * 16;
    const float* W = nullptr; int ldn = 0, K = 0, Nd = 0, kind = 0; bf16* WT = nullptr; const float* gf = nullptr; bool found = false;
#pragma unroll 1
    for (int sl = 0; sl < 12 && !found; ++sl) {
        const int layer = sl / 3, pos = sl % 3;
        if (pos != 1) {
            if (it < 2816) { const int lh = layer * 2 + (pos >> 1);
                W = F.in[IN_WD] + (size_t)lh * DFF * D; ldn = D; K = DFF; Nd = D; kind = 0; WT = (bf16*)(F.ws + WS_WFFN + (size_t)lh * WFFN_STRIDE + WD_OFF); gf = nullptr; found = true; }
            else it -= 2816;
        } else {
            const int mk = layer % 3, j = layer / 3; const float* gm = F.in[IN_NG] + (size_t)(layer * 6 + 2) * D;
            const int n1 = (mk == 0) ? 1280 : (mk == 1 ? 3072 : 2048);
            if (it < n1) { found = true; gf = gm; K = D;
                if (mk == 0) { W = F.in[IN_WQKV] + (size_t)j * D * NQKV; ldn = NQKV; Nd = NQKV; kind = 0; WT = (bf16*)(F.ws + WS_WATT + (size_t)j * WATT_STRIDE); }
                else if (mk == 1) { W = F.in[IN_CWIN]; ldn = NCIN; Nd = NCIN; kind = 2; WT = (bf16*)(F.ws + WS_WCONV); }
                else { W = F.in[IN_SWIN]; ldn = NSIN; Nd = NSIN; kind = 0; WT = (bf16*)(F.ws + WS_WSGU); } }
            else { it -= n1;
                if (it < 1024) { found = true; gf = nullptr; K = D; ldn = D; Nd = D; kind = 0;
                    if (mk == 0) { W = F.in[IN_WO] + (size_t)j * D * D; WT = (bf16*)(F.ws + WS_WATT + (size_t)j * WATT_STRIDE + WO_OFF); }
                    else if (mk == 1) { W = F.in[IN_CWOUT]; WT = (bf16*)(F.ws + WS_WCONV + WCOUT_OFF); }
                    else { W = F.in[IN_SWOUT]; WT = (bf16*)(F.ws + WS_WSGU + WSOUT_OFF); } }
                else it -= 1024; }
        }
    }
    if (!found) return;
    LAS float* scr = (LAS float*)(F.lds + F.wave * CVT_SCR);
    const int nblk = Nd / 64, i0 = it + 2 * F.wave;
    f32x4 va[16], vb[16];
    cvt_load(W, ldn, 0, nblk, kind, i0, lane, va, gf);
    cvt_load(W, ldn, 0, nblk, kind, i0 + 1, lane, vb, gf);
    cvt_store(va, K, 0, nblk, WT, scr, i0, lane);
    cvt_store(vb, K, 0, nblk, WT, scr, i0 + 1, lane);
}
__device__ __forceinline__ void prologue_tables(Frame& F) {
    const int tid = opq(F.tid), lane = tid & 63; (void)lane;
    {
        const double inv_d[8] = {1.0, 0.19392274474868576, 0.03760603093086393, 0.007292664737217109, 0.001414213562373095, 0.0002742481756762073, 5.318295896944988e-05, 1.031338537721246e-05};
        float* rc = (float*)(F.ws + WS_ROPE); float* rs = rc + 4100 * 8;
        for (int idx = blockIdx.x * 512 + tid; idx < 4100 * 8; idx += F.G * 512) {
            const int slot = idx >> 3, i = idx & 7;
            const float pos = (float)(slot < 4096 ? slot : 16384 + (slot - 4096));
            float inv = 1.0f;
#pragma unroll
            for (int k = 0; k < 8; ++k) if (i == k) inv = (float)inv_d[k];
            const float ang = pos * inv;
            double t = (double)ang * 0.15915494309189535; t -= __builtin_rint(t);
            const float fr = (float)t;
            rc[idx] = __builtin_amdgcn_cosf(fr); rs[idx] = __builtin_amdgcn_sinf(fr);
        }
    }
    {
        const int n16 = (M - MR) * D * 2 / 16;
        GAS v4u* h = (GAS v4u*)(F.ws + WS_H + (size_t)MR * D * 2); GAS v4u* o = (GAS v4u*)(F.ws + WS_O + (size_t)MR * D * 2);
        for (int i = blockIdx.x * 512 + tid; i < n16; i += F.G * 512) { h[i] = (v4u){0u, 0u, 0u, 0u}; o[i] = (v4u){0u, 0u, 0u, 0u}; }
    }
}

__device__ __forceinline__ void unpack8(const v4u v, float (&f)[8]) { f[0] = bflo(v.x); f[1] = bfhi(v.x); f[2] = bflo(v.y); f[3] = bfhi(v.y); f[4] = bflo(v.z); f[5] = bfhi(v.z); f[6] = bflo(v.w); f[7] = bfhi(v.w); }
__device__ __forceinline__ void ld8f(const float* p, float (&f)[8]) { const f32x4 a = *(const GAS f32x4*)p, b = *(const GAS f32x4*)(p + 4); f[0] = a.x; f[1] = a.y; f[2] = a.z; f[3] = a.w; f[4] = b.x; f[5] = b.y; f[6] = b.z; f[7] = b.w; }
__device__ __forceinline__ void norm_finish_row(Frame& F, float (&x)[4][8], int m, int lane, bool last, bool want_q8) {
    if (last) {
#pragma unroll
        for (int j = 0; j < 4; ++j) { float* dst = F.out + (size_t)m * D + (lane + 64 * j) * 8;
            *(GAS f32x4*)dst = (f32x4){x[j][0], x[j][1], x[j][2], x[j][3]}; *(GAS f32x4*)(dst + 4) = (f32x4){x[j][4], x[j][5], x[j][6], x[j][7]}; }
    } else {
        bf16* X = (bf16*)(F.ws + WS_H); float ss = 0.f;
#pragma unroll
        for (int j = 0; j < 4; ++j) { v4u w; w.x = pk2(x[j][0], x[j][1]); w.y = pk2(x[j][2], x[j][3]); w.z = pk2(x[j][4], x[j][5]); w.w = pk2(x[j][6], x[j][7]);
            *(GAS v4u*)(X + (size_t)m * D + (lane + 64 * j) * 8) = w;
            float r[8]; unpack8(w, r);
#pragma unroll
            for (int e = 0; e < 8; ++e) ss += r[e] * r[e]; }
        const float rsx = 1.0f / sqrtf(wave_sum(ss) * (1.0f / D) + RMS_EPS);
        if (lane == 0) ((float*)(F.ws + WS_RSTD))[m] = rsx;
        if (want_q8) {
            float mx = 0.f;
#pragma unroll
            for (int j = 0; j < 4; ++j)
#pragma unroll
                for (int e = 0; e < 8; ++e) mx = fmaxf(mx, fabsf(x[j][e]));
            mx = fmaxf(wave_max(mx), 1e-30f);
            const float inv = 127.0f / mx;
            unsigned char* XQ = F.ws + WS_XQ8;
#pragma unroll
            for (int j = 0; j < 4; ++j) { unsigned b[8];
#pragma unroll
                for (int e = 0; e < 8; ++e) b[e] = (unsigned)(int)__builtin_rintf(x[j][e] * inv) & 0xffu;
                v2u w; w.x = b[0] | (b[1] << 8) | (b[2] << 16) | (b[3] << 24); w.y = b[4] | (b[5] << 8) | (b[6] << 16) | (b[7] << 24);
                *(GAS v2u*)(XQ + (size_t)m * D + (lane + 64 * j) * 8) = w; }
            if (lane == 0) ((float*)(F.ws + WS_RS8))[m] = rsx * (mx * (1.0f / 127.0f));
        }
    }
}
__device__ __forceinline__ void norm_first_rows(Frame& F, int chunk) {
    const int tid = opq(F.tid), lane = tid & 63;
    const int m = chunk * NWAVES + F.wave;
    if (m < MR) {
        const float* src = m < MP ? F.in[IN_XP] + (size_t)m * D : F.in[IN_XS] + (size_t)(m - MP) * D;
        float x[4][8];
#pragma unroll
        for (int j = 0; j < 4; ++j) ld8f(src + (lane + 64 * j) * 8, x[j]);
        norm_finish_row(F, x, m, lane, false, true);
    }
}
constexpr int CVT_NNR = (MR + NWAVES - 1) / NWAVES;
__device__ __forceinline__ void prologue_phase(Frame& F) {
    const int tid = opq(F.tid), lane = tid & 63; (void)lane;
    prologue_tables(F);
    unsigned* tk = (unsigned*)(F.ws + WS_CTL) + CW_TICKET;
    volatile LAS unsigned* tl = (volatile LAS unsigned*)(F.lds + MISC_OFF) + 12;
    if (tid == 0) tl[0] = __hip_atomic_fetch_add(tk, 1u, __ATOMIC_RELAXED, __HIP_MEMORY_SCOPE_AGENT);
    __syncthreads();
    int t = (int)tl[0];
    while (t < CVT_NI8 + CVT_NCH + CVT_NNR) {
        unsigned tn = 0u; if (tid == 0) tn = __hip_atomic_fetch_add(tk, 1u, __ATOMIC_RELAXED, __HIP_MEMORY_SCOPE_AGENT);
        __syncthreads();
        if (t < CVT_NI8) convert_wgu_i8(F, t); else if (t < CVT_NI8 + CVT_NCH) convert_bf_chunk(F, t - CVT_NI8); else norm_first_rows(F, t - CVT_NI8 - CVT_NCH);
        if (tid == 0) tl[0] = tn;
        __syncthreads();
        t = (int)tl[0];
    }
    __syncthreads();
}
__device__ __forceinline__ void norm_phase(Frame& F, float alpha, const float* g_post, bool last, int nsplit, bool want_q8, bool with_sample) {
    const int tid = opq(F.tid), lane = tid & 63;
    const int gw = F.vcu * NWAVES + F.wave, NGW = F.G * NWAVES;
    const bf16* X = (const bf16*)(F.ws + WS_H); const bf16* OUTB = (const bf16*)(F.ws + WS_OUTF);
    float gp[4][8];
#pragma unroll
    for (int j = 0; j < 4; ++j) ld8f(g_post + (lane + 64 * j) * 8, gp[j]);
    v4u ro[4], rx[4];
#pragma unroll
    for (int j = 0; j < 4; ++j) { ro[j] = (v4u){0u, 0u, 0u, 0u}; rx[j] = ro[j];
        if (gw < MP) { ro[j] = *(const GAS v4u*)(OUTB + (size_t)gw * D + (lane + 64 * j) * 8); rx[j] = *(const GAS v4u*)(X + (size_t)gw * D + (lane + 64 * j) * 8); } }
    for (int m = gw; m < MP; m += NGW) {
        float x[4][8], xo[4][8]; float ss = 0.f;
#pragma unroll
        for (int j = 0; j < 4; ++j) { unpack8(ro[j], x[j]); unpack8(rx[j], xo[j]);
#pragma unroll
            for (int e = 0; e < 8; ++e) ss += x[j][e] * x[j][e]; }
        if (m + NGW < MP) {
#pragma unroll
            for (int j = 0; j < 4; ++j) { ro[j] = *(const GAS v4u*)(OUTB + (size_t)(m + NGW) * D + (lane + 64 * j) * 8); rx[j] = *(const GAS v4u*)(X + (size_t)(m + NGW) * D + (lane + 64 * j) * 8); } }
        const float rs = alpha / sqrtf(wave_sum(ss) * (1.0f / D) + RMS_EPS);
#pragma unroll
        for (int j = 0; j < 4; ++j)
#pragma unroll
            for (int e = 0; e < 8; ++e) x[j][e] = xo[j][e] + (x[j][e] * rs) * gp[j][e];
        norm_finish_row(F, x, m, lane, last, want_q8);
    }
    for (int m = MP + gw; with_sample && m < MR; m += NGW) {
        const float* pr = (const float*)(F.ws + WS_PART) + (size_t)(m - MP) * D;
        float x[4][8]; float ss = 0.f;
#pragma unroll
        for (int j = 0; j < 4; ++j) ld8f(pr + (lane + 64 * j) * 8, x[j]);
#pragma unroll 2
        for (int s = 1; s < nsplit; ++s) {
            float t[4][8];
#pragma unroll
            for (int j = 0; j < 4; ++j) ld8f(pr + (size_t)s * PART_SLAB + (lane + 64 * j) * 8, t[j]);
#pragma unroll
            for (int j = 0; j < 4; ++j)
#pragma unroll
                for (int e = 0; e < 8; ++e) x[j][e] += t[j][e]; }
#pragma unroll
        for (int j = 0; j < 4; ++j)
#pragma unroll
            for (int e = 0; e < 8; ++e) ss += x[j][e] * x[j][e];
        const float rs = alpha / sqrtf(wave_sum(ss) * (1.0f / D) + RMS_EPS);
#pragma unroll
        for (int j = 0; j < 4; ++j) { float xo[8]; unpack8(*(const GAS v4u*)(X + (size_t)m * D + (lane + 64 * j) * 8), xo);
#pragma unroll
            for (int e = 0; e < 8; ++e) x[j][e] = xo[e] + (x[j][e] * rs) * gp[j][e]; }
        norm_finish_row(F, x, m, lane, last, want_q8);
    }
}

constexpr int CW_SFLAG = 16384;
__device__ __forceinline__ void st8_wt(void* p, unsigned lo, unsigned hi) { __hip_atomic_store((unsigned long long*)p, ((unsigned long long)hi << 32) | lo, __ATOMIC_RELAXED, __HIP_MEMORY_SCOPE_AGENT); }
__device__ __forceinline__ void sample_tail_norm(Frame& F, float alpha, const float* g_post, int nsplit, bool want_q8, unsigned* flag1, unsigned need1, unsigned* flag2) {
    if ((int)blockIdx.x < F.G - 16) return;
    const int tid = opq(F.tid), lane = tid & 63;
    const int m = MP + ((int)blockIdx.x - (F.G - 16)) * NWAVES + F.wave;
    { unsigned spins = 0;
      while ((unsigned)__builtin_amdgcn_readfirstlane(__hip_atomic_load(flag1, __ATOMIC_RELAXED, __HIP_MEMORY_SCOPE_AGENT)) < need1) { __builtin_amdgcn_s_sleep(2); if (++spins > (1u << 22)) break; }
      __builtin_amdgcn_fence(__ATOMIC_ACQUIRE, "agent"); asm volatile("s_waitcnt vmcnt(0)" ::: "memory"); }
    bf16* X = (bf16*)(F.ws + WS_H);
    const float* pr = (const float*)(F.ws + WS_PART) + (size_t)(m - MP) * D;
    float x[4][8]; float ss = 0.f;
#pragma unroll
    for (int j = 0; j < 4; ++j) ld8f(pr + (lane + 64 * j) * 8, x[j]);
#pragma unroll 2
    for (int s = 1; s < nsplit; ++s) {
        float t[4][8];
#pragma unroll
        for (int j = 0; j < 4; ++j) ld8f(pr + (size_t)s * PART_SLAB + (lane + 64 * j) * 8, t[j]);
#pragma unroll
        for (int j = 0; j < 4; ++j)
#pragma unroll
            for (int e = 0; e < 8; ++e) x[j][e] += t[j][e]; }
#pragma unroll
    for (int j = 0; j < 4; ++j)
#pragma unroll
        for (int e = 0; e < 8; ++e) ss += x[j][e] * x[j][e];
    const float rs = alpha / sqrtf(wave_sum(ss) * (1.0f / D) + RMS_EPS);
#pragma unroll
    for (int j = 0; j < 4; ++j) { float xo[8], gp[8]; unpack8(*(const GAS v4u*)(X + (size_t)m * D + (lane + 64 * j) * 8), xo); ld8f(g_post + (lane + 64 * j) * 8, gp);
#pragma unroll
        for (int e = 0; e < 8; ++e) x[j][e] = xo[e] + (x[j][e] * rs) * gp[e]; }
    float sx = 0.f;
#pragma unroll
    for (int j = 0; j < 4; ++j) { v4u w; w.x = pk2(x[j][0], x[j][1]); w.y = pk2(x[j][2], x[j][3]); w.z = pk2(x[j][4], x[j][5]); w.w = pk2(x[j][6], x[j][7]);
        bf16* dst = X + (size_t)m * D + (lane + 64 * j) * 8; st8_wt(dst, w.x, w.y); st8_wt(dst + 4, w.z, w.w);
        float r[8]; unpack8(w, r);
#pragma unroll
        for (int e = 0; e < 8; ++e) sx += r[e] * r[e]; }
    const float rsx = 1.0f / sqrtf(wave_sum(sx) * (1.0f / D) + RMS_EPS);
    if (lane == 0) __hip_atomic_store((unsigned*)(F.ws + WS_RSTD) + m, __float_as_uint(rsx), __ATOMIC_RELAXED, __HIP_MEMORY_SCOPE_AGENT);
    if (want_q8) {
        float mx = 0.f;
#pragma unroll
        for (int j = 0; j < 4; ++j)
#pragma unroll
            for (int e = 0; e < 8; ++e) mx = fmaxf(mx, fabsf(x[j][e]));
        mx = fmaxf(wave_max(mx), 1e-30f);
        const float inv = 127.0f / mx;
        unsigned char* XQ = F.ws + WS_XQ8;
#pragma unroll
        for (int j = 0; j < 4; ++j) {
            const unsigned b0 = (unsigned)(int)__builtin_rintf(x[j][0] * inv) & 0xffu, b1 = (unsigned)(int)__builtin_rintf(x[j][1] * inv) & 0xffu, b2 = (unsigned)(int)__builtin_rintf(x[j][2] * inv) & 0xffu, b3 = (unsigned)(int)__builtin_rintf(x[j][3] * inv) & 0xffu;
            const unsigned b4 = (unsigned)(int)__builtin_rintf(x[j][4] * inv) & 0xffu, b5 = (unsigned)(int)__builtin_rintf(x[j][5] * inv) & 0xffu, b6 = (unsigned)(int)__builtin_rintf(x[j][6] * inv) & 0xffu, b7 = (unsigned)(int)__builtin_rintf(x[j][7] * inv) & 0xffu;
            st8_wt(XQ + (size_t)m * D + (lane + 64 * j) * 8, b0 | (b1 << 8) | (b2 << 16) | (b3 << 24), b4 | (b5 << 8) | (b6 << 16) | (b7 << 24)); }
        if (lane == 0) __hip_atomic_store((unsigned*)(F.ws + WS_RS8) + m, __float_as_uint(rsx * (mx * (1.0f / 127.0f))), __ATOMIC_RELAXED, __HIP_MEMORY_SCOPE_AGENT);
    }
    asm volatile("s_waitcnt vmcnt(0)" ::: "memory");
    if (lane == 0) __hip_atomic_fetch_add(flag2, 1u, __ATOMIC_RELAXED, __HIP_MEMORY_SCOPE_AGENT);
}

constexpr int KSTR = 144, VSTR = 528, ATT_K = 0, ATT_V = 256 * KSTR;
__device__ __forceinline__ int crow(int r, int hi) { return (r & 3) + 8 * (r >> 2) + 4 * hi; }
__device__ __forceinline__ void attn_qtile(const LAS unsigned char* Ks, const LAS unsigned char* Vt, LAS float* iscr, const bf16x8 (&qf)[4], int kt0, int qrel, int jmin, float sink2, f32x16 (&o)[2], int lane) {
    const int r32 = lane & 31, hi = lane >> 5;
    f32x16 s[5];
#pragma unroll
    for (int t = 0; t < 5; ++t) {
        s[t] = (f32x16){0.f, 0.f, 0.f, 0.f, 0.f, 0.f, 0.f, 0.f, 0.f, 0.f, 0.f, 0.f, 0.f, 0.f, 0.f, 0.f};
        const LAS unsigned char* kp = Ks + ((kt0 + t) * 32 + r32) * KSTR + hi * 16;
#pragma unroll
        for (int st = 0; st < 4; ++st) { const bf16x8 kf = *(const LAS bf16x8*)(kp + st * 32); s[t] = __builtin_amdgcn_mfma_f32_32x32x16_bf16(kf, qf[st], s[t], 0, 0, 0); }
    }
    const float sc = 0.125f * LOG2E;
    const int qa = qrel - 4 * hi;
    float mraw = -1e30f; float tb[5];
#pragma unroll
    for (int t = 0; t < 5; ++t) {
        const bool ok = (kt0 + t) * 32 >= jmin;
        tb[t] = ok ? 0.f : -1e30f;
        float mt = -1e30f;
#pragma unroll
        for (int r = 0; r < 16; ++r) { const int cr = (r & 3) + 8 * (r >> 2);
            float v = s[t][r];
            if (t == 0) v = (cr >= qa) ? v : -1e30f;
            if (t == 4) v = (cr <= qa) ? v : -1e30f;
            s[t][r] = v; mt = fmaxf(mt, v); }
        mraw = fmaxf(mraw, ok ? mt : -1e30f); }
    mraw = fmaxf(mraw, __shfl_xor(mraw, 32));
    const float mx = fmaxf(sink2, mraw * sc);
    float l = 0.f;
#pragma unroll
    for (int t = 0; t < 5; ++t) { const float bt = tb[t] - mx;
#pragma unroll
        for (int r = 0; r < 16; ++r) { const float e = __builtin_amdgcn_exp2f(__builtin_fmaf(s[t][r], sc, bt)); s[t][r] = e; l += e; } }
    l += __shfl_xor(l, 32);
    const float inv = 1.0f / (l + __builtin_amdgcn_exp2f(sink2 - mx));
    if (hi == 0) iscr[r32] = inv;
    o[0] = (f32x16){0.f, 0.f, 0.f, 0.f, 0.f, 0.f, 0.f, 0.f, 0.f, 0.f, 0.f, 0.f, 0.f, 0.f, 0.f, 0.f}; o[1] = o[0];
#pragma unroll
    for (int t = 0; t < 5; ++t)
#pragma unroll
        for (int hf = 0; hf < 2; ++hf) {
            v4u pw; pw.x = pk2(s[t][8 * hf + 0], s[t][8 * hf + 1]); pw.y = pk2(s[t][8 * hf + 2], s[t][8 * hf + 3]);
            pw.z = pk2(s[t][8 * hf + 4], s[t][8 * hf + 5]); pw.w = pk2(s[t][8 * hf + 6], s[t][8 * hf + 7]);
            const bf16x8 pa = __builtin_bit_cast(bf16x8, pw);
#pragma unroll
            for (int dt = 0; dt < 2; ++dt) {
                const LAS unsigned char* vp = Vt + (dt * 32 + r32) * VSTR + ((kt0 + t) * 32 + 16 * hf + 4 * hi) * 2;
                const s16x4 lo = *(const LAS s16x4*)vp, hh = *(const LAS s16x4*)(vp + 16);
                const bf16x8 vb = (bf16x8){lo[0], lo[1], lo[2], lo[3], hh[0], hh[1], hh[2], hh[3]};
                o[dt] = __builtin_amdgcn_mfma_f32_32x32x16_bf16(pa, vb, o[dt], 0, 0, 0);
            }
        }
#pragma unroll
    for (int k = 0; k < 4; ++k) { const f32x4 iv = *(const LAS f32x4*)(iscr + 8 * k + 4 * hi);
#pragma unroll
        for (int e = 0; e < 4; ++e) { o[0][4 * k + e] *= iv[e]; o[1][4 * k + e] *= iv[e]; } }
}
constexpr int ATT_K2 = ATT_V + 64 * VSTR, ATT_V2 = ATT_K2 + 160 * KSTR, ATT_ISCR = ATT_V2 + 64 * VSTR;
__device__ __forceinline__ void attn_unit(Frame& F, int u, int su, int ja) {
    const int tid = opq(F.tid), lane = tid & 63; (void)lane;
    const int kvh = u & 3, blk = (u >> 2) & 31, b = u >> 7;
    LAS unsigned char* Ks = F.lds + ATT_K; LAS unsigned char* Vt = F.lds + ATT_V; LAS unsigned char* Ks2 = F.lds + ATT_K2; LAS unsigned char* Vt2 = F.lds + ATT_V2;
    const bf16* qkv = (const bf16*)(F.ws + WS_QKV);
    bf16* O = (bf16*)(F.ws + WS_O);
    const int tok0 = blk * 128 - 128;
    const size_t rowb = (size_t)b * SEQ;
    const int h = kvh * 8 + F.wave, r32 = lane & 31, hi = lane >> 5;
    LAS float* iscr = (LAS float*)(F.lds + ATT_ISCR) + F.wave * 32;
    v4u kq[4], vq[4]; bf16x8 qf[4];
#pragma unroll
    for (int i = 0; i < 4; ++i) { const int c = tid + 512 * i, key = c >> 3, part = c & 7, t = tok0 + key;
        kq[i] = (v4u){0u, 0u, 0u, 0u}; if (t >= 0) kq[i] = *(const GAS v4u*)(qkv + (rowb + t) * NQKV + 2048 + kvh * 64 + part * 8); }
#pragma unroll
    for (int kg = 0; kg < 4; ++kg) { const int key = kg * 64 + lane, t = tok0 + key;
        vq[kg] = (v4u){0u, 0u, 0u, 0u}; if (t >= 0) vq[kg] = *(const GAS v4u*)(qkv + (rowb + t) * NQKV + 2304 + kvh * 64 + F.wave * 8); }
#pragma unroll
    for (int st = 0; st < 4; ++st) qf[st] = *(const GAS bf16x8*)(qkv + (rowb + blk * 128 + r32) * NQKV + h * 64 + st * 16 + hi * 8);
    const int skv = su & 3, sb = su >> 2;
    const float* ck = F.in[IN_CK] + (size_t)(ja * 32 + sb) * 128 * 256 + skv * 64;
    const float* cv = F.in[IN_CV] + (size_t)(ja * 32 + sb) * 128 * 256 + skv * 64;
    const size_t srow = (size_t)MP + sb * 4;
    f32x4 sk[4], sv[4]; v4u nk = (v4u){0u, 0u, 0u, 0u}; unsigned short nv[4] = {0, 0, 0, 0};
    if (su >= 0) {
#pragma unroll
        for (int i = 0; i < 4; ++i) { const int c = tid + 512 * i, key = c >> 4, part = c & 15; sk[i] = *(const GAS f32x4*)(ck + (size_t)key * 256 + part * 4); }
        if (tid < 256) { const int key = 128 + (tid >> 3), part = tid & 7; if (key < 132) nk = *(const GAS v4u*)(qkv + (srow + key - 128) * NQKV + 2048 + skv * 64 + part * 8); }
#pragma unroll
        for (int it = 0; it < 4; ++it) { const int dc = F.wave * 2 + (it >> 1), key = (it & 1) * 64 + lane; sv[it] = *(const GAS f32x4*)(cv + (size_t)key * 256 + dc * 4); }
        { const int d = tid & 63, jj0 = tid >> 6;
#pragma unroll
          for (int it = 0; it < 4; ++it) { const int jj = jj0 + 8 * it; if (jj < 4) nv[it] = qkv[(srow + jj) * NQKV + 2304 + skv * 64 + d]; } }
    }
#pragma unroll
    for (int i = 0; i < 4; ++i) { const int c = tid + 512 * i, key = c >> 3, part = c & 7; *(LAS v4u*)(Ks + key * KSTR + part * 16) = kq[i]; }
#pragma unroll
    for (int kg = 0; kg < 4; ++kg) { const int key = kg * 64 + lane;
#pragma unroll
        for (int e = 0; e < 8; ++e) { const unsigned w = vq[kg][e >> 1]; *(LAS unsigned short*)(Vt + (F.wave * 8 + e) * VSTR + key * 2) = (unsigned short)((e & 1) ? (w >> 16) : (w & 0xffffu)); } }
    if (su >= 0) {
#pragma unroll
        for (int i = 0; i < 4; ++i) { const int c = tid + 512 * i, key = c >> 4, part = c & 15;
            v2u w; w.x = pk2(sk[i].x, sk[i].y); w.y = pk2(sk[i].z, sk[i].w); *(LAS v2u*)(Ks2 + key * KSTR + part * 8) = w; }
        if (tid < 256) { const int key = 128 + (tid >> 3), part = tid & 7; *(LAS v4u*)(Ks2 + key * KSTR + part * 16) = nk; }
#pragma unroll
        for (int it = 0; it < 4; ++it) { const int dc = F.wave * 2 + (it >> 1), key = (it & 1) * 64 + lane;
#pragma unroll
            for (int e = 0; e < 4; ++e) *(LAS unsigned short*)(Vt2 + (dc * 4 + e) * VSTR + key * 2) = (unsigned short)f2bf(sv[it][e]); }
        { const int d = tid & 63, jj0 = tid >> 6;
#pragma unroll
          for (int it = 0; it < 4; ++it) { const int jj = jj0 + 8 * it, j = 128 + jj; *(LAS unsigned short*)(Vt2 + d * VSTR + j * 2) = nv[it]; } }
    }
    if (blk == 31) {
#pragma unroll
        for (int i = 0; i < 4; ++i) { const int c = tid + 512 * i, which = c >> 10, cc = c & 1023, jj = cc >> 3, part = cc & 7;
            const v4u v = *(const GAS v4u*)(qkv + (rowb + 3968 + jj) * NQKV + 2048 + which * 256 + kvh * 64 + part * 8);
            float* dst = F.out + (which ? OFF_VP : OFF_KP) + ((size_t)((ja * 2 + b) * 128 + jj) * 4 + kvh) * 64 + part * 8;
            *(GAS f32x4*)dst = (f32x4){bflo(v.x), bfhi(v.x), bflo(v.y), bfhi(v.y)}; *(GAS f32x4*)(dst + 4) = (f32x4){bflo(v.z), bfhi(v.z), bflo(v.w), bfhi(v.w)}; }
    }
    if (su >= 0) {
        f32x4 cp[8];
#pragma unroll
        for (int i = 0; i < 8; ++i) { const int c = tid + 512 * i, which = c >> 11, cc = c & 2047, jj = cc >> 4, part = cc & 15, j = jj + 4;
            if (j < 128) cp[i] = *(const GAS f32x4*)((which ? cv : ck) + (size_t)j * 256 + part * 4);
            else { const v2u w = *(const GAS v2u*)(qkv + (srow + j - 128) * NQKV + 2048 + which * 256 + skv * 64 + part * 4); cp[i] = (f32x4){bflo(w.x), bfhi(w.x), bflo(w.y), bfhi(w.y)}; } }
#pragma unroll
        for (int i = 0; i < 8; ++i) { const int c = tid + 512 * i, which = c >> 11, cc = c & 2047, jj = cc >> 4, part = cc & 15;
            *(GAS f32x4*)(F.out + (which ? OFF_VS : OFF_KS) + ((size_t)((ja * 32 + sb) * 128 + jj) * 4 + skv) * 64 + part * 4) = cp[i]; }
    }
    __syncthreads();
    const float sink2 = F.in[IN_SINK][ja * 32 + h] * LOG2E;
#pragma unroll 1
    for (int qt = 0; qt < 4; ++qt) {
        const size_t qrow = rowb + blk * 128 + qt * 32;
        f32x16 o[2];
        attn_qtile(Ks, Vt, iscr, qf, qt, r32, blk == 0 ? 128 : 0, sink2, o, lane);
        if (qt < 3) {
#pragma unroll
            for (int st = 0; st < 4; ++st) qf[st] = *(const GAS bf16x8*)(qkv + (qrow + 32 + r32) * NQKV + h * 64 + st * 16 + hi * 8); }
#pragma unroll
        for (int dt = 0; dt < 2; ++dt)
#pragma unroll
            for (int r = 0; r < 16; ++r) O[(qrow + crow(r, hi)) * D + h * 64 + dt * 32 + r32] = (bf16)f2bf(o[dt][r]);
    }
    if (su >= 0 && F.wave == 0) {
        const int g = r32 >> 2, l = r32 & 3, hs = skv * 8 + g;
        const float sink2s = F.in[IN_SINK][ja * 32 + hs] * LOG2E;
#pragma unroll
        for (int st = 0; st < 4; ++st) qf[st] = *(const GAS bf16x8*)(qkv + (srow + l) * NQKV + hs * 64 + st * 16 + hi * 8);
        f32x16 o[2];
        attn_qtile(Ks2, Vt2, iscr, qf, 0, l, 0, sink2s, o, lane);
#pragma unroll
        for (int dt = 0; dt < 2; ++dt)
#pragma unroll
            for (int r = 0; r < 16; ++r) { const int q = crow(r, hi); O[(srow + (q & 3)) * D + (skv * 8 + (q >> 2)) * 64 + dt * 32 + r32] = (bf16)f2bf(o[dt][r]); }
    }
    __syncthreads();
}
__device__ __forceinline__ void attn_phase(Frame& F, int ja) {
    for (int u = blockIdx.x; u < 256; u += F.G) attn_unit(F, u, u < 128 ? u : -1, ja);
}

__device__ __forceinline__ void ld8z(const bf16* p, bool ok, float (&f)[8]) { v4u v = (v4u){0u, 0u, 0u, 0u}; if (ok) v = *(const GAS v4u*)p; unpack8(v, f); }
__device__ __forceinline__ void convgate_phase(Frame& F) {
    const int tid = opq(F.tid), lane = tid & 63;
    const int gw = F.vcu * NWAVES + F.wave, NGW = F.G * NWAVES;
    const bf16* Z = (const bf16*)(F.ws + WS_Z); const bf16* BG = (const bf16*)(F.ws + WS_BG); bf16* GA = (bf16*)(F.ws + WS_O);
    const float* cw = F.in[IN_CW];
    float w0[4][8], w1[4][8], w2[4][8];
#pragma unroll
    for (int j = 0; j < 4; ++j) { const int ch = (lane + 64 * j) * 8; ld8f(cw + ch, w0[j]); ld8f(cw + D + ch, w1[j]); ld8f(cw + 2 * D + ch, w2[j]); }
    const int nfull = MR / NGW, xw = F.wave * F.G + (int)blockIdx.x, nk = nfull + (xw < MR - nfull * NGW ? 1 : 0);
    for (int k = 0; k < nk; ++k) { const int m = k < nfull ? gw + k * NGW : nfull * NGW + xw;
        const bool samp = m >= MP; const int b = samp ? (m - MP) >> 2 : m >> 12, t = samp ? (m - MP) & 3 : m & 4095;
        float y[4][8], z0[4][8];
#pragma unroll
        for (int j = 0; j < 4; ++j) {
            const int ch = (lane + 64 * j) * 8;
            float z1[8], z2[8], bg[8];
            unpack8(*(const GAS v4u*)(Z + (size_t)m * D + ch), z0[j]);
            unpack8(*(const GAS v4u*)(BG + (size_t)m * D + ch), bg);
            if (samp && t < 1) ld8f(F.in[IN_SC] + (size_t)(b * 2 + 1) * D + ch, z1); else ld8z(Z + (size_t)(m - 1) * D + ch, t >= 1, z1);
            if (samp && t < 2) ld8f(F.in[IN_SC] + (size_t)(b * 2 + t) * D + ch, z2); else ld8z(Z + (size_t)(m - 2) * D + ch, t >= 2, z2);
#pragma unroll
            for (int e = 0; e < 8; ++e) y[j][e] = bg[e] * (w0[j][e] * z2[e] + w1[j][e] * z1[e] + w2[j][e] * z0[j][e]);
        }
#pragma unroll
        for (int j = 0; j < 4; ++j) {
            const int ch = (lane + 64 * j) * 8;
            v4u w; w.x = pk2(y[j][0], y[j][1]); w.y = pk2(y[j][2], y[j][3]); w.z = pk2(y[j][4], y[j][5]); w.w = pk2(y[j][6], y[j][7]);
            *(GAS v4u*)(GA + (size_t)m * D + ch) = w;
            float* dst = nullptr;
            if (!samp && t >= SEQ - 2) dst = F.out + OFF_CP + (size_t)(b * 2 + (t - (SEQ - 2))) * D + ch;
            if (samp && t >= 2) dst = F.out + OFF_CS + (size_t)(b * 2 + (t - 2)) * D + ch;
            if (dst) { *(GAS f32x4*)dst = (f32x4){z0[j][0], z0[j][1], z0[j][2], z0[j][3]}; *(GAS f32x4*)(dst + 4) = (f32x4){z0[j][4], z0[j][5], z0[j][6], z0[j][7]}; }
        }
    }
}

__device__ __forceinline__ void sgu_ln_phase(Frame& F) {
    const int tid = opq(F.tid), lane = tid & 63; (void)lane;
    const int gw = F.vcu * NWAVES + F.wave, NGW = F.G * NWAVES;
    const bf16* V = (const bf16*)(F.ws + WS_Z); bf16* VLN = (bf16*)(F.ws + WS_VLN);
    float lg[4][8], lb[4][8];
#pragma unroll
    for (int j = 0; j < 4; ++j) { ld8f(F.in[IN_SLNG] + (lane + 64 * j) * 8, lg[j]); ld8f(F.in[IN_SLNB] + (lane + 64 * j) * 8, lb[j]); }
    v4u raw[4];
    const int nfull = MR / NGW, xw = F.wave * F.G + (int)blockIdx.x, nk = nfull + (xw < MR - nfull * NGW ? 1 : 0);
    const int mfirst = nfull > 0 ? gw : nfull * NGW + xw;
#pragma unroll
    for (int j = 0; j < 4; ++j) raw[j] = (nk > 0) ? *(const GAS v4u*)(V + (size_t)mfirst * D + (lane + 64 * j) * 8) : (v4u){0u, 0u, 0u, 0u};
    for (int k = 0; k < nk; ++k) { const int m = k < nfull ? gw + k * NGW : nfull * NGW + xw, mn = (k + 1) < nfull ? gw + (k + 1) * NGW : nfull * NGW + xw;
        float v[4][8]; float s = 0.f;
#pragma unroll
        for (int j = 0; j < 4; ++j) { unpack8(raw[j], v[j]);
#pragma unroll
            for (int e = 0; e < 8; ++e) s += v[j][e]; }
        if (k + 1 < nk) {
#pragma unroll
            for (int j = 0; j < 4; ++j) raw[j] = *(const GAS v4u*)(V + (size_t)mn * D + (lane + 64 * j) * 8); }
        const float mean = wave_sum(s) * (1.0f / D); float q = 0.f;
#pragma unroll
        for (int j = 0; j < 4; ++j)
#pragma unroll
            for (int e = 0; e < 8; ++e) { v[j][e] -= mean; q += v[j][e] * v[j][e]; }
        const float rstd = 1.0f / sqrtf(wave_sum(q) * (1.0f / D) + LN_EPS);
#pragma unroll
        for (int j = 0; j < 4; ++j) { const int ch = (lane + 64 * j) * 8; float y[8];
#pragma unroll
            for (int e = 0; e < 8; ++e) y[e] = v[j][e] * rstd * lg[j][e] + lb[j][e];
            v4u w; w.x = pk2(y[0], y[1]); w.y = pk2(y[2], y[3]); w.z = pk2(y[4], y[5]); w.w = pk2(y[6], y[7]);
            *(GAS v4u*)(VLN + (size_t)m * D + ch) = w;
            if (m >= MP) { float* dst = F.out + OFF_SV + (size_t)(m - MP) * D + ch; *(GAS f32x4*)dst = (f32x4){y[0], y[1], y[2], y[3]}; *(GAS f32x4*)(dst + 4) = (f32x4){y[4], y[5], y[6], y[7]}; }
        }
    }
}
constexpr int MIX_STR = 272, MIX_W = 0, MIX_V = 128 * MIX_STR, MIX_B = MIX_V + 256 * MIX_STR;
__device__ __forceinline__ void sgu_mix_unit(Frame& F, int u) {
    const int tid = opq(F.tid), lane = tid & 63; (void)lane;
    const int g = u & 7, c = u >> 3;
    LAS unsigned char* Wl = F.lds + MIX_W; LAS unsigned char* Vl = F.lds + MIX_V; LAS float* bsl = (LAS float*)(F.lds + MIX_B);
    const float* ws = F.in[IN_SWS] + (size_t)g * 128 * 128;
    const bf16* VLN = (const bf16*)(F.ws + WS_VLN); const bf16* U = (const bf16*)(F.ws + WS_BG); bf16* A2 = (bf16*)(F.ws + WS_O);
    const int r32 = lane & 31, hi = lane >> 5;
    f32x4 wv[8];
#pragma unroll
    for (int i = 0; i < 8; ++i) { const int cc = tid + 512 * i, t = cc >> 5, s4 = (cc & 31) * 4; wv[i] = *(const GAS f32x4*)(ws + t * 128 + s4); }
    v4u vv[8];
#pragma unroll
    for (int it = 0; it < 8; ++it) { const int pi = it * 8 + F.wave, dc = pi >> 1, s = (pi & 1) * 64 + lane; vv[it] = *(const GAS v4u*)(VLN + (size_t)(c * 128 + s) * D + g * 256 + dc * 8); }
    if (tid < 128) bsl[tid] = F.in[IN_SBS][g * 128 + tid];
    unsigned short uu[4][16];
#pragma unroll
    for (int mt = 0; mt < 4; ++mt) { const size_t ib = (size_t)(c * 128 + 32 * mt + 4 * hi) * D + g * 256 + 32 * F.wave + r32;
#pragma unroll
        for (int r = 0; r < 16; ++r) uu[mt][r] = U[ib + (size_t)((r & 3) + 8 * (r >> 2)) * D]; }
#pragma unroll
    for (int i = 0; i < 8; ++i) { const int cc = tid + 512 * i, t = cc >> 5, s4 = (cc & 31) * 4; f32x4 v = wv[i];
        if (s4 + 0 > t) v.x = 0.f; if (s4 + 1 > t) v.y = 0.f; if (s4 + 2 > t) v.z = 0.f; if (s4 + 3 > t) v.w = 0.f;
        v2u w; w.x = pk2(v.x, v.y); w.y = pk2(v.z, v.w); *(LAS v2u*)(Wl + t * MIX_STR + s4 * 2) = w; }
#pragma unroll
    for (int it = 0; it < 8; ++it) { const int pi = it * 8 + F.wave, dc = pi >> 1, s = (pi & 1) * 64 + lane; const v4u v = vv[it];
#pragma unroll
        for (int e = 0; e < 8; ++e) { const unsigned w = v[e >> 1]; *(LAS unsigned short*)(Vl + (dc * 8 + e) * MIX_STR + s * 2) = (unsigned short)((e & 1) ? (w >> 16) : (w & 0xffffu)); } }
    __syncthreads();
#pragma unroll
    for (int mt = 0; mt < 4; ++mt) {
        f32x16 acc = (f32x16){0.f, 0.f, 0.f, 0.f, 0.f, 0.f, 0.f, 0.f, 0.f, 0.f, 0.f, 0.f, 0.f, 0.f, 0.f, 0.f};
#pragma unroll
        for (int ks = 0; ks < 2 * mt + 2; ++ks) {
            const bf16x8 a = *(const LAS bf16x8*)(Wl + (32 * mt + r32) * MIX_STR + (16 * ks + 8 * hi) * 2);
            const bf16x8 bb = *(const LAS bf16x8*)(Vl + (32 * F.wave + r32) * MIX_STR + (16 * ks + 8 * hi) * 2);
            acc = __builtin_amdgcn_mfma_f32_32x32x16_bf16(a, bb, acc, 0, 0, 0);
        }
        const size_t ib = (size_t)(c * 128 + 32 * mt + 4 * hi) * D + g * 256 + 32 * F.wave + r32;
#pragma unroll
        for (int r = 0; r < 16; ++r) { const int t = 32 * mt + crow(r, hi);
            A2[ib + (size_t)((r & 3) + 8 * (r >> 2)) * D] = (bf16)f2bf(bf2f(uu[mt][r]) * (acc[r] + bsl[t])); }
    }
    __syncthreads();
}
__device__ __forceinline__ void sgu_mix_phase(Frame& F) {
    const int tid = opq(F.tid), lane = tid & 63; (void)lane;
    for (int u = blockIdx.x; u < 512; u += F.G) sgu_mix_unit(F, u);
    const bf16* VLN = (const bf16*)(F.ws + WS_VLN); const bf16* U = (const bf16*)(F.ws + WS_BG); bf16* A2 = (bf16*)(F.ws + WS_O);
    for (int r = F.wave * F.G + (int)blockIdx.x; r < MS; r += F.G * NWAVES) {
        const int m = MP + r, l = r & 3, m0 = m - l;
        v4u vr[4][4], ur[4]; float ws[4][4], bs[4];
#pragma unroll
        for (int j = 0; j < 4; ++j) { const int ch = (lane + 64 * j) * 8, g = ch >> 8;
#pragma unroll
            for (int sI = 0; sI < 4; ++sI) { vr[j][sI] = (v4u){0u, 0u, 0u, 0u}; ws[j][sI] = 0.f;
                if (sI <= l) { vr[j][sI] = *(const GAS v4u*)(VLN + (size_t)(m0 + sI) * D + ch); ws[j][sI] = F.in[IN_SWS][(size_t)(g * 128 + l) * 128 + sI]; } }
            ur[j] = *(const GAS v4u*)(U + (size_t)m * D + ch); bs[j] = F.in[IN_SBS][g * 128 + l]; }
#pragma unroll
        for (int j = 0; j < 4; ++j) { const int ch = (lane + 64 * j) * 8;
            float mix[8], uu[8];
#pragma unroll
            for (int e = 0; e < 8; ++e) mix[e] = bs[j];
#pragma unroll
            for (int sI = 0; sI < 4; ++sI) { float vv[8]; unpack8(vr[j][sI], vv);
#pragma unroll
                for (int e = 0; e < 8; ++e) mix[e] += ws[j][sI] * vv[e]; }
            unpack8(ur[j], uu);
            v4u w; w.x = pk2(uu[0] * mix[0], uu[1] * mix[1]); w.y = pk2(uu[2] * mix[2], uu[3] * mix[3]); w.z = pk2(uu[4] * mix[4], uu[5] * mix[5]); w.w = pk2(uu[6] * mix[6], uu[7] * mix[7]);
            *(GAS v4u*)(A2 + (size_t)m * D + ch) = w; }
    }
}

#ifdef SKIP_PRO
#define PRO(...)
#else
#define PRO(...) __VA_ARGS__
#endif
#ifdef SKIP_NRM
#define NRM(...)
#else
#define NRM(...) __VA_ARGS__
#endif
#ifdef SKIP_ATT
#define ATT(...)
#else
#define ATT(...) __VA_ARGS__
#endif
#ifdef SKIP_CNV
#define CNV(...)
#else
#define CNV(...) __VA_ARGS__
#endif
#ifdef SKIP_SGL
#define SGL(...)
#else
#define SGL(...) __VA_ARGS__
#endif
#ifdef SKIP_SGM
#define SGM(...)
#else
#define SGM(...) __VA_ARGS__
#endif
#ifdef SKIP_GM_EpiGated
#define GM_EpiGated(...)
#else
#define GM_EpiGated(...) __VA_ARGS__
#endif
#ifdef SKIP_GM_EpiF32
#define GM_EpiF32(...)
#else
#define GM_EpiF32(...) __VA_ARGS__
#endif
#ifdef SKIP_GM_EpiQKV
#define GM_EpiQKV(...)
#else
#define GM_EpiQKV(...) __VA_ARGS__
#endif
#ifdef SKIP_GM_EpiConvIn
#define GM_EpiConvIn(...)
#else
#define GM_EpiConvIn(...) __VA_ARGS__
#endif
#ifdef SKIP_GM_EpiGeluSplit
#define GM_EpiGeluSplit(...)
#else
#define GM_EpiGeluSplit(...) __VA_ARGS__
#endif

#ifndef MK_PER_PHASE
#define MK_PER_PHASE 0
#endif
constexpr int N_STEPS = 42;
struct Args { const float* in[20]; float* out; unsigned char* ws; int lo, hi, li, pad; };
__global__ void __launch_bounds__(NWAVES * 64, 2) mk_fwd(Args a) {
    extern __shared__ __attribute__((aligned(16))) unsigned char lds_raw[];
    Frame F;
    F.lds = (LAS unsigned char*)lds_raw;
    F.tid = threadIdx.x; F.lane = F.tid & 63; F.wave = __builtin_amdgcn_readfirstlane(F.tid >> 6);
    F.G = gridDim.x; { const int bx = blockIdx.x; F.vcu = (F.G % 8 == 0) ? (bx % 8) * (F.G / 8) + bx / 8 : bx; }
#pragma unroll
    for (int i = 0; i < 20; ++i) F.in[i] = a.in[i];
    F.out = a.out; F.ws = a.ws;
    for (int u = F.tid; u < (LDS_BYTES - LDSCTL_OFF) / 4; u += NWAVES * 64) ((LAS unsigned*)(F.lds + LDSCTL_OFF))[u] = 0u;
    __syncthreads();
    unsigned* barw = (unsigned*)(a.ws + WS_CTL) + CW_BAR + a.li * XCD_BAR_WORDS;
    XcdBarrier bar; bar.bar = barw; bar.x = 0; bar.st = nullptr;
    if (a.hi - a.lo > 1) bar = xcd_barrier_post(barw, (volatile LAS unsigned*)(F.lds + MISC_OFF) + 8);
    int st = 0;
#ifndef XBAR_EXTRA
#define XBAR_EXTRA 0
#endif
#ifndef DUP_MASK
#define DUP_MASK 0
#endif
#define DUPN(bit) (((DUP_MASK) >> (bit)) & 1 ? 2 : 1)
#define CVT(sl) do { } while (0)
#define REP(bit, ...) for (int rep_ = 0; rep_ < DUPN(bit); ++rep_) { __VA_ARGS__ }
#ifdef PROBE_WAIT
#define PT(k) ptype_ = (k);
#define RUN(...) do { if (st >= a.lo && st < a.hi) { __VA_ARGS__; if (st + 1 < a.hi) { const unsigned long long t0_ = __builtin_amdgcn_s_memrealtime(); xcd_barrier(bar); if ((PROBE_WAIT) & ptype_) wacc_ += (unsigned)(__builtin_amdgcn_s_memrealtime() - t0_); } } ++st; } while (0)
    int ptype_ = 0; unsigned wacc_ = 0u;
#elif defined(PROBE_DUR)
#ifndef PROBE_MUL
#define PROBE_MUL 1
#endif
#define PT(k) ptype_ = (k);
#define RUN(...) do { if (st >= a.lo && st < a.hi) { const unsigned long long t0_ = __builtin_amdgcn_s_memrealtime(); __VA_ARGS__; if (st + 1 < a.hi) xcd_barrier(bar); if ((PROBE_DUR) & ptype_) dacc_ += (unsigned)(__builtin_amdgcn_s_memrealtime() - t0_); } ++st; } while (0)
    int ptype_ = 0; unsigned dacc_ = 0u;
#else
#define PT(k)
#define RUN(...) do { if (st >= a.lo && st < a.hi) { __VA_ARGS__; if (st + 1 < a.hi) { xcd_barrier(bar); for (int xb_ = 0; xb_ < XBAR_EXTRA; ++xb_) xcd_barrier(bar); } } ++st; } while (0)
#endif
    const float* ng = F.in[IN_NG];
    bf16* H = (bf16*)(F.ws + WS_H); bf16* ACT = (bf16*)(F.ws + WS_ACT); bf16* OUTF = (bf16*)(F.ws + WS_OUTF); const float* RSTD = (const float*)(F.ws + WS_RSTD); bf16* OB = (bf16*)(F.ws + WS_O);

    PT(32) RUN({ REP(0, PRO(prologue_phase(F);)) });

    const bf16* stA = nullptr; const bf16* stB = nullptr; int stK = 0, stNs = 1, stT = -1; float stAlpha = 0.f; const float* stG = nullptr;
#define SAMP_TAIL(WQ8) do { if (stT >= 0) { \
        unsigned* f1_ = (unsigned*)(F.ws + WS_CTL) + CW_SFLAG + stT * 128; \
        pg8::Gemm gp_{stA, stB, stK}; pg8::PanelOrder SP_; SP_.init(D, stK, stNs, F.G, (int)blockIdx.x, 2); \
        pg8::EpiF32 EP_{OUTF, D, (float*)(F.ws + WS_PART), PART_SLAB}; \
        pg8::gemm_phase<pg8::EpiF32, pg8::PanelOrder, true, true>(F.lds, gp_, SP_, EP_); \
        const int npc_ = SP_.nS < F.G ? SP_.nS : F.G;                        \
        if (F.G - 1 - (int)blockIdx.x < npc_ && F.tid == 0) __hip_atomic_fetch_add(f1_, 1u, __ATOMIC_RELAXED, __HIP_MEMORY_SCOPE_AGENT); \
        sample_tail_norm(F, stAlpha, stG, stNs, WQ8, f1_, (unsigned)npc_, f1_ + 64); } } while (0)
#define SAMP_FLAG (stT >= 0 ? (const unsigned*)((unsigned*)(F.ws + WS_CTL) + CW_SFLAG + stT * 128 + 64) : (const unsigned*)nullptr)

    for (int layer = 0; layer < 4; ++layer) {
        const int kind = layer % 3, jm = layer / 3;
        const float* g = ng + (size_t)layer * 6 * D;
        for (int half = 0; half < 2; ++half) {
            const bf16* wgu = (const bf16*)(F.ws + WS_WFFN + (size_t)(layer * 2 + half) * WFFN_STRIDE);
            const bf16* wd = (const bf16*)((const unsigned char*)wgu + WD_OFF);
            const bool lastsl = (layer == 3 && half == 1);
            const float* gpost = g + (half == 0 ? 1 : 5) * D;
            PT(1) RUN({ SAMP_TAIL(true);
                  pg8::Gemm gm{(const bf16*)(F.ws + WS_XQ8), wgu, D / 2}; pg8::PanelOrder S; S.init(NGU, D / 2, 1, F.G, (int)blockIdx.x, 0, SAMP_FLAG, 128u);
                  pg8::EpiGatedI8 E{ACT, DFF, (const float*)(F.ws + WS_RS8), (const float*)(F.ws + WS_SW) + (size_t)(layer * 2 + half) * NGU};
                  REP(2, GM_EpiGated(pg8::gemm_phase<pg8::EpiGatedI8, pg8::PanelOrder, true, true, true>(F.lds, gm, S, E);)) });
            PT(2) RUN({ pg8::Gemm gm{ACT, wd, DFF}; pg8::PanelOrder S; S.init(D, DFF, NSPLIT_FFN, F.G, (int)blockIdx.x, lastsl ? 0 : 1);
                  pg8::EpiF32 E{OUTF, D, (float*)(F.ws + WS_PART), PART_SLAB};
                  REP(3, GM_EpiF32(pg8::gemm_phase<pg8::EpiF32, pg8::PanelOrder, true, true>(F.lds, gm, S, E);))
                  });
            PT(4) RUN({ NRM(norm_phase(F, 0.5f, gpost, lastsl, NSPLIT_FFN, half == 1 && !lastsl, lastsl);) });
            stA = ACT; stB = wd; stK = DFF; stNs = NSPLIT_FFN; stAlpha = 0.5f; stG = gpost; stT = layer * 3 + 2 * half;
            if (half == 1) break;
            const bf16* mixB = nullptr;
            if (kind == 0) {
                const bf16* wq = (const bf16*)(F.ws + WS_WATT + (size_t)jm * WATT_STRIDE); mixB = (const bf16*)((const unsigned char*)wq + WO_OFF);
                PT(64) RUN({ SAMP_TAIL(false);
                      pg8::Gemm gm{H, wq, D}; pg8::PanelOrder S; S.init(NQKV, D, 1, F.G, (int)blockIdx.x, 0, SAMP_FLAG, 128u);
                      pg8::EpiQKV E{(bf16*)(F.ws + WS_QKV), (const float*)(F.ws + WS_ROPE), (const float*)(F.ws + WS_ROPE) + 4100 * 8, RSTD};
                      REP(5, GM_EpiQKV(pg8::gemm_phase<pg8::EpiQKV, pg8::PanelOrder, true, true>(F.lds, gm, S, E);)) });
                PT(16) RUN({ REP(4, ATT(attn_phase(F, jm);)) });
            } else if (kind == 1) {
                mixB = (const bf16*)(F.ws + WS_WCONV + WCOUT_OFF);
                PT(128) RUN({ SAMP_TAIL(false);
                      pg8::Gemm gm{H, (const bf16*)(F.ws + WS_WCONV), D}; pg8::PanelOrder S; S.init(NCIN, D, 1, F.G, (int)blockIdx.x, 0, SAMP_FLAG, 128u);
                      pg8::EpiConvIn E{(bf16*)(F.ws + WS_BG), (bf16*)(F.ws + WS_Z), RSTD};
                      REP(5, GM_EpiConvIn(pg8::gemm_phase<pg8::EpiConvIn, pg8::PanelOrder, true, true>(F.lds, gm, S, E);)) });
                PT(512) RUN({ REP(6, CNV(convgate_phase(F);)) });
            } else {
                mixB = (const bf16*)(F.ws + WS_WSGU + WSOUT_OFF);
                PT(256) RUN({ SAMP_TAIL(false);
                      pg8::Gemm gm{H, (const bf16*)(F.ws + WS_WSGU), D}; pg8::PanelOrder S; S.init(NSIN, D, 1, F.G, (int)blockIdx.x, 0, SAMP_FLAG, 128u);
                      pg8::EpiGeluSplit E{(bf16*)(F.ws + WS_BG), (bf16*)(F.ws + WS_Z), RSTD};
                      REP(5, GM_EpiGeluSplit(pg8::gemm_phase<pg8::EpiGeluSplit, pg8::PanelOrder, true, true>(F.lds, gm, S, E);)) });
                PT(1024) RUN({ REP(7, SGL(sgu_ln_phase(F);)) });
                PT(2048) RUN({ REP(8, SGM(sgu_mix_phase(F);)) });
            }
            PT(8) RUN({ pg8::Gemm gm{OB, mixB, D}; pg8::PanelOrder S; S.init(D, D, NSPLIT_MIX, F.G, (int)blockIdx.x, 1);
                  pg8::EpiF32 E{OUTF, D, (float*)(F.ws + WS_PART), PART_SLAB};
                  REP(5, GM_EpiF32(pg8::gemm_phase<pg8::EpiF32, pg8::PanelOrder, true, true>(F.lds, gm, S, E);)) });
            PT(4) RUN({ NRM(norm_phase(F, 1.0f, g + 3 * D, false, NSPLIT_MIX, true, false);) });
            stA = OB; stB = mixB; stK = D; stNs = NSPLIT_MIX; stAlpha = 1.0f; stG = g + 3 * D; stT = layer * 3 + 1;
        }
    }
#ifdef PROBE_WAIT
    {
        unsigned* tw = (unsigned*)(a.ws + WS_CTL) + 30000;
        if (threadIdx.x == 0) __hip_atomic_fetch_add(tw, wacc_, __ATOMIC_RELAXED, __HIP_MEMORY_SCOPE_AGENT);
        xcd_barrier(bar);
        const unsigned tot = __hip_atomic_load(tw, __ATOMIC_RELAXED, __HIP_MEMORY_SCOPE_AGENT);
        const unsigned long long t0 = __builtin_amdgcn_s_memrealtime(), dt = (unsigned long long)(tot / (unsigned)F.G);
        while (__builtin_amdgcn_s_memrealtime() - t0 < dt) __builtin_amdgcn_s_sleep(8);
    }
#endif
#ifdef PROBE_DUR
    { const unsigned long long t0 = __builtin_amdgcn_s_memrealtime(); while (__builtin_amdgcn_s_memrealtime() - t0 < (unsigned long long)dacc_ * (PROBE_MUL)) __builtin_amdgcn_s_sleep(8); }
#endif
#undef SAMP_TAIL
#undef SAMP_FLAG
#undef RUN
}

extern "C" void kernel_launch(void* const* d_in, const int* in_sizes, int n_in, void* d_out, int out_size, void* d_ws, size_t ws_size, hipStream_t stream) {
    static int grid = 0;
    if (grid == 0) {
        if (n_in != 20 || (size_t)out_size != OUT_TOTAL || ws_size < WS_END) { fprintf(stderr, "kernel_launch: unexpected shapes: n_in %d out %d ws %zu (need %zu)\n", n_in, out_size, ws_size, (size_t)WS_END); grid = -1; return; }
        int dev = 0, cus = 0, per_cu = 0;
        if (hipGetDevice(&dev) != hipSuccess || hipDeviceGetAttribute(&cus, hipDeviceAttributeMultiprocessorCount, dev) != hipSuccess) { grid = -1; return; }
        if (hipFuncSetAttribute((const void*)mk_fwd, hipFuncAttributeMaxDynamicSharedMemorySize, LDS_BYTES) != hipSuccess) { fprintf(stderr, "kernel_launch: hipFuncSetAttribute failed\n"); grid = -1; return; }
        if (hipOccupancyMaxActiveBlocksPerMultiprocessor(&per_cu, (const void*)mk_fwd, NWAVES * 64, LDS_BYTES) != hipSuccess || per_cu < 1) fprintf(stderr, "kernel_launch: occupancy query says %d\n", per_cu);
        (void)hipGetLastError();
        grid = cus;
    }
    if (grid < 0) return;
    (void)hipMemsetAsync((char*)d_ws + WS_CTL, 0, CTL_ZERO_BYTES, stream);
    Args a{};
    for (int i = 0; i < 20; ++i) a.in[i] = (const float*)d_in[i];
    a.out = (float*)d_out; a.ws = (unsigned char*)d_ws; a.pad = 0;
#if MK_PER_PHASE
    for (int s = 0; s < N_STEPS; ++s) { a.lo = s; a.hi = s + 1; a.li = 0; hipLaunchKernelGGL(mk_fwd, dim3(grid), dim3(NWAVES * 64), LDS_BYTES, stream, a); }
#else
    a.lo = 0; a.hi = N_STEPS; a.li = 0;
    hipLaunchKernelGGL(mk_fwd, dim3(grid), dim3(NWAVES * 64), LDS_BYTES, stream, a);
#endif
    const hipError_t le = hipPeekAtLastError();
    if (le != hipSuccess) fprintf(stderr, "kernel_launch: launch failed: %s\n", hipGetErrorName(le));
}
```

```cpp
#include <hip/hip_runtime.h>
#include <cstdio>
#include <cstdint>
namespace pg8 {
#define PG8_LAS __attribute__((address_space(3)))
typedef unsigned short bf16_t;
typedef short bf16x8 __attribute__((ext_vector_type(8)));
typedef float f32x4 __attribute__((ext_vector_type(4)));
typedef unsigned u32x4 __attribute__((ext_vector_type(4)));
typedef int i32x4 __attribute__((ext_vector_type(4)));
constexpr int BM = 256, BK = 64, HALF = 128, HTB = HALF * BK * 2  , STAGE_BYTES = 8 * HTB, NXCD = 8, WGM = 8;

__host__ __device__ __forceinline__ int lds_byte(int r, int c) { const int st = (r >> 4) * 2 + (c >> 5), rr = r & 15, cc = c & 31, ob = rr * 64 + cc * 2; return st * 1024 + (ob ^ (((ob >> 9) & 1) << 5)); }
__host__ __device__ __forceinline__ void stage_rc(int b, int& R, int& C) { const int st = b / 1024, sb = b % 1024, swz = sb ^ (((sb >> 9) & 1) << 5); R = (st >> 1) * 16 + swz / 64; C = (st & 1) * 32 + (swz % 64) / 2; }
__host__ __device__ __forceinline__ int perm32(int rho) { const int n = rho >> 4, i = rho & 15; return 8 * (i >> 2) + 4 * n + (i & 3); }

struct Unit { int pm, pn, ks, nt, hm, roff; };
struct Gemm { const bf16_t* A; const bf16_t* Bt; int K; };

struct StaticOrder {
    int nM, nN, nwg, G, c;
    __host__ __device__ void init(int M, int N, int G_, int c_) { nM = M / BM; nN = N / BM; nwg = nM * nN; G = G_; c = c_; }
    __host__ __device__ bool next(int i, Unit& u) const {
        const long L = (long)i * G + c; if (L >= nwg) return false;
        int wgid = (int)L; { const int q = nwg / NXCD, r = nwg % NXCD, xcd = wgid % NXCD, off = wgid / NXCD; wgid = (xcd < r ? xcd * (q + 1) : r * (q + 1) + (xcd - r) * q) + off; }
        const int nig = WGM * nN, gid = wgid / nig, fm = gid * WGM, gsz = (nM - fm) < WGM ? (nM - fm) : WGM;
        u.pm = fm + ((wgid % nig) % gsz); u.pn = (wgid % nig) / gsz; u.ks = 0; u.nt = 0; u.hm = 0; u.roff = 0; return true;
    }
    __device__ __forceinline__ void a_ready(const Unit&) const {}
    __device__ __forceinline__ void done(const Unit&) const {}
};
struct PanelOrder {
    int xm = 1;
    int swp = 0;
    int xr = 0;
    int nN, nP, nS, nsplit, G, c, ntFull, L0, L1, nF, nH;
    const unsigned* flag; unsigned need;
    __device__ __forceinline__ void init(int N, int K, int nsplit_, int G_, int c_, int mode = 0, const unsigned* flag_ = nullptr, unsigned need_ = 0u) {
        nN = N / BM; nP = 32 * nN; nsplit = nsplit_; nS = (mode == 1) ? 0 : nN * nsplit_; G = G_; c = c_; ntFull = K / BK; flag = flag_; need = need_;
        if (mode == 2) { nF = 0; nH = 0; c = G_ - 1 - c_; L0 = 0; L1 = nS; return; }
        const int R = nP % G_;
        nH = (R > 0 && 2 * R + nS <= G_) ? 2 * R : 0; nF = nP - nH / 2; L0 = 0; L1 = nF + nH + nS; }
    __device__ __forceinline__ void prompt_unit(int b, Unit& u) const {
        int wgid = b; { const int q = nP / NXCD, r = nP % NXCD, xcd = wgid % NXCD, off = wgid / NXCD; wgid = (xcd < r ? xcd * (q + 1) : r * (q + 1) + (xcd - r) * q) + off; }
        const int nig = WGM * nN, gid = wgid / nig, fm = gid * WGM;
        u.pm = fm + ((wgid % nig) % WGM); u.pn = (wgid % nig) / WGM; u.ks = 0; u.nt = ntFull; }
    __device__ __forceinline__ bool next(int i, Unit& u) const {
        const int L = L0 + i * G + (((swp == 2) || (swp && (i & 1))) ? (c ^ xm) : c); if (L >= L1) return false;
        if (L < nF) { prompt_unit(L, u); u.hm = 0; u.roff = 0; if (i & 1) u.pn ^= xr; }
        else if (L < nF + nH) { const int j = L - nF; prompt_unit(nF + (j >> 1), u); u.hm = 1; u.roff = 128 * (j & 1); }
        else { const int j = L - nF - nH; u.pm = 32; u.pn = j % nN; u.ks = j / nN; u.nt = ntFull / nsplit; u.hm = 1; u.roff = 0; }
        return true;
    }
    __device__ __forceinline__ void a_ready(const Unit& u) const {
        if (flag == nullptr || u.pm != 32) return;
        if (threadIdx.x < 64) {
            unsigned spins = 0;
            while ((unsigned)__builtin_amdgcn_readfirstlane(__hip_atomic_load(flag, __ATOMIC_RELAXED, __HIP_MEMORY_SCOPE_AGENT)) < need) { __builtin_amdgcn_s_sleep(2); if (++spins > (1u << 22)) break; }
            __builtin_amdgcn_fence(__ATOMIC_ACQUIRE, "agent");
            asm volatile("s_waitcnt vmcnt(0)" ::: "memory");
        }
        asm volatile("" ::: "memory"); __builtin_amdgcn_s_barrier(); asm volatile("" ::: "memory");
    }
    __device__ __forceinline__ void done(const Unit&) const {}
};


__device__ __forceinline__ void st16_wt(const void* base, const void* p, u32x4 v) {
    const __amdgpu_buffer_rsrc_t rs = __builtin_amdgcn_make_buffer_rsrc((void*)base, (short)0, 0x7ffffff0, 0x00020000);
    __builtin_amdgcn_raw_buffer_store_b128(v, rs, (int)((const char*)p - (const char*)base), 0, 16);
}
typedef float f32x2_cv __attribute__((ext_vector_type(2))); typedef __bf16 bf16x2_cv __attribute__((ext_vector_type(2)));
__device__ __forceinline__ unsigned cvt_pk_bf16(float lo, float hi) { const f32x2_cv v = {lo, hi}; const bf16x2_cv b = __builtin_convertvector(v, bf16x2_cv); return __builtin_bit_cast(unsigned, b); }
typedef unsigned u32x2 __attribute__((ext_vector_type(2)));
__device__ __forceinline__ float silu_f(float x) { return x * __builtin_amdgcn_rcpf(1.0f + __builtin_amdgcn_exp2f(-1.44269504089f * x)); }
__device__ __forceinline__ float gelu_tanh_f(float x) { const float t = x * (1.0f + 0.044715f * x * x) * (-2.0f * 0.7978845608f * 1.44269504089f); return x * __builtin_amdgcn_rcpf(1.0f + __builtin_amdgcn_exp2f(t)); }
__device__ __forceinline__ u32x4 pack8(const f32x4 a, const f32x4 b) { u32x4 w; w.x = cvt_pk_bf16(a[0], a[1]); w.y = cvt_pk_bf16(a[2], a[3]); w.z = cvt_pk_bf16(b[0], b[1]); w.w = cvt_pk_bf16(b[2], b[3]); return w; }

struct EpiF32 {
    static constexpr bool PERM = true, AFTER_DRAIN = false;
    bf16_t* O; int ldc; float* P; size_t slab;
    __device__ __forceinline__ void operator()(const f32x4 (&acc)[2][2][4][2], const Unit& u, int wr, int wc, int fr, int fq) const {
        const int col0 = u.pn * BM + wc * 32 + 8 * fq;
        if (u.pm == 32) {
            const int row0 = wr * 64 + fr; float* base = P + (size_t)u.ks * slab;
#pragma unroll
            for (int m = 0; m < 4; ++m) { float* rowp = base + (size_t)(row0 + m * 16) * ldc + col0;
#pragma unroll
                for (int bj = 0; bj < 2; ++bj)
#pragma unroll
                    for (int n = 0; n < 2; ++n)
                        st16_wt(base, rowp + bj * HALF + 4 * n, __builtin_bit_cast(u32x4, acc[0][bj][m][n])); }
        } else {
            const int row0 = u.pm * BM + u.roff + wr * 64 + fr;
#pragma unroll
            for (int ai = 0; ai < 2; ++ai) { if (ai == 1 && u.hm) break;
#pragma unroll
                for (int m = 0; m < 4; ++m) { bf16_t* rowp = O + (size_t)(row0 + ai * HALF + m * 16) * ldc + col0;
#pragma unroll
                    for (int bj = 0; bj < 2; ++bj) *(u32x4*)(rowp + bj * HALF) = pack8(acc[ai][bj][m][0], acc[ai][bj][m][1]); } }
        }
    }
};
template <int ACT> struct EpiGated {
    static constexpr bool PERM = true, AFTER_DRAIN = false;
    bf16_t* O; int ldc; const float* rstd;
    __device__ __forceinline__ void operator()(const f32x4 (&acc)[2][2][4][2], const Unit& u, int wr, int wc, int fr, int fq) const {
        const int row0 = u.pm * BM + u.roff + wr * 64 + fr, col0 = u.pn * HALF + wc * 32 + 8 * fq;
        float rsr[2][4];
#pragma unroll
        for (int ai = 0; ai < 2; ++ai)
#pragma unroll
            for (int m = 0; m < 4; ++m) rsr[ai][m] = rstd[row0 + ai * HALF + m * 16];
#pragma unroll
        for (int ai = 0; ai < 2; ++ai) { if (ai == 1 && u.hm) break;
#pragma unroll
            for (int m = 0; m < 4; ++m) { bf16_t* rowp = O + (size_t)(row0 + ai * HALF + m * 16) * ldc + col0; const float rs = rsr[ai][m];
                f32x4 v0, v1;
#pragma unroll
                for (int e = 0; e < 4; ++e) { const float g0 = acc[ai][0][m][0][e] * rs, g1 = acc[ai][0][m][1][e] * rs;
                    v0[e] = (ACT ? silu_f(g0) : g0) * (acc[ai][1][m][0][e] * rs); v1[e] = (ACT ? silu_f(g1) : g1) * (acc[ai][1][m][1][e] * rs); }
                *(u32x4*)rowp = pack8(v0, v1); } }
    }
};
struct EpiGatedI8 {
    static constexpr bool PERM = true, AFTER_DRAIN = false;
    bf16_t* O; int ldc; const float* rs; const float* sw;
    __device__ __forceinline__ void operator()(const f32x4 (&acc)[2][2][4][2], const Unit& u, int wr, int wc, int fr, int fq) const {
        const int row0 = u.pm * BM + u.roff + wr * 64 + fr, cl = wc * 32 + 8 * fq, col0 = u.pn * HALF + cl;
        const f32x4 sg0 = *(const f32x4*)(sw + u.pn * BM + cl) * -1.44269504089f, sg1 = *(const f32x4*)(sw + u.pn * BM + cl + 4) * -1.44269504089f,
                    su0 = *(const f32x4*)(sw + u.pn * BM + HALF + cl) * -0.69314718056f, su1 = *(const f32x4*)(sw + u.pn * BM + HALF + cl + 4) * -0.69314718056f;
        float rsr[2][4];
#pragma unroll
        for (int ai = 0; ai < 2; ++ai)
#pragma unroll
            for (int m = 0; m < 4; ++m) rsr[ai][m] = rs[row0 + ai * HALF + m * 16];
#pragma unroll
        for (int ai = 0; ai < 2; ++ai) { if (ai == 1 && u.hm) break;
#pragma unroll
            for (int m = 0; m < 4; ++m) { bf16_t* rowp = O + (size_t)(row0 + ai * HALF + m * 16) * ldc + col0; const float r = rsr[ai][m];
                f32x4 v0, v1;
#pragma unroll
                for (int e = 0; e < 4; ++e) {
                    const float ag0 = acc[ai][0][m][0][e], ag1 = acc[ai][0][m][1][e], au0 = acc[ai][1][m][0][e], au1 = acc[ai][1][m][1][e];
                    const float t0 = (float)__float_as_int(ag0) * (r * sg0[e]), t1 = (float)__float_as_int(ag1) * (r * sg1[e]);
                    const float u0 = (float)__float_as_int(au0) * (r * su0[e]), u1 = (float)__float_as_int(au1) * (r * su1[e]);
                    v0[e] = (t0 * u0) * __builtin_amdgcn_rcpf(1.0f + __builtin_amdgcn_exp2f(t0)); v1[e] = (t1 * u1) * __builtin_amdgcn_rcpf(1.0f + __builtin_amdgcn_exp2f(t1)); }
                *(u32x4*)rowp = pack8(v0, v1); } }
    }
};
struct EpiConvIn {
    static constexpr bool PERM = true, AFTER_DRAIN = false;
    bf16_t* BG; bf16_t* Z; const float* rstd;
    __device__ __forceinline__ void operator()(const f32x4 (&acc)[2][2][4][2], const Unit& u, int wr, int wc, int fr, int fq) const {
        const int row0 = u.pm * BM + u.roff + wr * 64 + fr;
        float rsr[2][4];
#pragma unroll
        for (int ai = 0; ai < 2; ++ai)
#pragma unroll
            for (int m = 0; m < 4; ++m) rsr[ai][m] = rstd[row0 + ai * HALF + m * 16];
        if (u.pn < 8) {
            const int col0 = u.pn * BM + wc * 32 + 8 * fq;
#pragma unroll
            for (int ai = 0; ai < 2; ++ai) { if (ai == 1 && u.hm) break;
#pragma unroll
                for (int m = 0; m < 4; ++m) { bf16_t* rowp = BG + (size_t)(row0 + ai * HALF + m * 16) * 2048 + col0; const float rs = rsr[ai][m];
#pragma unroll
                    for (int bj = 0; bj < 2; ++bj) *(u32x4*)(rowp + bj * HALF) = pack8(acc[ai][bj][m][0] * rs, acc[ai][bj][m][1] * rs); } }
        } else {
            const int col0 = (u.pn - 8) * HALF + wc * 32 + 8 * fq;
#pragma unroll
            for (int ai = 0; ai < 2; ++ai) { if (ai == 1 && u.hm) break;
#pragma unroll
                for (int m = 0; m < 4; ++m) { bf16_t* rowp = Z + (size_t)(row0 + ai * HALF + m * 16) * 2048 + col0; const float rs = rsr[ai][m], rs2 = rs * rs;
                    *(u32x4*)rowp = pack8(acc[ai][0][m][0] * acc[ai][1][m][0] * rs2, acc[ai][0][m][1] * acc[ai][1][m][1] * rs2); } }
        }
    }
};
struct EpiGeluSplit {
    static constexpr bool PERM = true, AFTER_DRAIN = false;
    bf16_t* U; bf16_t* V; const float* rstd;
    __device__ __forceinline__ void operator()(const f32x4 (&acc)[2][2][4][2], const Unit& u, int wr, int wc, int fr, int fq) const {
        const int row0 = u.pm * BM + u.roff + wr * 64 + fr, col0 = (u.pn & 7) * BM + wc * 32 + 8 * fq;
        bf16_t* base = (u.pn < 8) ? U : V;
        float rsr[2][4];
#pragma unroll
        for (int ai = 0; ai < 2; ++ai)
#pragma unroll
            for (int m = 0; m < 4; ++m) rsr[ai][m] = rstd[row0 + ai * HALF + m * 16];
#pragma unroll
        for (int ai = 0; ai < 2; ++ai) { if (ai == 1 && u.hm) break;
#pragma unroll
            for (int m = 0; m < 4; ++m) { bf16_t* rowp = base + (size_t)(row0 + ai * HALF + m * 16) * 2048 + col0; const float rs = rsr[ai][m];
#pragma unroll
                for (int bj = 0; bj < 2; ++bj) { f32x4 v0, v1;
#pragma unroll
                    for (int e = 0; e < 4; ++e) { v0[e] = gelu_tanh_f(acc[ai][bj][m][0][e] * rs); v1[e] = gelu_tanh_f(acc[ai][bj][m][1][e] * rs); }
                    *(u32x4*)(rowp + bj * HALF) = pack8(v0, v1); } } }
    }
};
struct EpiQKV {
    static constexpr bool PERM = true, AFTER_DRAIN = false;
    bf16_t* O; const float* rope_c; const float* rope_s; const float* rstd;
    __device__ __forceinline__ void operator()(const f32x4 (&acc)[2][2][4][2], const Unit& u, int wr, int wc, int fr, int fq) const {
        const int row0 = u.pm * BM + u.roff + wr * 64 + fr, col0 = u.pn * BM + wc * 32 + 8 * fq;
        const bool rot_tile = (u.pn < 9) && ((wc & 1) == 0);
        const bool rot_lane = fq < 2;
        const float sgn = (fq == 0) ? -1.0f : 1.0f;
#pragma unroll
        for (int ai = 0; ai < 2; ++ai) { if (ai == 1 && u.hm) break;
#pragma unroll
            for (int m = 0; m < 4; ++m) { const int row = row0 + ai * HALF + m * 16; bf16_t* rowp = O + (size_t)row * 2560 + col0; const float rs = rstd[row];
                if (rot_tile) {
                    const int slot = row < 8192 ? (row & 4095) : (row < 8320 ? 4096 + ((row - 8192) & 3) : 0);
                    const f32x4 c0 = *(const f32x4*)(rope_c + slot * 8), c1 = *(const f32x4*)(rope_c + slot * 8 + 4);
                    const f32x4 s0 = *(const f32x4*)(rope_s + slot * 8), s1 = *(const f32x4*)(rope_s + slot * 8 + 4);
#pragma unroll
                    for (int bj = 0; bj < 2; ++bj) { f32x4 v0 = acc[ai][bj][m][0] * rs, v1 = acc[ai][bj][m][1] * rs, o0, o1;
#pragma unroll
                        for (int e = 0; e < 4; ++e) { o0[e] = __shfl_xor(v0[e], 16); o1[e] = __shfl_xor(v1[e], 16); }
                        if (rot_lane) {
#pragma unroll
                            for (int e = 0; e < 4; ++e) { v0[e] = v0[e] * c0[e] + sgn * o0[e] * s0[e]; v1[e] = v1[e] * c1[e] + sgn * o1[e] * s1[e]; } }
                        *(u32x4*)(rowp + bj * HALF) = pack8(v0, v1); }
                } else {
#pragma unroll
                    for (int bj = 0; bj < 2; ++bj) *(u32x4*)(rowp + bj * HALF) = pack8(acc[ai][bj][m][0] * rs, acc[ai][bj][m][1] * rs);
                }
            } }
    }
};


template <class Epi, class Sched, bool ALIGN_EPI = false, bool SP2 = false, bool I8 = false>
__device__ __forceinline__ void gemm_phase(PG8_LAS unsigned char* lds, const Gemm g, const Sched& S, const Epi& E) {
    int tid_ = threadIdx.x; asm volatile("" : "+v"(tid_));
    const int tid = tid_, wid = __builtin_amdgcn_readfirstlane(tid >> 6), lane = tid & 63, wr = wid >> 2, wc = wid & 3, fr = lane & 15, fq = lane >> 4;
    const int LD = g.K;
    unsigned voffA[2], voffB[2];
#pragma unroll
    for (int i = 0; i < 2; ++i) { int R, C; stage_rc(tid * 16 + i * 8192, R, C); const int Rb = Epi::PERM ? ((R & ~31) + perm32(R & 31)) : R;
        voffA[i] = (unsigned)(R * LD + C) * 2u; voffB[i] = (unsigned)(Rb * LD + C) * 2u; }
    const size_t kstep = (size_t)(BK * 2);
    const size_t hstep = (size_t)HALF * LD * 2;
    const size_t tstep = 2 * hstep;
    const unsigned ldsw = (unsigned)wid * 1024u;
    const int aoff = lds_byte(wr * 64 + fr, fq * 8), boff = lds_byte(wc * 32 + fr, fq * 8);
#define PG8_SA(b, h) (((b) * 2 + (h)) * HTB)
#define PG8_SB(b, h) ((4 + (b) * 2 + (h)) * HTB)
#define PG8_STAGE(bufoff, gbase, voff) do { _Pragma("unroll") for (int _i = 0; _i < 2; ++_i) \
        __builtin_amdgcn_global_load_lds((const unsigned*)((const char*)(gbase) + (voff)[_i]), (PG8_LAS unsigned*)(lds + (bufoff) + ldsw + _i * 8192), 16, 0, 0); } while (0)
#define PG8_LDA(dst, b, h) do { _Pragma("unroll") for (int m = 0; m < 4; ++m) _Pragma("unroll") for (int k = 0; k < 2; ++k) dst[m][k] = *(const PG8_LAS bf16x8*)(lds + PG8_SA(b, h) + aoff + m * 2048 + k * 1024); } while (0)
#define PG8_LDB(dst, b, h) do { _Pragma("unroll") for (int n = 0; n < 2; ++n) _Pragma("unroll") for (int k = 0; k < 2; ++k) dst[n][k] = *(const PG8_LAS bf16x8*)(lds + PG8_SB(b, h) + boff + n * 2048 + k * 1024); } while (0)
#define PG8_MMA(ai, bj, At, Bt) do { __builtin_amdgcn_s_setprio(1); _Pragma("unroll") for (int m = 0; m < 4; ++m) _Pragma("unroll") for (int n = 0; n < 2; ++n) _Pragma("unroll") for (int k = 0; k < 2; ++k) \
        { if constexpr (I8) acc[ai][bj][m][n] = __builtin_bit_cast(f32x4, __builtin_amdgcn_mfma_i32_16x16x64_i8(__builtin_bit_cast(i32x4, Bt[n][k]), __builtin_bit_cast(i32x4, At[m][k]), __builtin_bit_cast(i32x4, acc[ai][bj][m][n]), 0, 0, 0)); \
          else acc[ai][bj][m][n] = __builtin_amdgcn_mfma_f32_16x16x32_bf16(Bt[n][k], At[m][k], acc[ai][bj][m][n], 0, 0, 0); } __builtin_amdgcn_s_setprio(0); } while (0)
#define PG8_WAIT_V(n) asm volatile("s_waitcnt vmcnt(" #n ")" ::: "memory")
#define PG8_WAIT_L(n) asm volatile("s_waitcnt lgkmcnt(" #n ")" ::: "memory")
#define PG8_BAR __builtin_amdgcn_s_barrier()
#define PG8_SCHED __builtin_amdgcn_sched_barrier(0)
    Unit cur, nxt; int ui = 0;
    if (!S.next(0, cur)) return;
    f32x4 acc[2][2][4][2];
#pragma unroll
    for (int a = 0; a < 2; ++a)
#pragma unroll
        for (int b = 0; b < 2; ++b)
#pragma unroll
            for (int m = 0; m < 4; ++m)
#pragma unroll
                for (int n = 0; n < 2; ++n) acc[a][b][m][n] = (f32x4){0.f, 0.f, 0.f, 0.f};
    bf16x8 At[4][2], B0[2][2], B1[2][2];
    int nt = cur.nt; bool hm = cur.hm != 0;
#define PG8_KOFFB(u) ((size_t)(u).ks * (size_t)(u).nt * (BK * 2))
#define PG8_KOFF(u) ((size_t)(u).ks * (size_t)(u).nt * (BK * 2) + (size_t)(u).roff * (size_t)LD * 2)
    const char* cA = (const char*)g.A + (size_t)cur.pm * tstep + PG8_KOFF(cur); const char* cB = (const char*)g.Bt + (size_t)cur.pn * tstep + PG8_KOFFB(cur);
    S.a_ready(cur);
    if constexpr (SP2) {
        PG8_STAGE(PG8_SB(0, 0), cB, voffB); PG8_STAGE(PG8_SB(0, 1), cB + hstep, voffB); PG8_STAGE(PG8_SA(0, 0), cA, voffA); PG8_STAGE(PG8_SA(0, 1), cA + hstep, voffA);
        if (wr == 1) PG8_BAR;
        PG8_WAIT_V(2); PG8_BAR;
        PG8_STAGE(PG8_SB(1, 0), cB + kstep, voffB); PG8_STAGE(PG8_SA(1, 0), cA + kstep, voffA); PG8_STAGE(PG8_SB(1, 1), cB + hstep + kstep, voffB);
        PG8_WAIT_V(6); PG8_BAR;
    } else {
        PG8_STAGE(PG8_SB(0, 0), cB, voffB); PG8_STAGE(PG8_SA(0, 0), cA, voffA); PG8_STAGE(PG8_SB(0, 1), cB + hstep, voffB); PG8_STAGE(PG8_SA(0, 1), cA + hstep, voffA);
        if (wr == 1) PG8_BAR;
        PG8_WAIT_V(4); PG8_BAR;
        PG8_STAGE(PG8_SB(1, 0), cB + kstep, voffB); PG8_STAGE(PG8_SA(1, 0), cA + kstep, voffA); PG8_STAGE(PG8_SB(1, 1), cB + hstep + kstep, voffB);
        PG8_WAIT_V(6); PG8_BAR;
    }
    for (;;) {
        const bool has_next = S.next(ui + 1, nxt);
        const char* nA = has_next ? (const char*)g.A + (size_t)nxt.pm * tstep + PG8_KOFF(nxt) : cA; const char* nB = has_next ? (const char*)g.Bt + (size_t)nxt.pn * tstep + PG8_KOFFB(nxt) : cB;
        for (int t = 0; t < nt; t += 2) {
            const bool last = (t == nt - 2);
            const char* a1 = cA + (size_t)(t + 1) * kstep;
            const char* a2 = last ? nA : cA + (size_t)(t + 2) * kstep; const char* b2 = last ? nB : cB + (size_t)(t + 2) * kstep;
            const char* a3 = a2 + kstep; const char* b3 = b2 + kstep;
            if (last && has_next) S.a_ready(nxt);
            if constexpr (SP2) {
            PG8_LDB(B0, 0, 0); PG8_LDB(B1, 0, 1); PG8_SCHED; PG8_LDA(At, 0, 0); PG8_STAGE(PG8_SA(1, 1), a1 + hstep, voffA);
            PG8_WAIT_V(8); PG8_WAIT_L(0); PG8_BAR; PG8_MMA(0, 0, At, B0); PG8_MMA(0, 1, At, B1); PG8_BAR; PG8_SCHED;
            if (!hm) { PG8_LDA(At, 0, 1); } PG8_STAGE(PG8_SB(0, 0), b2, voffB); PG8_STAGE(PG8_SB(0, 1), b2 + hstep, voffB); PG8_STAGE(PG8_SA(0, 0), a2, voffA);
            PG8_WAIT_V(8); PG8_WAIT_L(0); PG8_BAR; if (!hm) { PG8_MMA(1, 0, At, B0); PG8_MMA(1, 1, At, B1); } PG8_BAR; PG8_SCHED;
            PG8_LDB(B0, 1, 0); PG8_LDB(B1, 1, 1); PG8_SCHED; PG8_LDA(At, 1, 0); PG8_STAGE(PG8_SA(0, 1), a2 + hstep, voffA);
            PG8_WAIT_V(8); PG8_WAIT_L(0); PG8_BAR; PG8_MMA(0, 0, At, B0); PG8_MMA(0, 1, At, B1); PG8_BAR; PG8_SCHED;
            if (!hm) { PG8_LDA(At, 1, 1); } PG8_STAGE(PG8_SB(1, 0), b3, voffB); PG8_STAGE(PG8_SB(1, 1), b3 + hstep, voffB); PG8_STAGE(PG8_SA(1, 0), a3, voffA);
            PG8_WAIT_V(8); PG8_WAIT_L(0); PG8_BAR; if (!hm) { PG8_MMA(1, 0, At, B0); PG8_MMA(1, 1, At, B1); } PG8_BAR; PG8_SCHED;
            } else {
            PG8_LDB(B0, 0, 0); PG8_SCHED; PG8_LDA(At, 0, 0); PG8_STAGE(PG8_SA(1, 1), a1 + hstep, voffA);
            PG8_WAIT_L(8); PG8_BAR; PG8_WAIT_L(0); PG8_MMA(0, 0, At, B0); PG8_BAR; PG8_SCHED;
            PG8_LDB(B1, 0, 1); PG8_STAGE(PG8_SB(0, 0), b2, voffB);
            PG8_BAR; PG8_WAIT_L(0); PG8_MMA(0, 1, At, B1); PG8_BAR;
            PG8_LDA(At, 0, 1); PG8_STAGE(PG8_SA(0, 0), a2, voffA);
            PG8_BAR; PG8_WAIT_L(0); PG8_MMA(1, 0, At, B0); PG8_BAR; PG8_SCHED;
            PG8_STAGE(PG8_SB(0, 1), b2 + hstep, voffB);
            PG8_WAIT_V(6); PG8_BAR; PG8_MMA(1, 1, At, B1); PG8_BAR;
            PG8_LDB(B0, 1, 0); PG8_SCHED; PG8_LDA(At, 1, 0); PG8_STAGE(PG8_SA(0, 1), a2 + hstep, voffA);
            PG8_WAIT_L(8); PG8_BAR; PG8_WAIT_L(0); PG8_MMA(0, 0, At, B0); PG8_BAR; PG8_SCHED;
            PG8_LDB(B1, 1, 1); PG8_STAGE(PG8_SB(1, 0), b3, voffB);
            PG8_BAR; PG8_WAIT_L(0); PG8_MMA(0, 1, At, B1); PG8_BAR;
            PG8_LDA(At, 1, 1); PG8_STAGE(PG8_SA(1, 0), a3, voffA);
            PG8_BAR; PG8_WAIT_L(0); PG8_MMA(1, 0, At, B0); PG8_BAR; PG8_SCHED;
            PG8_STAGE(PG8_SB(1, 1), b3 + hstep, voffB);
            PG8_WAIT_V(6); PG8_BAR; PG8_MMA(1, 1, At, B1); PG8_BAR;
            }
        }
        if constexpr (ALIGN_EPI) { if (wr == 0) PG8_BAR; }
        if constexpr (!Epi::AFTER_DRAIN) { E(acc, cur, wr, wc, fr, fq); S.done(cur); }
        if (!has_next) break;
#pragma unroll
        for (int a = 0; a < 2; ++a)
#pragma unroll
            for (int b = 0; b < 2; ++b)
#pragma unroll
                for (int m = 0; m < 4; ++m)
#pragma unroll
                    for (int n = 0; n < 2; ++n) acc[a][b][m][n] = (f32x4){0.f, 0.f, 0.f, 0.f};
        cur = nxt; cA = nA; cB = nB; ++ui; nt = cur.nt; hm = cur.hm != 0;
        if constexpr (ALIGN_EPI) { if (wr == 1) PG8_BAR; }
    }
    PG8_WAIT_V(0);
    if constexpr (!ALIGN_EPI) { if (wr == 0) PG8_BAR; }
    PG8_BAR;
    if constexpr (Epi::AFTER_DRAIN) { E.fused(acc, cur, wr, wc, fr, fq, lds, wid, lane); S.done(cur); }
#undef PG8_KOFF
#undef PG8_KOFFB
#undef PG8_SA
#undef PG8_SB
#undef PG8_STAGE
#undef PG8_LDA
#undef PG8_LDB
#undef PG8_MMA
#undef PG8_WAIT_V
#undef PG8_WAIT_L
#undef PG8_BAR
#undef PG8_SCHED
}
}

constexpr int NWAVES = 8;
constexpr int D = 2048, DFF = 5632, NGU = 2 * DFF, SEQ = 4096, NBATCH = 2, MP = NBATCH * SEQ, DBATCH = 32, DSEQ = 4, MS = DBATCH * DSEQ;
constexpr int MR = MP + MS;
constexpr int M = 8448;
constexpr int NQKV = 2560, NCIN = 6144, NSIN = 4096;
constexpr int BM_ROWS = 256;
constexpr float RMS_EPS = 1e-6f, LN_EPS = 1e-5f, LOG2E = 1.4426950408889634f;
constexpr size_t OFF_Y = 0, OFF_KP = (size_t)MR * D, OFF_VP = OFF_KP + 131072, OFF_KS = OFF_VP + 131072, OFF_VS = OFF_KS + 2097152,
                 OFF_CP = OFF_VS + 2097152, OFF_CS = OFF_CP + 8192, OFF_SV = OFF_CS + 131072, OUT_TOTAL = OFF_SV + 262144;
constexpr size_t MiB = 1u << 20;
constexpr size_t WS_CTL = 0, CTL_ZERO_BYTES = 128 * 1024;
constexpr size_t WS_ROPE = 1 * MiB;
constexpr size_t WS_RSTD = WS_ROPE + 512 * 1024;
constexpr size_t WS_H = 2 * MiB;
constexpr size_t WS_ACT = 35 * MiB;
constexpr size_t WS_OUTF = 126 * MiB;
constexpr size_t WS_QKV = 192 * MiB;
constexpr size_t WS_O = 234 * MiB;
constexpr size_t WS_BG = 267 * MiB;
constexpr size_t WS_Z = 300 * MiB;
constexpr size_t WS_VLN = 333 * MiB;
constexpr size_t WS_WFFN = 368 * MiB;
constexpr size_t WFFN_STRIDE = 66 * MiB, WD_OFF = 44 * MiB;
constexpr size_t WS_WATT = WS_WFFN + 8 * WFFN_STRIDE;
constexpr size_t WATT_STRIDE = 18 * MiB, WO_OFF = 10 * MiB;
constexpr size_t WS_WCONV = WS_WATT + 2 * WATT_STRIDE;
constexpr size_t WCOUT_OFF = 24 * MiB;
constexpr size_t WS_WSGU = WS_WCONV + 32 * MiB;
constexpr size_t WSOUT_OFF = 16 * MiB;
constexpr size_t WS_PART = WS_WSGU + 24 * MiB;
constexpr size_t PART_SLAB = (size_t)MS * D;
constexpr int NSPLIT_FFN = 11, NSPLIT_MIX = 4;
constexpr size_t WS_XQ8 = WS_PART + 24 * MiB;
constexpr size_t WS_SW = WS_XQ8 + 17 * MiB;
constexpr size_t WS_RS8 = WS_SW + 512 * 1024;
constexpr size_t WS_END = WS_SW + 1 * MiB;
constexpr int CW_TICKET = 24576;
constexpr int CW_BAR = 4096;
constexpr int RING_BYTES = 133120  , LDSCTL_OFF = RING_BYTES, MISC_OFF = LDSCTL_OFF + 320, LDS_BYTES = 147456;

#define GAS __attribute__((address_space(1)))
#define LAS __attribute__((address_space(3)))
typedef unsigned short bf16;
typedef unsigned v4u __attribute__((ext_vector_type(4)));
typedef unsigned v2u __attribute__((ext_vector_type(2)));
typedef float f32x4 __attribute__((ext_vector_type(4)));
typedef float f32x16 __attribute__((ext_vector_type(16)));
typedef short bf16x8 __attribute__((ext_vector_type(8)));
typedef short s16x4 __attribute__((ext_vector_type(4)));
#define LDS_WAIT() asm volatile("s_waitcnt lgkmcnt(0)" ::: "memory")
typedef float f32x2_cv __attribute__((ext_vector_type(2))); typedef __bf16 bf16x2_cv __attribute__((ext_vector_type(2)));
__device__ __forceinline__ unsigned pk2(float lo, float hi) { const f32x2_cv v = {lo, hi}; const bf16x2_cv b = __builtin_convertvector(v, bf16x2_cv); return __builtin_bit_cast(unsigned, b); }
__device__ __forceinline__ unsigned f2bf(float f) { return pk2(f, f) & 0xffffu; }
__device__ __forceinline__ float bf2f(unsigned short h) { return __builtin_bit_cast(float, (unsigned)h << 16); }
__device__ __forceinline__ float bflo(unsigned w) { return __builtin_bit_cast(float, w << 16); }
__device__ __forceinline__ float bfhi(unsigned w) { return __builtin_bit_cast(float, w & 0xffff0000u); }
#define XB_TMO      128
#define XB_XCNT(j)  (256  + 64 * (j))
#define XB_XSUB(j)  (1280 + 64 * (j))
#define XB_XGEN(j)  (2304 + 64 * (j))
#define XB_TOP      3328
#define XB_TOPGEN   3392
#define XCD_BAR_WORDS 3456
#define XB_SPIN_CAP (1u << 18)

__device__ __forceinline__ unsigned xb_ld(unsigned* p)              { return __hip_atomic_load(p, __ATOMIC_RELAXED, __HIP_MEMORY_SCOPE_AGENT); }
__device__ __forceinline__ unsigned xb_add(unsigned* p, unsigned v) { return __hip_atomic_fetch_add(p, v, __ATOMIC_RELAXED, __HIP_MEMORY_SCOPE_AGENT); }
__device__ __forceinline__ unsigned xb_xcc_id() { return (unsigned)__builtin_amdgcn_s_getreg((3 << 11) | 20) & 0xFu; }
#define XB_SPIN(cond, bar) do { unsigned _sp = 0; while (cond) { __builtin_amdgcn_s_sleep(1); \
    if ((++_sp & 255u) == 0u) { if (xb_ld(&(bar)[XB_TMO])) break; if (_sp > XB_SPIN_CAP) { atomicAdd(&(bar)[XB_TMO], 1u); break; } } } } while (0)

struct XcdBarrier {
    unsigned* bar; unsigned x;
    volatile LAS unsigned* st;
};

__device__ __forceinline__ XcdBarrier xcd_barrier_post(unsigned* bar, volatile LAS unsigned* st) {
    XcdBarrier b; b.bar = bar; b.x = xb_xcc_id(); b.st = st;
    if (threadIdx.x == 0) (void)xb_add(&bar[XB_XCNT(b.x)], 1u);
    return b;
}
__device__ __forceinline__ void xcd_barrier_complete(unsigned* bar, unsigned x, unsigned& nloc, unsigned& nx) {
    const unsigned G = gridDim.x * gridDim.y * gridDim.z;
    unsigned sum, cnt, mine, sp = 0u;
    for (;;) {
        sum = 0u; cnt = 0u; mine = 0u;
#pragma unroll
        for (unsigned j = 0; j < 16; ++j) { const unsigned c = xb_ld(&bar[XB_XCNT(j)]); sum += c; cnt += (c > 0u) ? 1u : 0u; mine = (j == x) ? c : mine; }
        if (sum == G) break;
        __builtin_amdgcn_s_sleep(1);
        if ((++sp & 255u) == 0u) { if (xb_ld(&bar[XB_TMO])) break; if (sp > XB_SPIN_CAP) { atomicAdd(&bar[XB_TMO], 1u); break; } }
    }
    nloc = mine > 0u ? mine : 1u; nx = cnt > 0u ? cnt : 1u;
}

__device__ __forceinline__ void xcd_barrier(const XcdBarrier& b) {
    asm volatile("s_waitcnt vmcnt(0)" ::: "memory");
    __syncthreads();
    if (threadIdx.x == 0) {
        unsigned* bar = b.bar;
        __builtin_amdgcn_s_waitcnt(0);
        unsigned nloc = b.st[0], nx = b.st[1];
        if (nloc == 0u) { xcd_barrier_complete(bar, b.x, nloc, nx); b.st[0] = nloc; b.st[1] = nx; }
        const unsigned old = xb_add(&bar[XB_XSUB(b.x)], 1u);
        const unsigned gen = old / nloc;
#ifdef XB_EARLY_WB_AT
        if (old - gen * nloc == (unsigned)(XB_EARLY_WB_AT) * nloc / 32u && old + 1u != (gen + 1u) * nloc) {
            __builtin_amdgcn_fence(__ATOMIC_RELEASE, "agent");
            asm volatile("s_waitcnt vmcnt(0)" ::: "memory"); }
#endif
        if (old + 1u == (gen + 1u) * nloc) {
            __builtin_amdgcn_fence(__ATOMIC_RELEASE, "agent");
            asm volatile("s_waitcnt vmcnt(0)" ::: "memory");
            const unsigned og = xb_add(&bar[XB_TOP], 1u);
            const unsigned tg = og / nx;
            if (og + 1u == (tg + 1u) * nx) xb_add(&bar[XB_TOPGEN], 1u);
            else XB_SPIN(xb_ld(&bar[XB_TOPGEN]) == tg, bar);
            __builtin_amdgcn_fence(__ATOMIC_ACQUIRE, "agent");
            xb_add(&bar[XB_XGEN(b.x)], 1u);
            asm volatile("s_waitcnt vmcnt(0)" ::: "memory");
        } else {
            XB_SPIN(xb_ld(&bar[XB_XGEN(b.x)]) == gen, bar);
            __builtin_amdgcn_fence(__ATOMIC_ACQUIRE, "agent");
            asm volatile("s_waitcnt vmcnt(0)" ::: "memory");
        }
    }
    __syncthreads();
}

struct Frame {
    LAS unsigned char* lds;
    int tid, lane, wave, vcu, G;
    const float* in[20];
    float* out;
    unsigned char* ws;
};
#define IN_XP 0
#define IN_XS 1
#define IN_CK 2
#define IN_CV 3
#define IN_SC 4
#define IN_NG 5
#define IN_WGU 6
#define IN_WD 7
#define IN_WQKV 8
#define IN_WO 9
#define IN_SINK 10
#define IN_CWIN 11
#define IN_CW 12
#define IN_CWOUT 13
#define IN_SWIN 14
#define IN_SLNG 15
#define IN_SLNB 16
#define IN_SWS 17
#define IN_SBS 18
#define IN_SWOUT 19

template <int CTRL, int RM> __device__ __forceinline__ float dpp_or0(float v) { return __builtin_bit_cast(float, __builtin_amdgcn_update_dpp(0, __builtin_bit_cast(int, v), CTRL, RM, 0xF, true)); }
template <int CTRL, int RM> __device__ __forceinline__ float dpp_self(float v) { return __builtin_bit_cast(float, __builtin_amdgcn_update_dpp(__builtin_bit_cast(int, v), __builtin_bit_cast(int, v), CTRL, RM, 0xF, false)); }
__device__ __forceinline__ float wave_sum(float v) {
    v += dpp_or0<0xB1, 0xF>(v); v += dpp_or0<0x4E, 0xF>(v); v += dpp_or0<0x141, 0xF>(v); v += dpp_or0<0x140, 0xF>(v); v += dpp_or0<0x142, 0xA>(v); v += dpp_or0<0x143, 0xC>(v);
    return __builtin_bit_cast(float, __builtin_amdgcn_readlane(__builtin_bit_cast(int, v), 63));
}
__device__ __forceinline__ float wave_max(float v) {
    v = fmaxf(v, dpp_self<0xB1, 0xF>(v)); v = fmaxf(v, dpp_self<0x4E, 0xF>(v)); v = fmaxf(v, dpp_self<0x141, 0xF>(v)); v = fmaxf(v, dpp_self<0x140, 0xF>(v));
    v = fmaxf(v, dpp_self<0x142, 0xA>(v)); v = fmaxf(v, dpp_self<0x143, 0xC>(v));
    return __builtin_bit_cast(float, __builtin_amdgcn_readlane(__builtin_bit_cast(int, v), 63));
}

__device__ __forceinline__ int opq(int v) { asm volatile("" : "+v"(v)); return v; }
__device__ __forceinline__ int src_col_base(int kind, int db) {
    if (kind == 0) return db * 128;
    if (kind == 1) return (db & 1) * DFF + (db >> 1) * 128;
    if (db < 16) return db * 128;
    const int e = db - 16; return 2048 + (e & 1) * 2048 + (e >> 1) * 128;
}
constexpr int CVT_SCR = 64 * 65 * 4;
__device__ __forceinline__ void cvt_load(const float* W, int ldn, int nb0, int nbn, int kind, int item, int lane, f32x4 (&v)[16], const float* gfold) {
    const int kb = item / nbn, nb = nb0 + item % nbn, k0 = 64 * kb, n0 = 64 * nb;
    const int scol = src_col_base(kind, n0 >> 7) + (n0 & 127);
    const int r4 = lane >> 4, c16 = lane & 15;
#pragma unroll
    for (int i = 0; i < 16; ++i) v[i] = __builtin_nontemporal_load((const GAS f32x4*)(W + (size_t)(k0 + 4 * i + r4) * ldn + scol + c16 * 4));
    if (gfold) {
#pragma unroll
        for (int i = 0; i < 16; ++i) v[i] = v[i] * gfold[k0 + 4 * i + r4]; }
}
__device__ __forceinline__ void cvt_store(const f32x4 (&v)[16], int K, int nb0, int nbn, bf16* WT, LAS float* scr, int item, int lane) {
    const int kb = item / nbn, nb = nb0 + item % nbn, k0 = 64 * kb, n0 = 64 * nb;
    const int r4 = lane >> 4, c16 = lane & 15;
#pragma unroll
    for (int i = 0; i < 16; ++i) { LAS float* d = scr + (4 * i + r4) * 65 + c16 * 4; d[0] = v[i].x; d[1] = v[i].y; d[2] = v[i].z; d[3] = v[i].w; }
    LDS_WAIT(); asm volatile("" ::: "memory");
    const int rr = lane >> 3, c = lane & 7;
#pragma unroll
    for (int j = 0; j < 8; ++j) { const int n = rr + 8 * j; const LAS float* s = scr + (8 * c) * 65 + n;
        v4u o; o.x = pk2(s[0 * 65], s[1 * 65]); o.y = pk2(s[2 * 65], s[3 * 65]); o.z = pk2(s[4 * 65], s[5 * 65]); o.w = pk2(s[6 * 65], s[7 * 65]);
        *(GAS v4u*)(WT + (size_t)(n0 + n) * K + k0 + 8 * c) = o; }
    LDS_WAIT(); asm volatile("" ::: "memory");
}
__device__ __forceinline__ void convert_matrix(Frame& F, const float* W, int ldn, int K, int Nd, int kind, bf16* WT, int& off, int wg0, int nwg, int p0, int p1, const float* gfold) {
    const int tid = opq(F.tid), lane = tid & 63;
    LAS float* scr = (LAS float*)(F.lds + F.wave * CVT_SCR);
    const int gw = ((int)blockIdx.x - wg0) * NWAVES + F.wave, NGW = nwg * NWAVES;
    const int nblk = Nd / 64, nb0 = nblk * p0 / 2, nbn = nblk * p1 / 2 - nb0;
    const int items = (K / 64) * nbn;
    int first = gw - off; if (first < 0) first += NGW;
    off = (off + items) % NGW;
    if (first >= items) return;
    f32x4 va[16], vb[16];
    cvt_load(W, ldn, nb0, nbn, kind, first, lane, va, gfold);
    for (int it = first; it < items; it += 2 * NGW) {
        if (it + NGW < items) cvt_load(W, ldn, nb0, nbn, kind, it + NGW, lane, vb, gfold);
        cvt_store(va, K, nb0, nbn, WT, scr, it, lane);
#ifdef CVT_SLEEP
        if (wg0 != 0) __builtin_amdgcn_s_sleep(CVT_SLEEP);
#endif
        if (it + NGW >= items) break;
        if (it + 2 * NGW < items) cvt_load(W, ldn, nb0, nbn, kind, it + 2 * NGW, lane, va, gfold);
        cvt_store(vb, K, nb0, nbn, WT, scr, it + NGW, lane);
#ifdef CVT_SLEEP
        if (wg0 != 0) __builtin_amdgcn_s_sleep(CVT_SLEEP);
#endif
    }
}
constexpr int CVT_RED_OFF = 135168;
constexpr int T2_PITCH = 4104;
__device__ __forceinline__ void convert_wgu_i8(Frame& F, int gi) {
    const int tid = opq(F.tid), lane = tid & 63;
    LAS unsigned char* T2 = F.lds; LAS float* red = (LAS float*)(F.lds + CVT_RED_OFF);
    const int r8 = lane >> 3, c8 = lane & 7;
    {
        const int lh = gi / 352, it = gi % 352;
        const float* W = F.in[IN_WGU] + (size_t)lh * D * NGU; const float* g = F.in[IN_NG] + (size_t)((lh >> 1) * 6 + 4 * (lh & 1)) * D;
        unsigned char* W8 = F.ws + WS_WFFN + (size_t)lh * WFFN_STRIDE; float* SW = (float*)(F.ws + WS_SW) + (size_t)lh * NGU;
        const int n0 = 32 * it, scol = src_col_base(1, n0 >> 7) + (n0 & 127);
        const float* Wc = W + scol + c8 * 4;
        f32x4 mx = (f32x4){0.f, 0.f, 0.f, 0.f};
#pragma unroll 1
        for (int b = 0; b < 4; ++b) {
            f32x4 v[8];
#pragma unroll
            for (int i = 0; i < 8; ++i) v[i] = __builtin_nontemporal_load((const GAS f32x4*)(Wc + (size_t)(F.wave * 256 + (b * 8 + i) * 8 + r8) * NGU));
#pragma unroll
            for (int i = 0; i < 8; ++i) { const int k = F.wave * 256 + (b * 8 + i) * 8 + r8; const float gg = g[k]; const f32x4 t = v[i] * gg;
                mx.x = fmaxf(mx.x, fabsf(t.x)); mx.y = fmaxf(mx.y, fabsf(t.y)); mx.z = fmaxf(mx.z, fabsf(t.z)); mx.w = fmaxf(mx.w, fabsf(t.w));
                LAS unsigned char* d = T2 + (c8 * 4) * T2_PITCH + k * 2;
                *(LAS unsigned short*)(d) = (unsigned short)f2bf(t.x); *(LAS unsigned short*)(d + T2_PITCH) = (unsigned short)f2bf(t.y);
                *(LAS unsigned short*)(d + 2 * T2_PITCH) = (unsigned short)f2bf(t.z); *(LAS unsigned short*)(d + 3 * T2_PITCH) = (unsigned short)f2bf(t.w); }
        }
#pragma unroll
        for (int o = 8; o < 64; o <<= 1) { mx.x = fmaxf(mx.x, __shfl_xor(mx.x, o)); mx.y = fmaxf(mx.y, __shfl_xor(mx.y, o)); mx.z = fmaxf(mx.z, __shfl_xor(mx.z, o)); mx.w = fmaxf(mx.w, __shfl_xor(mx.w, o)); }
        if (r8 == 0) *(LAS f32x4*)(red + F.wave * 32 + c8 * 4) = mx;
        __syncthreads();
#pragma unroll
        for (int q = 0; q < 4; ++q) { const int n = F.wave * 4 + q;
            float m = red[n];
#pragma unroll
            for (int w = 1; w < 8; ++w) m = fmaxf(m, red[w * 32 + n]);
            m = fmaxf(m, 1e-30f);
            if (lane == 0) SW[n0 + n] = m * (1.0f / 127.0f);
            const float inv = 127.0f / m;
#pragma unroll
            for (int j = 0; j < 4; ++j) { const int kc = (lane + 64 * j) * 8;
                const v2u lo = *(const LAS v2u*)(T2 + n * T2_PITCH + kc * 2), hi = *(const LAS v2u*)(T2 + n * T2_PITCH + kc * 2 + 8);
                const unsigned b0 = (unsigned)(int)__builtin_rintf(bflo(lo.x) * inv) & 0xffu, b1 = (unsigned)(int)__builtin_rintf(bfhi(lo.x) * inv) & 0xffu;
                const unsigned b2 = (unsigned)(int)__builtin_rintf(bflo(lo.y) * inv) & 0xffu, b3 = (unsigned)(int)__builtin_rintf(bfhi(lo.y) * inv) & 0xffu;
                const unsigned b4 = (unsigned)(int)__builtin_rintf(bflo(hi.x) * inv) & 0xffu, b5 = (unsigned)(int)__builtin_rintf(bfhi(hi.x) * inv) & 0xffu;
                const unsigned b6 = (unsigned)(int)__builtin_rintf(bflo(hi.y) * inv) & 0xffu, b7 = (unsigned)(int)__builtin_rintf(bfhi(hi.y) * inv) & 0xffu;
                v2u w; w.x = b0 | (b1 << 8) | (b2 << 16) | (b3 << 24); w.y = b4 | (b5 << 8) | (b6 << 16) | (b7 << 24);
                *(GAS v2u*)(W8 + (size_t)(n0 + n) * D + kc) = w; } }
        __syncthreads();
    }
}
constexpr int CVT_NI8 = 8 * 352, CVT_NCH = (8 * 2816 + 2 * (1280 + 1024) + (3072 + 1024) + (2048 + 1024)) / 16;
__device__ __forceinline__ void convert_bf_chunk(Frame& F, int c) {
    const int tid = opq(F.tid), lane = tid & 63;
    int it = c * 16;
    const float* W = nullptr; int ldn = 0, K = 0, Nd = 0, kind = 0; bf16* WT = nullptr; const float* gf = nullptr; bool found = false;
#pragma unroll 1
    for (int sl = 0; sl < 12 && !found; ++sl) {
        const int layer = sl / 3, pos = sl % 3;
        if (pos != 1) {
            if (it < 2816) { const int lh = layer * 2 + (pos >> 1);
                W = F.in[IN_WD] + (size_t)lh * DFF * D; ldn = D; K = DFF; Nd = D; kind = 0; WT = (bf16*)(F.ws + WS_WFFN + (size_t)lh * WFFN_STRIDE + WD_OFF); gf = nullptr; found = true; }
            else it -= 2816;
        } else {
            const int mk = layer % 3, j = layer / 3; const float* gm = F.in[IN_NG] + (size_t)(layer * 6 + 2) * D;
            const int n1 = (mk == 0) ? 1280 : (mk == 1 ? 3072 : 2048);
            if (it < n1) { found = true; gf = gm; K = D;
                if (mk == 0) { W = F.in[IN_WQKV] + (size_t)j * D * NQKV; ldn = NQKV; Nd = NQKV; kind = 0; WT = (bf16*)(F.ws + WS_WATT + (size_t)j * WATT_STRIDE); }
                else if (mk == 1) { W = F.in[IN_CWIN]; ldn = NCIN; Nd = NCIN; kind = 2; WT = (bf16*)(F.ws + WS_WCONV); }
                else { W = F.in[IN_SWIN]; ldn = NSIN; Nd = NSIN; kind = 0; WT = (bf16*)(F.ws + WS_WSGU); } }
            else { it -= n1;
                if (it < 1024) { found = true; gf = nullptr; K = D; ldn = D; Nd = D; kind = 0;
                    if (mk == 0) { W = F.in[IN_WO] + (size_t)j * D * D; WT = (bf16*)(F.ws + WS_WATT + (size_t)j * WATT_STRIDE + WO_OFF); }
                    else if (mk == 1) { W = F.in[IN_CWOUT]; WT = (bf16*)(F.ws + WS_WCONV + WCOUT_OFF); }
                    else { W = F.in[IN_SWOUT]; WT = (bf16*)(F.ws + WS_WSGU + WSOUT_OFF); } }
                else it -= 1024; }
        }
    }
    if (!found) return;
    LAS float* scr = (LAS float*)(F.lds + F.wave * CVT_SCR);
    const int nblk = Nd / 64, i0 = it + 2 * F.wave;
    f32x4 va[16], vb[16];
    cvt_load(W, ldn, 0, nblk, kind, i0, lane, va, gf);
    cvt_load(W, ldn, 0, nblk, kind, i0 + 1, lane, vb, gf);
    cvt_store(va, K, 0, nblk, WT, scr, i0, lane);
    cvt_store(vb, K, 0, nblk, WT, scr, i0 + 1, lane);
}
__device__ __forceinline__ void prologue_tables(Frame& F) {
    const int tid = opq(F.tid), lane = tid & 63; (void)lane;
    {
        const double inv_d[8] = {1.0, 0.19392274474868576, 0.03760603093086393, 0.007292664737217109, 0.001414213562373095, 0.0002742481756762073, 5.318295896944988e-05, 1.031338537721246e-05};
        float* rc = (float*)(F.ws + WS_ROPE); float* rs = rc + 4100 * 8;
        for (int idx = blockIdx.x * 512 + tid; idx < 4100 * 8; idx += F.G * 512) {
            const int slot = idx >> 3, i = idx & 7;
            const float pos = (float)(slot < 4096 ? slot : 16384 + (slot - 4096));
            float inv = 1.0f;
#pragma unroll
            for (int k = 0; k < 8; ++k) if (i == k) inv = (float)inv_d[k];
            const float ang = pos * inv;
            double t = (double)ang * 0.15915494309189535; t -= __builtin_rint(t);
            const float fr = (float)t;
            rc[idx] = __builtin_amdgcn_cosf(fr); rs[idx] = __builtin_amdgcn_sinf(fr);
        }
    }
    {
        const int n16 = (M - MR) * D * 2 / 16;
        GAS v4u* h = (GAS v4u*)(F.ws + WS_H + (size_t)MR * D * 2); GAS v4u* o = (GAS v4u*)(F.ws + WS_O + (size_t)MR * D * 2);
        for (int i = blockIdx.x * 512 + tid; i < n16; i += F.G * 512) { h[i] = (v4u){0u, 0u, 0u, 0u}; o[i] = (v4u){0u, 0u, 0u, 0u}; }
    }
}

__device__ __forceinline__ void unpack8(const v4u v, float (&f)[8]) { f[0] = bflo(v.x); f[1] = bfhi(v.x); f[2] = bflo(v.y); f[3] = bfhi(v.y); f[4] = bflo(v.z); f[5] = bfhi(v.z); f[6] = bflo(v.w); f[7] = bfhi(v.w); }
__device__ __forceinline__ void ld8f(const float* p, float (&f)[8]) { const f32x4 a = *(const GAS f32x4*)p, b = *(const GAS f32x4*)(p + 4); f[0] = a.x; f[1] = a.y; f[2] = a.z; f[3] = a.w; f[4] = b.x; f[5] = b.y; f[6] = b.z; f[7] = b.w; }
__device__ __forceinline__ void norm_finish_row(Frame& F, float (&x)[4][8], int m, int lane, bool last, bool want_q8) {
    if (last) {
#pragma unroll
        for (int j = 0; j < 4; ++j) { float* dst = F.out + (size_t)m * D + (lane + 64 * j) * 8;
            *(GAS f32x4*)dst = (f32x4){x[j][0], x[j][1], x[j][2], x[j][3]}; *(GAS f32x4*)(dst + 4) = (f32x4){x[j][4], x[j][5], x[j][6], x[j][7]}; }
    } else {
        bf16* X = (bf16*)(F.ws + WS_H); float ss = 0.f;
#pragma unroll
        for (int j = 0; j < 4; ++j) { v4u w; w.x = pk2(x[j][0], x[j][1]); w.y = pk2(x[j][2], x[j][3]); w.z = pk2(x[j][4], x[j][5]); w.w = pk2(x[j][6], x[j][7]);
            *(GAS v4u*)(X + (size_t)m * D + (lane + 64 * j) * 8) = w;
            float r[8]; unpack8(w, r);
#pragma unroll
            for (int e = 0; e < 8; ++e) ss += r[e] * r[e]; }
        const float rsx = 1.0f / sqrtf(wave_sum(ss) * (1.0f / D) + RMS_EPS);
        if (lane == 0) ((float*)(F.ws + WS_RSTD))[m] = rsx;
        if (want_q8) {
            float mx = 0.f;
#pragma unroll
            for (int j = 0; j < 4; ++j)
#pragma unroll
                for (int e = 0; e < 8; ++e) mx = fmaxf(mx, fabsf(x[j][e]));
            mx = fmaxf(wave_max(mx), 1e-30f);
            const float inv = 127.0f / mx;
            unsigned char* XQ = F.ws + WS_XQ8;
#pragma unroll
            for (int j = 0; j < 4; ++j) { unsigned b[8];
#pragma unroll
                for (int e = 0; e < 8; ++e) b[e] = (unsigned)(int)__builtin_rintf(x[j][e] * inv) & 0xffu;
                v2u w; w.x = b[0] | (b[1] << 8) | (b[2] << 16) | (b[3] << 24); w.y = b[4] | (b[5] << 8) | (b[6] << 16) | (b[7] << 24);
                *(GAS v2u*)(XQ + (size_t)m * D + (lane + 64 * j) * 8) = w; }
            if (lane == 0) ((float*)(F.ws + WS_RS8))[m] = rsx * (mx * (1.0f / 127.0f));
        }
    }
}
__device__ __forceinline__ void norm_first_rows(Frame& F, int chunk) {
    const int tid = opq(F.tid), lane = tid & 63;
    const int m = chunk * NWAVES + F.wave;
    if (m < MR) {
        const float* src = m < MP ? F.in[IN_XP] + (size_t)m * D : F.in[IN_XS] + (size_t)(m - MP) * D;
        float x[4][8];
#pragma unroll
        for (int j = 0; j < 4; ++j) ld8f(src + (lane + 64 * j) * 8, x[j]);
        norm_finish_row(F, x, m, lane, false, true);
    }
}
constexpr int CVT_NNR = (MR + NWAVES - 1) / NWAVES;
__device__ __forceinline__ void prologue_phase(Frame& F) {
    const int tid = opq(F.tid), lane = tid & 63; (void)lane;
    prologue_tables(F);
    unsigned* tk = (unsigned*)(F.ws + WS_CTL) + CW_TICKET;
    volatile LAS unsigned* tl = (volatile LAS unsigned*)(F.lds + MISC_OFF) + 12;
    if (tid == 0) tl[0] = __hip_atomic_fetch_add(tk, 1u, __ATOMIC_RELAXED, __HIP_MEMORY_SCOPE_AGENT);
    __syncthreads();
    int t = (int)tl[0];
    while (t < CVT_NI8 + CVT_NCH + CVT_NNR) {
        unsigned tn = 0u; if (tid == 0) tn = __hip_atomic_fetch_add(tk, 1u, __ATOMIC_RELAXED, __HIP_MEMORY_SCOPE_AGENT);
        __syncthreads();
        if (t < CVT_NI8) convert_wgu_i8(F, t); else if (t < CVT_NI8 + CVT_NCH) convert_bf_chunk(F, t - CVT_NI8); else norm_first_rows(F, t - CVT_NI8 - CVT_NCH);
        if (tid == 0) tl[0] = tn;
        __syncthreads();
        t = (int)tl[0];
    }
    __syncthreads();
}
__device__ __forceinline__ void norm_phase(Frame& F, float alpha, const float* g_post, bool last, int nsplit, bool want_q8, bool with_sample) {
    const int tid = opq(F.tid), lane = tid & 63;
    const int gw = F.vcu * NWAVES + F.wave, NGW = F.G * NWAVES;
    const bf16* X = (const bf16*)(F.ws + WS_H); const bf16* OUTB = (const bf16*)(F.ws + WS_OUTF);
    float gp[4][8];
#pragma unroll
    for (int j = 0; j < 4; ++j) ld8f(g_post + (lane + 64 * j) * 8, gp[j]);
    v4u ro[4], rx[4];
#pragma unroll
    for (int j = 0; j < 4; ++j) { ro[j] = (v4u){0u, 0u, 0u, 0u}; rx[j] = ro[j];
        if (gw < MP) { ro[j] = *(const GAS v4u*)(OUTB + (size_t)gw * D + (lane + 64 * j) * 8); rx[j] = *(const GAS v4u*)(X + (size_t)gw * D + (lane + 64 * j) * 8); } }
    for (int m = gw; m < MP; m += NGW) {
        float x[4][8], xo[4][8]; float ss = 0.f;
#pragma unroll
        for (int j = 0; j < 4; ++j) { unpack8(ro[j], x[j]); unpack8(rx[j], xo[j]);
#pragma unroll
            for (int e = 0; e < 8; ++e) ss += x[j][e] * x[j][e]; }
        if (m + NGW < MP) {
#pragma unroll
            for (int j = 0; j < 4; ++j) { ro[j] = *(const GAS v4u*)(OUTB + (size_t)(m + NGW) * D + (lane + 64 * j) * 8); rx[j] = *(const GAS v4u*)(X + (size_t)(m + NGW) * D + (lane + 64 * j) * 8); } }
        const float rs = alpha / sqrtf(wave_sum(ss) * (1.0f / D) + RMS_EPS);
#pragma unroll
        for (int j = 0; j < 4; ++j)
#pragma unroll
            for (int e = 0; e < 8; ++e) x[j][e] = xo[j][e] + (x[j][e] * rs) * gp[j][e];
        norm_finish_row(F, x, m, lane, last, want_q8);
    }
    for (int r_ = F.wave * F.G + (int)blockIdx.x; with_sample && r_ < MS; r_ += F.G * NWAVES) { const int m = MP + r_;
        const float* pr = (const float*)(F.ws + WS_PART) + (size_t)(m - MP) * D;
        float x[4][8]; float ss = 0.f;
#pragma unroll
        for (int j = 0; j < 4; ++j) ld8f(pr + (lane + 64 * j) * 8, x[j]);
#pragma unroll 2
        for (int s = 1; s < nsplit; ++s) {
            float t[4][8];
#pragma unroll
            for (int j = 0; j < 4; ++j) ld8f(pr + (size_t)s * PART_SLAB + (lane + 64 * j) * 8, t[j]);
#pragma unroll
            for (int j = 0; j < 4; ++j)
#pragma unroll
                for (int e = 0; e < 8; ++e) x[j][e] += t[j][e]; }
#pragma unroll
        for (int j = 0; j < 4; ++j)
#pragma unroll
            for (int e = 0; e < 8; ++e) ss += x[j][e] * x[j][e];
        const float rs = alpha / sqrtf(wave_sum(ss) * (1.0f / D) + RMS_EPS);
#pragma unroll
        for (int j = 0; j < 4; ++j) { float xo[8]; unpack8(*(const GAS v4u*)(X + (size_t)m * D + (lane + 64 * j) * 8), xo);
#pragma unroll
            for (int e = 0; e < 8; ++e) x[j][e] = xo[e] + (x[j][e] * rs) * gp[j][e]; }
        norm_finish_row(F, x, m, lane, last, want_q8);
    }
}

constexpr int CW_SFLAG = 16384;
__device__ __forceinline__ void st8_wt(void* p, unsigned lo, unsigned hi) { __hip_atomic_store((unsigned long long*)p, ((unsigned long long)hi << 32) | lo, __ATOMIC_RELAXED, __HIP_MEMORY_SCOPE_AGENT); }
__device__ __forceinline__ void sample_tail_norm(Frame& F, float alpha, const float* g_post, int nsplit, bool want_q8, unsigned* flag1, unsigned need1, unsigned* flag2) {
    if ((int)blockIdx.x < F.G - 16) return;
    const int tid = opq(F.tid), lane = tid & 63;
    const int m = MP + ((int)blockIdx.x - (F.G - 16)) * NWAVES + F.wave;
    { unsigned spins = 0;
      while ((unsigned)__builtin_amdgcn_readfirstlane(__hip_atomic_load(flag1, __ATOMIC_RELAXED, __HIP_MEMORY_SCOPE_AGENT)) < need1) { __builtin_amdgcn_s_sleep(2); if (++spins > (1u << 22)) break; }
      __builtin_amdgcn_fence(__ATOMIC_ACQUIRE, "agent"); asm volatile("s_waitcnt vmcnt(0)" ::: "memory"); }
    bf16* X = (bf16*)(F.ws + WS_H);
    const float* pr = (const float*)(F.ws + WS_PART) + (size_t)(m - MP) * D;
    float x[4][8]; float ss = 0.f;
#pragma unroll
    for (int j = 0; j < 4; ++j) ld8f(pr + (lane + 64 * j) * 8, x[j]);
#pragma unroll 2
    for (int s = 1; s < nsplit; ++s) {
        float t[4][8];
#pragma unroll
        for (int j = 0; j < 4; ++j) ld8f(pr + (size_t)s * PART_SLAB + (lane + 64 * j) * 8, t[j]);
#pragma unroll
        for (int j = 0; j < 4; ++j)
#pragma unroll
            for (int e = 0; e < 8; ++e) x[j][e] += t[j][e]; }
#pragma unroll
    for (int j = 0; j < 4; ++j)
#pragma unroll
        for (int e = 0; e < 8; ++e) ss += x[j][e] * x[j][e];
    const float rs = alpha / sqrtf(wave_sum(ss) * (1.0f / D) + RMS_EPS);
#pragma unroll
    for (int j = 0; j < 4; ++j) { float xo[8], gp[8]; unpack8(*(const GAS v4u*)(X + (size_t)m * D + (lane + 64 * j) * 8), xo); ld8f(g_post + (lane + 64 * j) * 8, gp);
#pragma unroll
        for (int e = 0; e < 8; ++e) x[j][e] = xo[e] + (x[j][e] * rs) * gp[e]; }
    float sx = 0.f;
#pragma unroll
    for (int j = 0; j < 4; ++j) { v4u w; w.x = pk2(x[j][0], x[j][1]); w.y = pk2(x[j][2], x[j][3]); w.z = pk2(x[j][4], x[j][5]); w.w = pk2(x[j][6], x[j][7]);
        bf16* dst = X + (size_t)m * D + (lane + 64 * j) * 8; st8_wt(dst, w.x, w.y); st8_wt(dst + 4, w.z, w.w);
        float r[8]; unpack8(w, r);
#pragma unroll
        for (int e = 0; e < 8; ++e) sx += r[e] * r[e]; }
    const float rsx = 1.0f / sqrtf(wave_sum(sx) * (1.0f / D) + RMS_EPS);
    if (lane == 0) __hip_atomic_store((unsigned*)(F.ws + WS_RSTD) + m, __float_as_uint(rsx), __ATOMIC_RELAXED, __HIP_MEMORY_SCOPE_AGENT);
    if (want_q8) {
        float mx = 0.f;
#pragma unroll
        for (int j = 0; j < 4; ++j)
#pragma unroll
            for (int e = 0; e < 8; ++e) mx = fmaxf(mx, fabsf(x[j][e]));
        mx = fmaxf(wave_max(mx), 1e-30f);
        const float inv = 127.0f / mx;
        unsigned char* XQ = F.ws + WS_XQ8;
#pragma unroll
        for (int j = 0; j < 4; ++j) {
            const unsigned b0 = (unsigned)(int)__builtin_rintf(x[j][0] * inv) & 0xffu, b1 = (unsigned)(int)__builtin_rintf(x[j][1] * inv) & 0xffu, b2 = (unsigned)(int)__builtin_rintf(x[j][2] * inv) & 0xffu, b3 = (unsigned)(int)__builtin_rintf(x[j][3] * inv) & 0xffu;
            const unsigned b4 = (unsigned)(int)__builtin_rintf(x[j][4] * inv) & 0xffu, b5 = (unsigned)(int)__builtin_rintf(x[j][5] * inv) & 0xffu, b6 = (unsigned)(int)__builtin_rintf(x[j][6] * inv) & 0xffu, b7 = (unsigned)(int)__builtin_rintf(x[j][7] * inv) & 0xffu;
            st8_wt(XQ + (size_t)m * D + (lane + 64 * j) * 8, b0 | (b1 << 8) | (b2 << 16) | (b3 << 24), b4 | (b5 << 8) | (b6 << 16) | (b7 << 24)); }
        if (lane == 0) __hip_atomic_store((unsigned*)(F.ws + WS_RS8) + m, __float_as_uint(rsx * (mx * (1.0f / 127.0f))), __ATOMIC_RELAXED, __HIP_MEMORY_SCOPE_AGENT);
    }
    asm volatile("s_waitcnt vmcnt(0)" ::: "memory");
    if (lane == 0) __hip_atomic_fetch_add(flag2, 1u, __ATOMIC_RELAXED, __HIP_MEMORY_SCOPE_AGENT);
}

constexpr int KSTR = 144, VSTR = 528, ATT_K = 0, ATT_V = 256 * KSTR;
__device__ __forceinline__ int crow(int r, int hi) { return (r & 3) + 8 * (r >> 2) + 4 * hi; }
__device__ __forceinline__ void attn_qtile(const LAS unsigned char* Ks, const LAS unsigned char* Vt, LAS float* iscr, const bf16x8 (&qf)[4], int kt0, int qrel, int jmin, float sink2, f32x16 (&o)[2], int lane) {
    const int r32 = lane & 31, hi = lane >> 5;
    f32x16 s[5];
#pragma unroll
    for (int t = 0; t < 5; ++t) {
        s[t] = (f32x16){0.f, 0.f, 0.f, 0.f, 0.f, 0.f, 0.f, 0.f, 0.f, 0.f, 0.f, 0.f, 0.f, 0.f, 0.f, 0.f};
        const LAS unsigned char* kp = Ks + ((kt0 + t) * 32 + r32) * KSTR + hi * 16;
#pragma unroll
        for (int st = 0; st < 4; ++st) { const bf16x8 kf = *(const LAS bf16x8*)(kp + st * 32); s[t] = __builtin_amdgcn_mfma_f32_32x32x16_bf16(kf, qf[st], s[t], 0, 0, 0); }
    }
    const float sc = 0.125f * LOG2E;
    const int qa = qrel - 4 * hi;
    float mraw = -1e30f; float tb[5];
#pragma unroll
    for (int t = 0; t < 5; ++t) {
        const bool ok = (kt0 + t) * 32 >= jmin;
        tb[t] = ok ? 0.f : -1e30f;
        float mt = -1e30f;
#pragma unroll
        for (int r = 0; r < 16; ++r) { const int cr = (r & 3) + 8 * (r >> 2);
            float v = s[t][r];
            if (t == 0) v = (cr >= qa) ? v : -1e30f;
            if (t == 4) v = (cr <= qa) ? v : -1e30f;
            s[t][r] = v; mt = fmaxf(mt, v); }
        mraw = fmaxf(mraw, ok ? mt : -1e30f); }
    mraw = fmaxf(mraw, __shfl_xor(mraw, 32));
    const float mx = fmaxf(sink2, mraw * sc);
    float l = 0.f;
#pragma unroll
    for (int t = 0; t < 5; ++t) { const float bt = tb[t] - mx;
#pragma unroll
        for (int r = 0; r < 16; ++r) { const float e = __builtin_amdgcn_exp2f(__builtin_fmaf(s[t][r], sc, bt)); s[t][r] = e; l += e; } }
    l += __shfl_xor(l, 32);
    const float inv = 1.0f / (l + __builtin_amdgcn_exp2f(sink2 - mx));
    if (hi == 0) iscr[r32] = inv;
    o[0] = (f32x16){0.f, 0.f, 0.f, 0.f, 0.f, 0.f, 0.f, 0.f, 0.f, 0.f, 0.f, 0.f, 0.f, 0.f, 0.f, 0.f}; o[1] = o[0];
#pragma unroll
    for (int t = 0; t < 5; ++t)
#pragma unroll
        for (int hf = 0; hf < 2; ++hf) {
            v4u pw; pw.x = pk2(s[t][8 * hf + 0], s[t][8 * hf + 1]); pw.y = pk2(s[t][8 * hf + 2], s[t][8 * hf + 3]);
            pw.z = pk2(s[t][8 * hf + 4], s[t][8 * hf + 5]); pw.w = pk2(s[t][8 * hf + 6], s[t][8 * hf + 7]);
            const bf16x8 pa = __builtin_bit_cast(bf16x8, pw);
#pragma unroll
            for (int dt = 0; dt < 2; ++dt) {
                const LAS unsigned char* vp = Vt + (dt * 32 + r32) * VSTR + ((kt0 + t) * 32 + 16 * hf + 4 * hi) * 2;
                const s16x4 lo = *(const LAS s16x4*)vp, hh = *(const LAS s16x4*)(vp + 16);
                const bf16x8 vb = (bf16x8){lo[0], lo[1], lo[2], lo[3], hh[0], hh[1], hh[2], hh[3]};
                o[dt] = __builtin_amdgcn_mfma_f32_32x32x16_bf16(pa, vb, o[dt], 0, 0, 0);
            }
        }
#pragma unroll
    for (int k = 0; k < 4; ++k) { const f32x4 iv = *(const LAS f32x4*)(iscr + 8 * k + 4 * hi);
#pragma unroll
        for (int e = 0; e < 4; ++e) { o[0][4 * k + e] *= iv[e]; o[1][4 * k + e] *= iv[e]; } }
}
constexpr int ATT_K2 = ATT_V + 64 * VSTR, ATT_V2 = ATT_K2 + 160 * KSTR, ATT_ISCR = ATT_V2 + 64 * VSTR;
__device__ __forceinline__ void attn_unit(Frame& F, int u, int su, int cu, int ja) {
    const int tid = opq(F.tid), lane = tid & 63; (void)lane;
    const int kvh = u & 3, blk = (u >> 2) & 31, b = u >> 7;
    LAS unsigned char* Ks = F.lds + ATT_K; LAS unsigned char* Vt = F.lds + ATT_V; LAS unsigned char* Ks2 = F.lds + ATT_K2; LAS unsigned char* Vt2 = F.lds + ATT_V2;
    const bf16* qkv = (const bf16*)(F.ws + WS_QKV);
    bf16* O = (bf16*)(F.ws + WS_O);
    const int tok0 = blk * 128 - 128;
    const size_t rowb = (size_t)b * SEQ;
    const int h = kvh * 8 + F.wave, r32 = lane & 31, hi = lane >> 5;
    LAS float* iscr = (LAS float*)(F.lds + ATT_ISCR) + F.wave * 32;
    v4u kq[4], vq[4]; bf16x8 qf[4];
#pragma unroll
    for (int i = 0; i < 4; ++i) { const int c = tid + 512 * i, key = c >> 3, part = c & 7, t = tok0 + key;
        kq[i] = (v4u){0u, 0u, 0u, 0u}; if (t >= 0) kq[i] = *(const GAS v4u*)(qkv + (rowb + t) * NQKV + 2048 + kvh * 64 + part * 8); }
#pragma unroll
    for (int kg = 0; kg < 4; ++kg) { const int key = kg * 64 + lane, t = tok0 + key;
        vq[kg] = (v4u){0u, 0u, 0u, 0u}; if (t >= 0) vq[kg] = *(const GAS v4u*)(qkv + (rowb + t) * NQKV + 2304 + kvh * 64 + F.wave * 8); }
#pragma unroll
    for (int st = 0; st < 4; ++st) qf[st] = *(const GAS bf16x8*)(qkv + (rowb + blk * 128 + r32) * NQKV + h * 64 + st * 16 + hi * 8);
    const int skv = su & 3, sb = su >> 2;
    const float* ck = F.in[IN_CK] + (size_t)(ja * 32 + sb) * 128 * 256 + skv * 64;
    const float* cv = F.in[IN_CV] + (size_t)(ja * 32 + sb) * 128 * 256 + skv * 64;
    const size_t srow = (size_t)MP + sb * 4;
    f32x4 sk[4], sv[4]; v4u nk = (v4u){0u, 0u, 0u, 0u}; unsigned short nv[4] = {0, 0, 0, 0};
    if (su >= 0) {
#pragma unroll
        for (int i = 0; i < 4; ++i) { const int c = tid + 512 * i, key = c >> 4, part = c & 15; sk[i] = *(const GAS f32x4*)(ck + (size_t)key * 256 + part * 4); }
        if (tid < 256) { const int key = 128 + (tid >> 3), part = tid & 7; if (key < 132) nk = *(const GAS v4u*)(qkv + (srow + key - 128) * NQKV + 2048 + skv * 64 + part * 8); }
#pragma unroll
        for (int it = 0; it < 4; ++it) { const int dc = F.wave * 2 + (it >> 1), key = (it & 1) * 64 + lane; sv[it] = *(const GAS f32x4*)(cv + (size_t)key * 256 + dc * 4); }
        { const int d = tid & 63, jj0 = tid >> 6;
#pragma unroll
          for (int it = 0; it < 4; ++it) { const int jj = jj0 + 8 * it; if (jj < 4) nv[it] = qkv[(srow + jj) * NQKV + 2304 + skv * 64 + d]; } }
    }
#pragma unroll
    for (int i = 0; i < 4; ++i) { const int c = tid + 512 * i, key = c >> 3, part = c & 7; *(LAS v4u*)(Ks + key * KSTR + part * 16) = kq[i]; }
#pragma unroll
    for (int kg = 0; kg < 4; ++kg) { const int key = kg * 64 + lane;
#pragma unroll
        for (int e = 0; e < 8; ++e) { const unsigned w = vq[kg][e >> 1]; *(LAS unsigned short*)(Vt + (F.wave * 8 + e) * VSTR + key * 2) = (unsigned short)((e & 1) ? (w >> 16) : (w & 0xffffu)); } }
    if (su >= 0) {
#pragma unroll
        for (int i = 0; i < 4; ++i) { const int c = tid + 512 * i, key = c >> 4, part = c & 15;
            v2u w; w.x = pk2(sk[i].x, sk[i].y); w.y = pk2(sk[i].z, sk[i].w); *(LAS v2u*)(Ks2 + key * KSTR + part * 8) = w; }
        if (tid < 256) { const int key = 128 + (tid >> 3), part = tid & 7; *(LAS v4u*)(Ks2 + key * KSTR + part * 16) = nk; }
#pragma unroll
        for (int it = 0; it < 4; ++it) { const int dc = F.wave * 2 + (it >> 1), key = (it & 1) * 64 + lane;
#pragma unroll
            for (int e = 0; e < 4; ++e) *(LAS unsigned short*)(Vt2 + (dc * 4 + e) * VSTR + key * 2) = (unsigned short)f2bf(sv[it][e]); }
        { const int d = tid & 63, jj0 = tid >> 6;
#pragma unroll
          for (int it = 0; it < 4; ++it) { const int jj = jj0 + 8 * it, j = 128 + jj; *(LAS unsigned short*)(Vt2 + d * VSTR + j * 2) = nv[it]; } }
    }
    if (blk == 31) {
#pragma unroll
        for (int i = 0; i < 4; ++i) { const int c = tid + 512 * i, which = c >> 10, cc = c & 1023, jj = cc >> 3, part = cc & 7;
            const v4u v = *(const GAS v4u*)(qkv + (rowb + 3968 + jj) * NQKV + 2048 + which * 256 + kvh * 64 + part * 8);
            float* dst = F.out + (which ? OFF_VP : OFF_KP) + ((size_t)((ja * 2 + b) * 128 + jj) * 4 + kvh) * 64 + part * 8;
            *(GAS f32x4*)dst = (f32x4){bflo(v.x), bfhi(v.x), bflo(v.y), bfhi(v.y)}; *(GAS f32x4*)(dst + 4) = (f32x4){bflo(v.z), bfhi(v.z), bflo(v.w), bfhi(v.w)}; }
    }
    if (cu >= 0) {
        const int ckv = cu & 3, cb = cu >> 2;
        const float* ck2 = F.in[IN_CK] + (size_t)(ja * 32 + cb) * 128 * 256 + ckv * 64; const float* cv2 = F.in[IN_CV] + (size_t)(ja * 32 + cb) * 128 * 256 + ckv * 64;
        const size_t crw = (size_t)MP + cb * 4;
        f32x4 cp[8];
#pragma unroll
        for (int i = 0; i < 8; ++i) { const int c = tid + 512 * i, which = c >> 11, cc = c & 2047, jj = cc >> 4, part = cc & 15, j = jj + 4;
            if (j < 128) cp[i] = *(const GAS f32x4*)((which ? cv2 : ck2) + (size_t)j * 256 + part * 4);
            else { const v2u w = *(const GAS v2u*)(qkv + (crw + j - 128) * NQKV + 2048 + which * 256 + ckv * 64 + part * 4); cp[i] = (f32x4){bflo(w.x), bfhi(w.x), bflo(w.y), bfhi(w.y)}; } }
#pragma unroll
        for (int i = 0; i < 8; ++i) { const int c = tid + 512 * i, which = c >> 11, cc = c & 2047, jj = cc >> 4, part = cc & 15;
            *(GAS f32x4*)(F.out + (which ? OFF_VS : OFF_KS) + ((size_t)((ja * 32 + cb) * 128 + jj) * 4 + ckv) * 64 + part * 4) = cp[i]; }
    }
    __syncthreads();
    const float sink2 = F.in[IN_SINK][ja * 32 + h] * LOG2E;
#pragma unroll 1
    for (int qt = 0; qt < 4; ++qt) {
        const size_t qrow = rowb + blk * 128 + qt * 32;
        f32x16 o[2];
        attn_qtile(Ks, Vt, iscr, qf, qt, r32, blk == 0 ? 128 : 0, sink2, o, lane);
        if (qt < 3) {
#pragma unroll
            for (int st = 0; st < 4; ++st) qf[st] = *(const GAS bf16x8*)(qkv + (qrow + 32 + r32) * NQKV + h * 64 + st * 16 + hi * 8); }
#pragma unroll
        for (int dt = 0; dt < 2; ++dt)
#pragma unroll
            for (int r = 0; r < 16; ++r) O[(qrow + crow(r, hi)) * D + h * 64 + dt * 32 + r32] = (bf16)f2bf(o[dt][r]);
    }
    if (su >= 0 && F.wave == 0) {
        const int g = r32 >> 2, l = r32 & 3, hs = skv * 8 + g;
        const float sink2s = F.in[IN_SINK][ja * 32 + hs] * LOG2E;
#pragma unroll
        for (int st = 0; st < 4; ++st) qf[st] = *(const GAS bf16x8*)(qkv + (srow + l) * NQKV + hs * 64 + st * 16 + hi * 8);
        f32x16 o[2];
        attn_qtile(Ks2, Vt2, iscr, qf, 0, l, 0, sink2s, o, lane);
#pragma unroll
        for (int dt = 0; dt < 2; ++dt)
#pragma unroll
            for (int r = 0; r < 16; ++r) { const int q = crow(r, hi); O[(srow + (q & 3)) * D + (skv * 8 + (q >> 2)) * 64 + dt * 32 + r32] = (bf16)f2bf(o[dt][r]); }
    }
    __syncthreads();
}
__device__ __forceinline__ void attn_phase(Frame& F, int ja) {
    for (int u = blockIdx.x; u < 256; u += F.G) attn_unit(F, u, u < 128 ? u : -1, u >= 128 ? u - 128 : -1, ja);
}

__device__ __forceinline__ void ld8z(const bf16* p, bool ok, float (&f)[8]) { v4u v = (v4u){0u, 0u, 0u, 0u}; if (ok) v = *(const GAS v4u*)p; unpack8(v, f); }
__device__ __forceinline__ void convgate_phase(Frame& F) {
    const int tid = opq(F.tid), lane = tid & 63;
    const int gw = F.vcu * NWAVES + F.wave, NGW = F.G * NWAVES;
    const bf16* Z = (const bf16*)(F.ws + WS_Z); const bf16* BG = (const bf16*)(F.ws + WS_BG); bf16* GA = (bf16*)(F.ws + WS_O);
    const float* cw = F.in[IN_CW];
    float w0[4][8], w1[4][8], w2[4][8];
#pragma unroll
    for (int j = 0; j < 4; ++j) { const int ch = (lane + 64 * j) * 8; ld8f(cw + ch, w0[j]); ld8f(cw + D + ch, w1[j]); ld8f(cw + 2 * D + ch, w2[j]); }
    const int nfull = MR / NGW, xw = F.wave * F.G + (int)blockIdx.x, nk = nfull + (xw < MR - nfull * NGW ? 1 : 0);
    for (int k = 0; k < nk; ++k) { const int m = k < nfull ? gw + k * NGW : nfull * NGW + xw;
        const bool samp = m >= MP; const int b = samp ? (m - MP) >> 2 : m >> 12, t = samp ? (m - MP) & 3 : m & 4095;
        float y[4][8], z0[4][8];
#pragma unroll
        for (int j = 0; j < 4; ++j) {
            const int ch = (lane + 64 * j) * 8;
            float z1[8], z2[8], bg[8];
            unpack8(*(const GAS v4u*)(Z + (size_t)m * D + ch), z0[j]);
            unpack8(*(const GAS v4u*)(BG + (size_t)m * D + ch), bg);
            if (samp && t < 1) ld8f(F.in[IN_SC] + (size_t)(b * 2 + 1) * D + ch, z1); else ld8z(Z + (size_t)(m - 1) * D + ch, t >= 1, z1);
            if (samp && t < 2) ld8f(F.in[IN_SC] + (size_t)(b * 2 + t) * D + ch, z2); else ld8z(Z + (size_t)(m - 2) * D + ch, t >= 2, z2);
#pragma unroll
            for (int e = 0; e < 8; ++e) y[j][e] = bg[e] * (w0[j][e] * z2[e] + w1[j][e] * z1[e] + w2[j][e] * z0[j][e]);
        }
#pragma unroll
        for (int j = 0; j < 4; ++j) {
            const int ch = (lane + 64 * j) * 8;
            v4u w; w.x = pk2(y[j][0], y[j][1]); w.y = pk2(y[j][2], y[j][3]); w.z = pk2(y[j][4], y[j][5]); w.w = pk2(y[j][6], y[j][7]);
            *(GAS v4u*)(GA + (size_t)m * D + ch) = w;
            float* dst = nullptr;
            if (!samp && t >= SEQ - 2) dst = F.out + OFF_CP + (size_t)(b * 2 + (t - (SEQ - 2))) * D + ch;
            if (samp && t >= 2) dst = F.out + OFF_CS + (size_t)(b * 2 + (t - 2)) * D + ch;
            if (dst) { *(GAS f32x4*)dst = (f32x4){z0[j][0], z0[j][1], z0[j][2], z0[j][3]}; *(GAS f32x4*)(dst + 4) = (f32x4){z0[j][4], z0[j][5], z0[j][6], z0[j][7]}; }
        }
    }
}

__device__ __forceinline__ void sgu_ln_phase(Frame& F) {
    const int tid = opq(F.tid), lane = tid & 63; (void)lane;
    const int gw = F.vcu * NWAVES + F.wave, NGW = F.G * NWAVES;
    const bf16* V = (const bf16*)(F.ws + WS_Z); bf16* VLN = (bf16*)(F.ws + WS_VLN);
    float lg[4][8], lb[4][8];
#pragma unroll
    for (int j = 0; j < 4; ++j) { ld8f(F.in[IN_SLNG] + (lane + 64 * j) * 8, lg[j]); ld8f(F.in[IN_SLNB] + (lane + 64 * j) * 8, lb[j]); }
    v4u raw[4];
    const int nfull = MR / NGW, xw = F.wave * F.G + (int)blockIdx.x, nk = nfull + (xw < MR - nfull * NGW ? 1 : 0);
    const int mfirst = nfull > 0 ? gw : nfull * NGW + xw;
#pragma unroll
    for (int j = 0; j < 4; ++j) raw[j] = (nk > 0) ? *(const GAS v4u*)(V + (size_t)mfirst * D + (lane + 64 * j) * 8) : (v4u){0u, 0u, 0u, 0u};
    for (int k = 0; k < nk; ++k) { const int m = k < nfull ? gw + k * NGW : nfull * NGW + xw, mn = (k + 1) < nfull ? gw + (k + 1) * NGW : nfull * NGW + xw;
        float v[4][8]; float s = 0.f;
#pragma unroll
        for (int j = 0; j < 4; ++j) { unpack8(raw[j], v[j]);
#pragma unroll
            for (int e = 0; e < 8; ++e) s += v[j][e]; }
        if (k + 1 < nk) {
#pragma unroll
            for (int j = 0; j < 4; ++j) raw[j] = *(const GAS v4u*)(V + (size_t)mn * D + (lane + 64 * j) * 8); }
        const float mean = wave_sum(s) * (1.0f / D); float q = 0.f;
#pragma unroll
        for (int j = 0; j < 4; ++j)
#pragma unroll
            for (int e = 0; e < 8; ++e) { v[j][e] -= mean; q += v[j][e] * v[j][e]; }
        const float rstd = 1.0f / sqrtf(wave_sum(q) * (1.0f / D) + LN_EPS);
#pragma unroll
        for (int j = 0; j < 4; ++j) { const int ch = (lane + 64 * j) * 8; float y[8];
#pragma unroll
            for (int e = 0; e < 8; ++e) y[e] = v[j][e] * rstd * lg[j][e] + lb[j][e];
            v4u w; w.x = pk2(y[0], y[1]); w.y = pk2(y[2], y[3]); w.z = pk2(y[4], y[5]); w.w = pk2(y[6], y[7]);
            *(GAS v4u*)(VLN + (size_t)m * D + ch) = w;
            if (m >= MP) { float* dst = F.out + OFF_SV + (size_t)(m - MP) * D + ch; *(GAS f32x4*)dst = (f32x4){y[0], y[1], y[2], y[3]}; *(GAS f32x4*)(dst + 4) = (f32x4){y[4], y[5], y[6], y[7]}; }
        }
    }
}
constexpr int MIX_STR = 272, MIX_W = 0, MIX_V = 128 * MIX_STR, MIX_B = MIX_V + 256 * MIX_STR;
__device__ __forceinline__ void sgu_mix_unit(Frame& F, int u) {
    const int tid = opq(F.tid), lane = tid & 63; (void)lane;
    const int g = u & 7, c = u >> 3;
    LAS unsigned char* Wl = F.lds + MIX_W; LAS unsigned char* Vl = F.lds + MIX_V; LAS float* bsl = (LAS float*)(F.lds + MIX_B);
    const float* ws = F.in[IN_SWS] + (size_t)g * 128 * 128;
    const bf16* VLN = (const bf16*)(F.ws + WS_VLN); const bf16* U = (const bf16*)(F.ws + WS_BG); bf16* A2 = (bf16*)(F.ws + WS_O);
    const int r32 = lane & 31, hi = lane >> 5;
    f32x4 wv[8];
#pragma unroll
    for (int i = 0; i < 8; ++i) { const int cc = tid + 512 * i, t = cc >> 5, s4 = (cc & 31) * 4; wv[i] = *(const GAS f32x4*)(ws + t * 128 + s4); }
    v4u vv[8];
#pragma unroll
    for (int it = 0; it < 8; ++it) { const int pi = it * 8 + F.wave, dc = pi >> 1, s = (pi & 1) * 64 + lane; vv[it] = *(const GAS v4u*)(VLN + (size_t)(c * 128 + s) * D + g * 256 + dc * 8); }
    if (tid < 128) bsl[tid] = F.in[IN_SBS][g * 128 + tid];
    unsigned short uu[4][16];
#pragma unroll
    for (int mt = 0; mt < 4; ++mt) { const size_t ib = (size_t)(c * 128 + 32 * mt + 4 * hi) * D + g * 256 + 32 * F.wave + r32;
#pragma unroll
        for (int r = 0; r < 16; ++r) uu[mt][r] = U[ib + (size_t)((r & 3) + 8 * (r >> 2)) * D]; }
#pragma unroll
    for (int i = 0; i < 8; ++i) { const int cc = tid + 512 * i, t = cc >> 5, s4 = (cc & 31) * 4; f32x4 v = wv[i];
        if (s4 + 0 > t) v.x = 0.f; if (s4 + 1 > t) v.y = 0.f; if (s4 + 2 > t) v.z = 0.f; if (s4 + 3 > t) v.w = 0.f;
        v2u w; w.x = pk2(v.x, v.y); w.y = pk2(v.z, v.w); *(LAS v2u*)(Wl + t * MIX_STR + s4 * 2) = w; }
#pragma unroll
    for (int it = 0; it < 8; ++it) { const int pi = it * 8 + F.wave, dc = pi >> 1, s = (pi & 1) * 64 + lane; const v4u v = vv[it];
#pragma unroll
        for (int e = 0; e < 8; ++e) { const unsigned w = v[e >> 1]; *(LAS unsigned short*)(Vl + (dc * 8 + e) * MIX_STR + s * 2) = (unsigned short)((e & 1) ? (w >> 16) : (w & 0xffffu)); } }
    __syncthreads();
#pragma unroll
    for (int mt = 0; mt < 4; ++mt) {
        f32x16 acc = (f32x16){0.f, 0.f, 0.f, 0.f, 0.f, 0.f, 0.f, 0.f, 0.f, 0.f, 0.f, 0.f, 0.f, 0.f, 0.f, 0.f};
#pragma unroll
        for (int ks = 0; ks < 2 * mt + 2; ++ks) {
            const bf16x8 a = *(const LAS bf16x8*)(Wl + (32 * mt + r32) * MIX_STR + (16 * ks + 8 * hi) * 2);
            const bf16x8 bb = *(const LAS bf16x8*)(Vl + (32 * F.wave + r32) * MIX_STR + (16 * ks + 8 * hi) * 2);
            acc = __builtin_amdgcn_mfma_f32_32x32x16_bf16(a, bb, acc, 0, 0, 0);
        }
        const size_t ib = (size_t)(c * 128 + 32 * mt + 4 * hi) * D + g * 256 + 32 * F.wave + r32;
#pragma unroll
        for (int r = 0; r < 16; ++r) { const int t = 32 * mt + crow(r, hi);
            A2[ib + (size_t)((r & 3) + 8 * (r >> 2)) * D] = (bf16)f2bf(bf2f(uu[mt][r]) * (acc[r] + bsl[t])); }
    }
    __syncthreads();
}
__device__ __forceinline__ void sgu_mix_phase(Frame& F) {
    const int tid = opq(F.tid), lane = tid & 63; (void)lane;
    for (int u = blockIdx.x; u < 512; u += F.G) sgu_mix_unit(F, u);
    const bf16* VLN = (const bf16*)(F.ws + WS_VLN); const bf16* U = (const bf16*)(F.ws + WS_BG); bf16* A2 = (bf16*)(F.ws + WS_O);
    for (int r = F.wave * F.G + (int)blockIdx.x; r < MS; r += F.G * NWAVES) {
        const int m = MP + r, l = r & 3, m0 = m - l;
        v4u vr[4][4], ur[4]; float ws[4][4], bs[4];
#pragma unroll
        for (int j = 0; j < 4; ++j) { const int ch = (lane + 64 * j) * 8, g = ch >> 8;
#pragma unroll
            for (int sI = 0; sI < 4; ++sI) { vr[j][sI] = (v4u){0u, 0u, 0u, 0u}; ws[j][sI] = 0.f;
                if (sI <= l) { vr[j][sI] = *(const GAS v4u*)(VLN + (size_t)(m0 + sI) * D + ch); ws[j][sI] = F.in[IN_SWS][(size_t)(g * 128 + l) * 128 + sI]; } }
            ur[j] = *(const GAS v4u*)(U + (size_t)m * D + ch); bs[j] = F.in[IN_SBS][g * 128 + l]; }
#pragma unroll
        for (int j = 0; j < 4; ++j) { const int ch = (lane + 64 * j) * 8;
            float mix[8], uu[8];
#pragma unroll
            for (int e = 0; e < 8; ++e) mix[e] = bs[j];
#pragma unroll
            for (int sI = 0; sI < 4; ++sI) { float vv[8]; unpack8(vr[j][sI], vv);
#pragma unroll
                for (int e = 0; e < 8; ++e) mix[e] += ws[j][sI] * vv[e]; }
            unpack8(ur[j], uu);
            v4u w; w.x = pk2(uu[0] * mix[0], uu[1] * mix[1]); w.y = pk2(uu[2] * mix[2], uu[3] * mix[3]); w.z = pk2(uu[4] * mix[4], uu[5] * mix[5]); w.w = pk2(uu[6] * mix[6], uu[7] * mix[7]);
            *(GAS v4u*)(A2 + (size_t)m * D + ch) = w; }
    }
}

#ifdef SKIP_PRO
#define PRO(...)
#else
#define PRO(...) __VA_ARGS__
#endif
#ifdef SKIP_NRM
#define NRM(...)
#else
#define NRM(...) __VA_ARGS__
#endif
#ifdef SKIP_ATT
#define ATT(...)
#else
#define ATT(...) __VA_ARGS__
#endif
#ifdef SKIP_CNV
#define CNV(...)
#else
#define CNV(...) __VA_ARGS__
#endif
#ifdef SKIP_SGL
#define SGL(...)
#else
#define SGL(...) __VA_ARGS__
#endif
#ifdef SKIP_SGM
#define SGM(...)
#else
#define SGM(...) __VA_ARGS__
#endif
#ifdef SKIP_GM_EpiGated
#define GM_EpiGated(...)
#else
#define GM_EpiGated(...) __VA_ARGS__
#endif
#ifdef SKIP_GM_EpiF32
#define GM_EpiF32(...)
#else
#define GM_EpiF32(...) __VA_ARGS__
#endif
#ifdef SKIP_GM_EpiQKV
#define GM_EpiQKV(...)
#else
#define GM_EpiQKV(...) __VA_ARGS__
#endif
#ifdef SKIP_GM_EpiConvIn
#define GM_EpiConvIn(...)
#else
#define GM_EpiConvIn(...) __VA_ARGS__
#endif
#ifdef SKIP_GM_EpiGeluSplit
#define GM_EpiGeluSplit(...)
#else
#define GM_EpiGeluSplit(...) __VA_ARGS__
#endif

#ifndef MK_PER_PHASE
#define MK_PER_PHASE 0
#endif
constexpr int N_STEPS = 42;
struct Args { const float* in[20]; float* out; unsigned char* ws; int lo, hi, li, pad; };
__global__ void __launch_bounds__(NWAVES * 64, 2) mk_fwd(Args a) {
    extern __shared__ __attribute__((aligned(16))) unsigned char lds_raw[];
    Frame F;
    F.lds = (LAS unsigned char*)lds_raw;
    F.tid = threadIdx.x; F.lane = F.tid & 63; F.wave = __builtin_amdgcn_readfirstlane(F.tid >> 6);
    F.G = gridDim.x; { const int bx = blockIdx.x; F.vcu = (F.G % 8 == 0) ? (bx % 8) * (F.G / 8) + bx / 8 : bx; }
#pragma unroll
    for (int i = 0; i < 20; ++i) F.in[i] = a.in[i];
    F.out = a.out; F.ws = a.ws;
    for (int u = F.tid; u < (LDS_BYTES - LDSCTL_OFF) / 4; u += NWAVES * 64) ((LAS unsigned*)(F.lds + LDSCTL_OFF))[u] = 0u;
    __syncthreads();
    unsigned* barw = (unsigned*)(a.ws + WS_CTL) + CW_BAR + a.li * XCD_BAR_WORDS;
    XcdBarrier bar; bar.bar = barw; bar.x = 0; bar.st = nullptr;
    if (a.hi - a.lo > 1) bar = xcd_barrier_post(barw, (volatile LAS unsigned*)(F.lds + MISC_OFF) + 8);
    int st = 0;
#ifndef XBAR_EXTRA
#define XBAR_EXTRA 0
#endif
#ifndef DUP_MASK
#define DUP_MASK 0
#endif
#define DUPN(bit) (((DUP_MASK) >> (bit)) & 1 ? 2 : 1)
#define CVT(sl) do { } while (0)
#define REP(bit, ...) for (int rep_ = 0; rep_ < DUPN(bit); ++rep_) { __VA_ARGS__ }
#ifdef PROBE_WAIT
#define PT(k) ptype_ = (k);
#define RUN(...) do { if (st >= a.lo && st < a.hi) { __VA_ARGS__; if (st + 1 < a.hi) { const unsigned long long t0_ = __builtin_amdgcn_s_memrealtime(); xcd_barrier(bar); if ((PROBE_WAIT) & ptype_) wacc_ += (unsigned)(__builtin_amdgcn_s_memrealtime() - t0_); } } ++st; } while (0)
    int ptype_ = 0; unsigned wacc_ = 0u;
#elif defined(PROBE_DUR)
#ifndef PROBE_MUL
#define PROBE_MUL 1
#endif
#define PT(k) ptype_ = (k);
#define RUN(...) do { if (st >= a.lo && st < a.hi) { const unsigned long long t0_ = __builtin_amdgcn_s_memrealtime(); __VA_ARGS__; if (st + 1 < a.hi) xcd_barrier(bar); if ((PROBE_DUR) & ptype_) dacc_ += (unsigned)(__builtin_amdgcn_s_memrealtime() - t0_); } ++st; } while (0)
    int ptype_ = 0; unsigned dacc_ = 0u;
#else
#define PT(k)
#define RUN(...) do { if (st >= a.lo && st < a.hi) { __VA_ARGS__; if (st + 1 < a.hi) { xcd_barrier(bar); for (int xb_ = 0; xb_ < XBAR_EXTRA; ++xb_) xcd_barrier(bar); } } ++st; } while (0)
#endif
    const float* ng = F.in[IN_NG];
    bf16* H = (bf16*)(F.ws + WS_H); bf16* ACT = (bf16*)(F.ws + WS_ACT); bf16* OUTF = (bf16*)(F.ws + WS_OUTF); const float* RSTD = (const float*)(F.ws + WS_RSTD); bf16* OB = (bf16*)(F.ws + WS_O);

    PT(32) RUN({ REP(0, PRO(prologue_phase(F);)) });

    const bf16* stA = nullptr; const bf16* stB = nullptr; int stK = 0, stNs = 1, stT = -1; float stAlpha = 0.f; const float* stG = nullptr;
#define SAMP_TAIL(WQ8) do { if (stT >= 0) { \
        unsigned* f1_ = (unsigned*)(F.ws + WS_CTL) + CW_SFLAG + stT * 128; \
        pg8::Gemm gp_{stA, stB, stK}; pg8::PanelOrder SP_; SP_.init(D, stK, stNs, F.G, (int)blockIdx.x, 2); \
        pg8::EpiF32 EP_{OUTF, D, (float*)(F.ws + WS_PART), PART_SLAB}; \
        pg8::gemm_phase<pg8::EpiF32, pg8::PanelOrder, true, true>(F.lds, gp_, SP_, EP_); \
        const int npc_ = SP_.nS < F.G ? SP_.nS : F.G;                        \
        if (F.G - 1 - (int)blockIdx.x < npc_ && F.tid == 0) __hip_atomic_fetch_add(f1_, 1u, __ATOMIC_RELAXED, __HIP_MEMORY_SCOPE_AGENT); \
        sample_tail_norm(F, stAlpha, stG, stNs, WQ8, f1_, (unsigned)npc_, f1_ + 64); } } while (0)
#define SAMP_FLAG (stT >= 0 ? (const unsigned*)((unsigned*)(F.ws + WS_CTL) + CW_SFLAG + stT * 128 + 64) : (const unsigned*)nullptr)

    for (int layer = 0; layer < 4; ++layer) {
        const int kind = layer % 3, jm = layer / 3;
        const float* g = ng + (size_t)layer * 6 * D;
        for (int half = 0; half < 2; ++half) {
            const bf16* wgu = (const bf16*)(F.ws + WS_WFFN + (size_t)(layer * 2 + half) * WFFN_STRIDE);
            const bf16* wd = (const bf16*)((const unsigned char*)wgu + WD_OFF);
            const bool lastsl = (layer == 3 && half == 1);
            const float* gpost = g + (half == 0 ? 1 : 5) * D;
            PT(1) RUN({ SAMP_TAIL(true);
                  pg8::Gemm gm{(const bf16*)(F.ws + WS_XQ8), wgu, D / 2}; pg8::PanelOrder S; S.init(NGU, D / 2, 1, F.G, (int)blockIdx.x, 0, SAMP_FLAG, 128u);
#ifdef G1_SWP
                  S.swp = 1;
#endif
                  pg8::EpiGatedI8 E{ACT, DFF, (const float*)(F.ws + WS_RS8), (const float*)(F.ws + WS_SW) + (size_t)(layer * 2 + half) * NGU};
                  REP(2, GM_EpiGated(pg8::gemm_phase<pg8::EpiGatedI8, pg8::PanelOrder, true, true, true>(F.lds, gm, S, E);)) });
            PT(lastsl ? 8192 : 2) RUN({ pg8::Gemm gm{ACT, wd, DFF}; pg8::PanelOrder S; S.init(D, DFF, NSPLIT_FFN, F.G, (int)blockIdx.x, lastsl ? 0 : 1);
#ifdef G2_SWP
                  S.swp = 2; S.xm = (G2_SWP);
#endif

                  pg8::EpiF32 E{OUTF, D, (float*)(F.ws + WS_PART), PART_SLAB};
                  REP(3, GM_EpiF32(pg8::gemm_phase<pg8::EpiF32, pg8::PanelOrder, true, true>(F.lds, gm, S, E);))
                  });
            PT(lastsl ? 4096 : 4) RUN({ NRM(norm_phase(F, 0.5f, gpost, lastsl, NSPLIT_FFN, half == 1 && !lastsl, lastsl);) });
            stA = ACT; stB = wd; stK = DFF; stNs = NSPLIT_FFN; stAlpha = 0.5f; stG = gpost; stT = layer * 3 + 2 * half;
            if (half == 1) break;
            const bf16* mixB = nullptr;
            if (kind == 0) {
                const bf16* wq = (const bf16*)(F.ws + WS_WATT + (size_t)jm * WATT_STRIDE); mixB = (const bf16*)((const unsigned char*)wq + WO_OFF);
                PT(64) RUN({ SAMP_TAIL(false);
                      pg8::Gemm gm{H, wq, D}; pg8::PanelOrder S; S.init(NQKV, D, 1, F.G, (int)blockIdx.x, 0, SAMP_FLAG, 128u);
#ifdef QKV_SWP
                      S.swp = 1;
#endif

                      pg8::EpiQKV E{(bf16*)(F.ws + WS_QKV), (const float*)(F.ws + WS_ROPE), (const float*)(F.ws + WS_ROPE) + 4100 * 8, RSTD};
                      REP(5, GM_EpiQKV(pg8::gemm_phase<pg8::EpiQKV, pg8::PanelOrder, true, true>(F.lds, gm, S, E);)) });
                PT(16) RUN({ REP(4, ATT(attn_phase(F, jm);)) });
            } else if (kind == 1) {
                mixB = (const bf16*)(F.ws + WS_WCONV + WCOUT_OFF);
                PT(128) RUN({ SAMP_TAIL(false);
                      pg8::Gemm gm{H, (const bf16*)(F.ws + WS_WCONV), D}; pg8::PanelOrder S; S.init(NCIN, D, 1, F.G, (int)blockIdx.x, 0, SAMP_FLAG, 128u);
#ifdef CIN_SWP
                      S.swp = 1;
#endif

                      pg8::EpiConvIn E{(bf16*)(F.ws + WS_BG), (bf16*)(F.ws + WS_Z), RSTD};
                      REP(5, GM_EpiConvIn(pg8::gemm_phase<pg8::EpiConvIn, pg8::PanelOrder, true, true>(F.lds, gm, S, E);)) });
                PT(512) RUN({ REP(6, CNV(convgate_phase(F);)) });
            } else {
                mixB = (const bf16*)(F.ws + WS_WSGU + WSOUT_OFF);
                PT(256) RUN({ SAMP_TAIL(false);
                      pg8::Gemm gm{H, (const bf16*)(F.ws + WS_WSGU), D}; pg8::PanelOrder S; S.init(NSIN, D, 1, F.G, (int)blockIdx.x, 0, SAMP_FLAG, 128u); if (F.G == 256) S.xr = 8;
                      pg8::EpiGeluSplit E{(bf16*)(F.ws + WS_BG), (bf16*)(F.ws + WS_Z), RSTD};
                      REP(5, GM_EpiGeluSplit(pg8::gemm_phase<pg8::EpiGeluSplit, pg8::PanelOrder, true, true>(F.lds, gm, S, E);)) });
                PT(1024) RUN({ REP(7, SGL(sgu_ln_phase(F);)) });
                PT(2048) RUN({ REP(8, SGM(sgu_mix_phase(F);)) });
            }
            PT(8) RUN({ pg8::Gemm gm{OB, mixB, D}; pg8::PanelOrder S; S.init(D, D, NSPLIT_MIX, F.G, (int)blockIdx.x, 1);
                  pg8::EpiF32 E{OUTF, D, (float*)(F.ws + WS_PART), PART_SLAB};
                  REP(5, GM_EpiF32(pg8::gemm_phase<pg8::EpiF32, pg8::PanelOrder, true, true>(F.lds, gm, S, E);)) });
            PT(4) RUN({ NRM(norm_phase(F, 1.0f, g + 3 * D, false, NSPLIT_MIX, true, false);) });
            stA = OB; stB = mixB; stK = D; stNs = NSPLIT_MIX; stAlpha = 1.0f; stG = g + 3 * D; stT = layer * 3 + 1;
        }
    }
#ifdef PROBE_WAIT
    {
        unsigned* tw = (unsigned*)(a.ws + WS_CTL) + 30000;
        if (threadIdx.x == 0) __hip_atomic_fetch_add(tw, wacc_, __ATOMIC_RELAXED, __HIP_MEMORY_SCOPE_AGENT);
        xcd_barrier(bar);
        const unsigned tot = __hip_atomic_load(tw, __ATOMIC_RELAXED, __HIP_MEMORY_SCOPE_AGENT);
        const unsigned long long t0 = __builtin_amdgcn_s_memrealtime(), dt = (unsigned long long)(tot / (unsigned)F.G);
        while (__builtin_amdgcn_s_memrealtime() - t0 < dt) __builtin_amdgcn_s_sleep(8);
    }
#endif
#ifdef PROBE_ATT
    { __syncthreads(); const unsigned dd = *(volatile LAS unsigned*)(F.lds + MISC_OFF + 52); const unsigned long long t0 = __builtin_amdgcn_s_memrealtime(); if (blockIdx.x == 0) while (__builtin_amdgcn_s_memrealtime() - t0 < (unsigned long long)dd * 8ull) __builtin_amdgcn_s_sleep(8); }
#endif
#ifdef PROBE_DUR
    { const unsigned long long t0 = __builtin_amdgcn_s_memrealtime(); while (__builtin_amdgcn_s_memrealtime() - t0 < (unsigned long long)dacc_ * (PROBE_MUL)) __builtin_amdgcn_s_sleep(8); }
#endif
#undef SAMP_TAIL
#undef SAMP_FLAG
#undef RUN
}

extern "C" void kernel_launch(void* const* d_in, const int* in_sizes, int n_in, void* d_out, int out_size, void* d_ws, size_t ws_size, hipStream_t stream) {
    static int grid = 0;
    if (grid == 0) {
        if (n_in != 20 || (size_t)out_size != OUT_TOTAL || ws_size < WS_END) { fprintf(stderr, "kernel_launch: unexpected shapes: n_in %d out %d ws %zu (need %zu)\n", n_in, out_size, ws_size, (size_t)WS_END); grid = -1; return; }
        int dev = 0, cus = 0, per_cu = 0;
        if (hipGetDevice(&dev) != hipSuccess || hipDeviceGetAttribute(&cus, hipDeviceAttributeMultiprocessorCount, dev) != hipSuccess) { grid = -1; return; }
        if (hipFuncSetAttribute((const void*)mk_fwd, hipFuncAttributeMaxDynamicSharedMemorySize, LDS_BYTES) != hipSuccess) { fprintf(stderr, "kernel_launch: hipFuncSetAttribute failed\n"); grid = -1; return; }
        if (hipOccupancyMaxActiveBlocksPerMultiprocessor(&per_cu, (const void*)mk_fwd, NWAVES * 64, LDS_BYTES) != hipSuccess || per_cu < 1) fprintf(stderr, "kernel_launch: occupancy query says %d\n", per_cu);
        (void)hipGetLastError();
        grid = cus;
    }
    if (grid < 0) return;
    (void)hipMemsetAsync((char*)d_ws + WS_CTL, 0, CTL_ZERO_BYTES, stream);
    Args a{};
    for (int i = 0; i < 20; ++i) a.in[i] = (const float*)d_in[i];
    a.out = (float*)d_out; a.ws = (unsigned char*)d_ws; a.pad = 0;
#if MK_PER_PHASE
    for (int s = 0; s < N_STEPS; ++s) { a.lo = s; a.hi = s + 1; a.li = 0; hipLaunchKernelGGL(mk_fwd, dim3(grid), dim3(NWAVES * 64), LDS_BYTES, stream, a); }
#else
    a.lo = 0; a.hi = N_STEPS; a.li = 0;
    hipLaunchKernelGGL(mk_fwd, dim3(grid), dim3(NWAVES * 64), LDS_BYTES, stream, a);
#endif
    const hipError_t le = hipPeekAtLastError();
    if (le != hipSuccess) fprintf(stderr, "kernel_launch: launch failed: %s\n", hipGetErrorName(le));
}
```
